# Optimizing an MI355X kernel written in HIP

```python
import math
import jax, jax.numpy as jnp
from jax import lax
import numpy as np

D_MODEL = 1024
BATCH = 4
SEQ = 8192
DEPTH = 4

N_MIXERS = 2
N_ATTN_LAYERS = (DEPTH + 1) // 2
N_SSM_LAYERS = DEPTH // 2

D_FF = 2816

ATTN_HEADS = 16
ATTN_HEAD_DIM = 64
KV_RANK = 256
IDX_HEADS = 8
IDX_HEAD_DIM = 64
TOPK_MAX = 256
Q_BLOCK = 128
ATTN_Q_DIM = ATTN_HEADS * ATTN_HEAD_DIM
ATTN_IN = ATTN_Q_DIM + KV_RANK + IDX_HEADS * IDX_HEAD_DIM + IDX_HEAD_DIM + IDX_HEADS

SSM_INNER = 2 * D_MODEL
SSM_HEAD_DIM = 64
SSM_HEADS = SSM_INNER // SSM_HEAD_DIM
SSM_GROUPS = 4
SSM_STATE = 128
SSM_CONV = 4
SSM_CHUNK = 128
SSM_CONV_DIM = SSM_INNER + 2 * SSM_GROUPS * SSM_STATE
SSM_IN = SSM_INNER + SSM_CONV_DIM + SSM_HEADS

DEEPNORM_ALPHA = (2.0 * DEPTH) ** 0.25
DEEPNORM_BETA = (8.0 * DEPTH) ** -0.25
LN_EPS = 1e-5
RMS_EPS = 1e-6

kernel_name = 'hybrid_dsa_ssd_macaron_deepnorm'


def layer_norm(x, g, b):
    xf = x.astype(jnp.float32)
    mu = jnp.mean(xf, -1, keepdims=True)
    var = jnp.mean(jnp.square(xf - mu), -1, keepdims=True)
    return ((xf - mu) * lax.rsqrt(var + LN_EPS) * g.astype(jnp.float32) + b.astype(jnp.float32)).astype(x.dtype)


def rms_norm(x, g):
    xf = x.astype(jnp.float32)
    ms = jnp.mean(jnp.square(xf), -1, keepdims=True)
    return (xf * lax.rsqrt(ms + RMS_EPS) * g.astype(jnp.float32)).astype(x.dtype)


def swiglu_ffn(x, w_in, w_out):
    gate, up = jnp.split(x @ w_in, 2, axis=-1)
    return (jax.nn.silu(gate) * up) @ w_out


def dsa_mixer(x, w_in, kv_norm_g, w_uk, w_uv, w_out):
    bsz, seq, _ = x.shape
    topk = min(TOPK_MAX, seq // 4)
    o1 = ATTN_Q_DIM
    o2 = o1 + KV_RANK
    o3 = o2 + IDX_HEADS * IDX_HEAD_DIM
    o4 = o3 + IDX_HEAD_DIM
    q, c_kv, q_idx, k_idx, w_idx = jnp.split(x @ w_in, [o1, o2, o3, o4], axis=-1)
    q = q.reshape(bsz, seq, ATTN_HEADS, ATTN_HEAD_DIM)
    c_kv = rms_norm(c_kv, kv_norm_g)
    q_idx = q_idx.reshape(bsz, seq, IDX_HEADS, IDX_HEAD_DIM)
    w_idx = w_idx * (IDX_HEADS ** -0.5)
    n_blk = seq // Q_BLOCK
    key_pos = jnp.arange(seq)

    def to_blocks(t):
        return jnp.moveaxis(t.reshape(bsz, n_blk, Q_BLOCK, *t.shape[2:]), 1, 0)

    def block(args):
        blk, q_b, qi_b, wi_b = args
        q_pos = blk * Q_BLOCK + jnp.arange(Q_BLOCK)
        s = jnp.einsum('bthd,bsd->bths', qi_b, k_idx).astype(jnp.float32) * (IDX_HEAD_DIM ** -0.5)
        score = jnp.einsum('bths,bth->bts', jax.nn.relu(s), wi_b.astype(jnp.float32))
        causal = key_pos[None, :] <= q_pos[:, None]
        score = jnp.where(causal[None], score, -jnp.inf)
        _, idx = lax.top_k(score, topk)
        valid = idx <= q_pos[None, :, None]
        c_sel = jax.vmap(lambda c, i: c[i])(c_kv, idx)
        q_abs = jnp.einsum('bthd,hdr->bthr', q_b, w_uk)
        logits = jnp.einsum('bthr,btkr->bthk', q_abs, c_sel).astype(jnp.float32) * (ATTN_HEAD_DIM ** -0.5)
        logits = jnp.where(valid[:, :, None, :], logits, -jnp.inf)
        p = jax.nn.softmax(logits, axis=-1).astype(c_sel.dtype)
        o_lat = jnp.einsum('bthk,btkr->bthr', p, c_sel)
        o = jnp.einsum('bthr,hrd->bthd', o_lat, w_uv)
        return o.reshape(bsz, Q_BLOCK, ATTN_Q_DIM)

    out = lax.map(block, (jnp.arange(n_blk), to_blocks(q), to_blocks(q_idx), to_blocks(w_idx)))
    out = jnp.moveaxis(out, 0, 1).reshape(bsz, seq, ATTN_Q_DIM)
    return out @ w_out


def ssd_scan(x, dt, a, b_in, c_in):
    bsz, seq, n_h, p_dim = x.shape
    nc = seq // SSM_CHUNK
    q_len = SSM_CHUNK
    g_n = SSM_GROUPS
    r_n = n_h // g_n
    xdt = (x.astype(jnp.float32) * dt[..., None]).reshape(bsz, nc, q_len, g_n, r_n, p_dim)
    a_dt = (dt * a).reshape(bsz, nc, q_len, g_n, r_n)
    a_cs_l = jnp.cumsum(a_dt, axis=2)
    a_cs = jnp.moveaxis(a_cs_l, 2, -1)
    bm = b_in.astype(jnp.float32).reshape(bsz, nc, q_len, g_n, SSM_STATE)
    cm = c_in.astype(jnp.float32).reshape(bsz, nc, q_len, g_n, SSM_STATE)
    seg = a_cs[..., :, None] - a_cs[..., None, :]
    tri = jnp.tril(jnp.ones((q_len, q_len), dtype=bool))
    decay = jnp.exp(jnp.where(tri, seg, -jnp.inf))
    cb = jnp.einsum('bclgn,bcsgn->bcgls', cm, bm)
    y_diag = jnp.einsum('bcgrls,bcsgrp->bclgrp', cb[:, :, :, None] * decay, xdt)
    decay_to_end = jnp.exp(a_cs_l[:, :, -1:] - a_cs_l)
    states = jnp.einsum('bclgn,bclgrp->bcgrpn', bm, xdt * decay_to_end[..., None])
    chunk_decay = jnp.exp(a_cs_l[:, :, -1])

    def step(h, inp):
        s_c, d_c = inp
        return h * d_c[..., None, None] + s_c, h

    h0 = jnp.zeros((bsz, g_n, r_n, p_dim, SSM_STATE), jnp.float32)
    _, prev = lax.scan(step, h0, (jnp.moveaxis(states, 1, 0), jnp.moveaxis(chunk_decay, 1, 0)))
    prev = jnp.moveaxis(prev, 0, 1)
    y_off = jnp.einsum('bclgn,bcgrpn->bclgrp', cm, prev) * jnp.exp(a_cs_l)[..., None]
    return (y_diag + y_off).reshape(bsz, seq, n_h, p_dim)


def ssd_mixer(x, w_in, conv_w, conv_b, dt_bias, a_log, d_skip, norm_g, w_out):
    bsz, seq, _ = x.shape
    z, xbc, dt = jnp.split(x @ w_in, [SSM_INNER, SSM_INNER + SSM_CONV_DIM], axis=-1)
    xbc_pad = jnp.pad(xbc, ((0, 0), (SSM_CONV - 1, 0), (0, 0)))
    conv = conv_b + xbc_pad[:, 0:seq] * conv_w[0]
    for k in range(1, SSM_CONV):
        conv = conv + xbc_pad[:, k:k + seq] * conv_w[k]
    xbc = jax.nn.silu(conv)
    xs, b_in, c_in = jnp.split(xbc, [SSM_INNER, SSM_INNER + SSM_GROUPS * SSM_STATE], axis=-1)
    xs = xs.reshape(bsz, seq, SSM_HEADS, SSM_HEAD_DIM)
    dt = jax.nn.softplus((dt + dt_bias).astype(jnp.float32))
    a = -jnp.exp(a_log.astype(jnp.float32))
    y = ssd_scan(xs, dt, a,
                 b_in.reshape(bsz, seq, SSM_GROUPS, SSM_STATE),
                 c_in.reshape(bsz, seq, SSM_GROUPS, SSM_STATE))
    y = y + xs.astype(jnp.float32) * d_skip.astype(jnp.float32)[:, None]
    yz = y.reshape(bsz, seq, SSM_INNER) * jax.nn.silu(z.astype(jnp.float32))
    yz = yz.reshape(bsz, seq, SSM_GROUPS, SSM_INNER // SSM_GROUPS)
    yz = yz * lax.rsqrt(jnp.mean(jnp.square(yz), -1, keepdims=True) + RMS_EPS)
    yz = (yz.reshape(bsz, seq, SSM_INNER) * norm_g.astype(jnp.float32)).astype(x.dtype)
    return yz @ w_out


def setup_inputs(seed: int = 0) -> dict:
    key = jax.random.key(seed)
    ks = jax.random.split(key, 20)
    f32 = jnp.float32
    D = D_MODEL
    nrm = lambda k, shape, s: jax.random.normal(k, shape, f32) * s
    x = jax.random.normal(ks[0], (BATCH, SEQ, D), f32)
    ln_g = 1.0 + nrm(ks[1], (DEPTH, 3, D), 0.02)
    ln_b = nrm(ks[2], (DEPTH, 3, D), 0.02)
    ffn1_w_in = nrm(ks[3], (DEPTH, D, 2 * D_FF), D ** -0.5)
    ffn1_w_out = nrm(ks[4], (DEPTH, D_FF, D), D_FF ** -0.5 * DEEPNORM_BETA)
    ffn2_w_in = nrm(ks[5], (DEPTH, D, 2 * D_FF), D ** -0.5)
    ffn2_w_out = nrm(ks[6], (DEPTH, D_FF, D), D_FF ** -0.5 * DEEPNORM_BETA)
    attn_w_in = nrm(ks[7], (N_ATTN_LAYERS, D, ATTN_IN), D ** -0.5)
    attn_kv_norm = 1.0 + nrm(ks[8], (N_ATTN_LAYERS, KV_RANK), 0.02)
    attn_w_uk = nrm(ks[9], (N_ATTN_LAYERS, ATTN_HEADS, ATTN_HEAD_DIM, KV_RANK), KV_RANK ** -0.5)
    attn_w_uv = nrm(ks[10], (N_ATTN_LAYERS, ATTN_HEADS, KV_RANK, ATTN_HEAD_DIM), KV_RANK ** -0.5)
    attn_w_out = nrm(ks[11], (N_ATTN_LAYERS, ATTN_Q_DIM, D), ATTN_Q_DIM ** -0.5 * DEEPNORM_BETA)
    ssm_w_in = nrm(ks[12], (N_SSM_LAYERS, D, SSM_IN), D ** -0.5)
    ssm_conv_w = nrm(ks[13], (N_SSM_LAYERS, SSM_CONV, SSM_CONV_DIM), SSM_CONV ** -0.5)
    ssm_conv_b = nrm(ks[14], (N_SSM_LAYERS, SSM_CONV_DIM), 0.01)
    dt0 = jnp.exp(jax.random.uniform(ks[15], (N_SSM_LAYERS, SSM_HEADS), f32,
                                     minval=math.log(1e-3), maxval=math.log(1e-1)))
    ssm_dt_bias = dt0 + jnp.log(-jnp.expm1(-dt0))
    ssm_a_log = jnp.log(jax.random.uniform(ks[16], (N_SSM_LAYERS, SSM_HEADS), f32, minval=1.0, maxval=16.0))
    ssm_d = 1.0 + nrm(ks[17], (N_SSM_LAYERS, SSM_HEADS), 0.02)
    ssm_norm_g = 1.0 + nrm(ks[18], (N_SSM_LAYERS, SSM_INNER), 0.02)
    ssm_w_out = nrm(ks[19], (N_SSM_LAYERS, SSM_INNER, D), SSM_INNER ** -0.5 * DEEPNORM_BETA)
    return {'x': x, 'ln_g': ln_g, 'ln_b': ln_b,
            'ffn1_w_in': ffn1_w_in, 'ffn1_w_out': ffn1_w_out,
            'ffn2_w_in': ffn2_w_in, 'ffn2_w_out': ffn2_w_out,
            'attn_w_in': attn_w_in, 'attn_kv_norm': attn_kv_norm,
            'attn_w_uk': attn_w_uk, 'attn_w_uv': attn_w_uv, 'attn_w_out': attn_w_out,
            'ssm_w_in': ssm_w_in, 'ssm_conv_w': ssm_conv_w, 'ssm_conv_b': ssm_conv_b,
            'ssm_dt_bias': ssm_dt_bias, 'ssm_a_log': ssm_a_log, 'ssm_d': ssm_d,
            'ssm_norm_g': ssm_norm_g, 'ssm_w_out': ssm_w_out}


def reference(x, ln_g, ln_b, ffn1_w_in, ffn1_w_out, ffn2_w_in, ffn2_w_out,
              attn_w_in, attn_kv_norm, attn_w_uk, attn_w_uv, attn_w_out,
              ssm_w_in, ssm_conv_w, ssm_conv_b, ssm_dt_bias, ssm_a_log, ssm_d,
              ssm_norm_g, ssm_w_out):
    for i in range(DEPTH):
        x = layer_norm(DEEPNORM_ALPHA * x + 0.5 * swiglu_ffn(x, ffn1_w_in[i], ffn1_w_out[i]), ln_g[i, 0], ln_b[i, 0])
        j = i // N_MIXERS
        if i % N_MIXERS == 0:
            m = dsa_mixer(x, attn_w_in[j], attn_kv_norm[j], attn_w_uk[j], attn_w_uv[j], attn_w_out[j])
        else:
            m = ssd_mixer(x, ssm_w_in[j], ssm_conv_w[j], ssm_conv_b[j], ssm_dt_bias[j],
                          ssm_a_log[j], ssm_d[j], ssm_norm_g[j], ssm_w_out[j])
        x = layer_norm(DEEPNORM_ALPHA * x + m, ln_g[i, 1], ln_b[i, 1])
        x = layer_norm(DEEPNORM_ALPHA * x + 0.5 * swiglu_ffn(x, ffn2_w_in[i], ffn2_w_out[i]), ln_g[i, 2], ln_b[i, 2])
    return x
```

```cpp
#include <hip/hip_runtime.h>
#include <hip/hip_cooperative_groups.h>
#include <cstdio>
namespace cg = cooperative_groups;
namespace pg8 {
#define PG8_LAS __attribute__((address_space(3)))
typedef unsigned short bf16_t;
typedef short bf16x8 __attribute__((ext_vector_type(8)));
typedef float f32x4 __attribute__((ext_vector_type(4)));
typedef unsigned u32x4 __attribute__((ext_vector_type(4)));
constexpr int BM = 256, BK = 64, HALF = 128, HTB = HALF * BK * 2  , STAGE_BYTES = 8 * HTB, NXCD = 8, WGM = 8;

__host__ __device__ __forceinline__ int lds_byte(int r, int c) { const int st = (r >> 4) * 2 + (c >> 5), rr = r & 15, cc = c & 31, ob = rr * 64 + cc * 2; return st * 1024 + (ob ^ (((ob >> 9) & 1) << 5)); }
__host__ __device__ __forceinline__ void stage_rc(int b, int& R, int& C) { const int st = b / 1024, sb = b % 1024, swz = sb ^ (((sb >> 9) & 1) << 5); R = (st >> 1) * 16 + swz / 64; C = (st & 1) * 32 + (swz % 64) / 2; }
__host__ __device__ __forceinline__ int perm32(int rho) { const int n = rho >> 4, i = rho & 15; return 8 * (i >> 2) + 4 * n + (i & 3); }

struct Unit { int pm, pn; };
struct Gemm { const bf16_t* A; const bf16_t* Bt; int M, N, K, lda; };

struct StaticOrder {
    int nM, nN, nwg, G, c;
    __host__ __device__ void init(int M, int N, int G_, int c_) { nM = M / BM; nN = N / BM; nwg = nM * nN; G = G_; c = c_; }
    __host__ __device__ bool next(int i, Unit& u) const {
        const long L = (long)i * G + c; if (L >= nwg) return false;
        int wgid = (int)L; { const int q = nwg / NXCD, r = nwg % NXCD, xcd = wgid % NXCD, off = wgid / NXCD; wgid = (xcd < r ? xcd * (q + 1) : r * (q + 1) + (xcd - r) * q) + off; }
        const int nig = WGM * nN, gid = wgid / nig, fm = gid * WGM, gsz = (nM - fm) < WGM ? (nM - fm) : WGM;
        u.pm = fm + ((wgid % nig) % gsz); u.pn = (wgid % nig) / gsz; return true;
    }
    __device__ __forceinline__ void a_ready(const Unit&) const {}
    __device__ __forceinline__ void done(const Unit&) const {}
};
typedef __bf16 bf16x2_t __attribute__((ext_vector_type(2)));
typedef float f32x2_t __attribute__((ext_vector_type(2)));
__device__ __forceinline__ unsigned cvt_pk_bf16(float lo, float hi) { const f32x2_t f = {lo, hi}; const bf16x2_t v = __builtin_convertvector(f, bf16x2_t); return __builtin_bit_cast(unsigned, v); }
__device__ __forceinline__ float silu_f(float x) { return x * __builtin_amdgcn_rcpf(1.0f + __expf(-x)); }
struct EpiSwiglu {
    static constexpr bool PERM = true, AFTER_DRAIN = false;
    bf16_t* H;
    __device__ __forceinline__ void operator()(const f32x4 (&acc)[2][2][4][2], const Unit& u, int wr, int wc, int fr, int fq) const {
        const int row0 = u.pm * BM + wr * 64 + fr, col0 = u.pn * 128 + wc * 32 + 8 * fq;
#pragma unroll
        for (int ai = 0; ai < 2; ++ai)
#pragma unroll
            for (int m = 0; m < 4; ++m) {
                bf16_t* rowp = H + (size_t)(row0 + ai * HALF + m * 16) * 2816 + col0;
                const f32x4 g0 = acc[ai][0][m][0], g1 = acc[ai][0][m][1], u0 = acc[ai][1][m][0], u1 = acc[ai][1][m][1];
                u32x4 w;
                w.x = cvt_pk_bf16(silu_f(g0[0]) * u0[0], silu_f(g0[1]) * u0[1]); w.y = cvt_pk_bf16(silu_f(g0[2]) * u0[2], silu_f(g0[3]) * u0[3]);
                w.z = cvt_pk_bf16(silu_f(g1[0]) * u1[0], silu_f(g1[1]) * u1[1]); w.w = cvt_pk_bf16(silu_f(g1[2]) * u1[2], silu_f(g1[3]) * u1[3]);
                *(u32x4*)rowp = w; }
    }
};
struct EpiResid {
    static constexpr bool PERM = false, AFTER_DRAIN = false;
    const float* R; float* Y; float alpha, scale;
    __device__ __forceinline__ void operator()(const f32x4 (&acc)[2][2][4][2], const Unit& u, int wr, int wc, int fr, int fq) const {
        const int row0 = u.pm * BM + wr * 64 + fr, col0 = u.pn * BM + wc * 32 + 4 * fq;
#pragma unroll
        for (int ai = 0; ai < 2; ++ai)
#pragma unroll
            for (int m = 0; m < 4; ++m) { const size_t ro = (size_t)(row0 + ai * HALF + m * 16) * 1024 + col0;
#pragma unroll
                for (int bj = 0; bj < 2; ++bj)
#pragma unroll
                    for (int n = 0; n < 2; ++n) { const size_t o = ro + bj * HALF + n * 16; const f32x4 r = *(const f32x4*)(R + o); *(f32x4*)(Y + o) = r * alpha + acc[ai][bj][m][n] * scale; } }
    }
};
struct EpiSplit {
    static constexpr bool PERM = true, AFTER_DRAIN = false;
    bf16_t* O; int ldo; int nb16; float* F; int ldf; int fcols;
    __device__ __forceinline__ void operator()(const f32x4 (&acc)[2][2][4][2], const Unit& u, int wr, int wc, int fr, int fq) const {
        const int row0 = u.pm * BM + wr * 64 + fr;
        if (u.pn < nb16) {
            const int col0 = u.pn * BM + wc * 32 + 8 * fq;
#pragma unroll
            for (int ai = 0; ai < 2; ++ai)
#pragma unroll
                for (int m = 0; m < 4; ++m) { bf16_t* rowp = O + (size_t)(row0 + ai * HALF + m * 16) * ldo + col0;
#pragma unroll
                    for (int bj = 0; bj < 2; ++bj) { const f32x4 v0 = acc[ai][bj][m][0], v1 = acc[ai][bj][m][1]; u32x4 w;
                        w.x = cvt_pk_bf16(v0[0], v0[1]); w.y = cvt_pk_bf16(v0[2], v0[3]); w.z = cvt_pk_bf16(v1[0], v1[1]); w.w = cvt_pk_bf16(v1[2], v1[3]);
                        *(u32x4*)(rowp + bj * HALF) = w; } }
        } else {
            const int col0 = (u.pn - nb16) * BM + wc * 32 + 8 * fq;
#pragma unroll
            for (int ai = 0; ai < 2; ++ai)
#pragma unroll
                for (int m = 0; m < 4; ++m) { float* rowp = F + (size_t)(row0 + ai * HALF + m * 16) * ldf;
#pragma unroll
                    for (int bj = 0; bj < 2; ++bj) { const int c = col0 + bj * HALF;
                        if (c < fcols) { *(f32x4*)(rowp + c) = acc[ai][bj][m][0]; *(f32x4*)(rowp + c + 4) = acc[ai][bj][m][1]; } } }
        }
    }
};
template <class Epi, class Sched, bool STAMP = false>
__device__ __forceinline__ void gemm_phase(PG8_LAS unsigned char* lds, const Gemm g, const Sched& S, const Epi& E, unsigned long long* stamps) {
    int tid = threadIdx.x; asm volatile("" : "+v"(tid)); const int wid = __builtin_amdgcn_readfirstlane(tid >> 6), lane = tid & 63, wr = wid >> 2, wc = wid & 3, fr = lane & 15, fq = lane >> 4;
    const int K = g.K, nt = K / BK;
    int ts_lo = 0, ts_hi = 0, nts = 0; const unsigned long long rt_entry = STAMP ? (unsigned long long)wall_clock64() : 0ull;
#define PG8_STAMP() do { if (STAMP && wid == 0 && nts < 64) { const unsigned long long _c = (unsigned long long)clock64(); \
        ts_lo = (lane == nts) ? (int)(unsigned)_c : ts_lo; ts_hi = (lane == nts) ? (int)(unsigned)(_c >> 32) : ts_hi; ++nts; } } while (0)
    PG8_STAMP();
    unsigned voffA[2], voffB[2];
#pragma unroll
    for (int i = 0; i < 2; ++i) { int R, C; stage_rc(tid * 16 + i * 8192, R, C); const int Rb = Epi::PERM ? ((R & ~31) + perm32(R & 31)) : R;
        voffA[i] = (unsigned)(R * g.lda + C) * 2u; voffB[i] = (unsigned)(Rb * K + C) * 2u; }
    const size_t kstep = (size_t)(BK * 2);
    const size_t hstep = (size_t)HALF * K * 2;
    const size_t tstep = 2 * hstep; const size_t hstepA = (size_t)HALF * g.lda * 2; const size_t tstepA = 2 * hstepA;
    const unsigned ldsw = (unsigned)wid * 1024u;
    const int aoff = lds_byte(wr * 64 + fr, fq * 8), boff = lds_byte(wc * 32 + fr, fq * 8);
#define PG8_SA(b, h) (((b) * 2 + (h)) * HTB)
#define PG8_SB(b, h) ((4 + (b) * 2 + (h)) * HTB)
#define PG8_STAGE(bufoff, gbase, voff) do { _Pragma("unroll") for (int _i = 0; _i < 2; ++_i) \
        __builtin_amdgcn_global_load_lds((const unsigned*)((const char*)(gbase) + (voff)[_i]), (PG8_LAS unsigned*)(lds + (bufoff) + ldsw + _i * 8192), 16, 0, 0); } while (0)
#define PG8_LDA(dst, b, h) do { _Pragma("unroll") for (int m = 0; m < 4; ++m) _Pragma("unroll") for (int k = 0; k < 2; ++k) dst[m][k] = *(const PG8_LAS bf16x8*)(lds + PG8_SA(b, h) + aoff + m * 2048 + k * 1024); } while (0)
#define PG8_LDB(dst, b, h) do { _Pragma("unroll") for (int n = 0; n < 2; ++n) _Pragma("unroll") for (int k = 0; k < 2; ++k) dst[n][k] = *(const PG8_LAS bf16x8*)(lds + PG8_SB(b, h) + boff + n * 2048 + k * 1024); } while (0)
#define PG8_MMA(ai, bj, At, Bt) do { __builtin_amdgcn_s_setprio(1); _Pragma("unroll") for (int m = 0; m < 4; ++m) _Pragma("unroll") for (int n = 0; n < 2; ++n) _Pragma("unroll") for (int k = 0; k < 2; ++k) \
        acc[ai][bj][m][n] = __builtin_amdgcn_mfma_f32_16x16x32_bf16(Bt[n][k], At[m][k], acc[ai][bj][m][n], 0, 0, 0); __builtin_amdgcn_s_setprio(0); } while (0)
#define PG8_WAIT_V(n) asm volatile("s_waitcnt vmcnt(" #n ")" ::: "memory")
#define PG8_WAIT_L(n) asm volatile("s_waitcnt lgkmcnt(" #n ")" ::: "memory")
#define PG8_BAR __builtin_amdgcn_s_barrier()
#define PG8_SCHED __builtin_amdgcn_sched_barrier(0)
    Unit cur, nxt; int ui = 0;
    if (!S.next(0, cur)) return;
    f32x4 acc[2][2][4][2];
#pragma unroll
    for (int a = 0; a < 2; ++a)
#pragma unroll
        for (int b = 0; b < 2; ++b)
#pragma unroll
            for (int m = 0; m < 4; ++m)
#pragma unroll
                for (int n = 0; n < 2; ++n) acc[a][b][m][n] = (f32x4){0.f, 0.f, 0.f, 0.f};
    bf16x8 At[4][2], B0[2][2], B1[2][2];
    const char* cA = (const char*)g.A + (size_t)cur.pm * tstepA; const char* cB = (const char*)g.Bt + (size_t)cur.pn * tstep;
    S.a_ready(cur);
    PG8_STAGE(PG8_SB(0, 0), cB, voffB); PG8_STAGE(PG8_SA(0, 0), cA, voffA); PG8_STAGE(PG8_SB(0, 1), cB + hstep, voffB); PG8_STAGE(PG8_SA(0, 1), cA + hstepA, voffA);
    if (wr == 1) PG8_BAR;
    PG8_WAIT_V(4); PG8_BAR;
    PG8_STAGE(PG8_SB(1, 0), cB + kstep, voffB); PG8_STAGE(PG8_SA(1, 0), cA + kstep, voffA); PG8_STAGE(PG8_SB(1, 1), cB + hstep + kstep, voffB);
    PG8_WAIT_V(6); PG8_BAR;
    PG8_STAMP();
    for (;;) {
        const bool has_next = S.next(ui + 1, nxt);
        const char* nA = has_next ? (const char*)g.A + (size_t)nxt.pm * tstepA : cA; const char* nB = has_next ? (const char*)g.Bt + (size_t)nxt.pn * tstep : cB;
        for (int t = 0; t < nt; t += 2) {
            const bool last = (t == nt - 2);
            const char* a1 = cA + (size_t)(t + 1) * kstep;
            const char* a2 = last ? nA : cA + (size_t)(t + 2) * kstep; const char* b2 = last ? nB : cB + (size_t)(t + 2) * kstep;
            const char* a3 = a2 + kstep; const char* b3 = b2 + kstep;
            if (last && has_next) S.a_ready(nxt);
            PG8_LDB(B0, 0, 0); PG8_SCHED; PG8_LDA(At, 0, 0); PG8_STAGE(PG8_SA(1, 1), a1 + hstepA, voffA);
            PG8_WAIT_L(8); PG8_BAR; PG8_WAIT_L(0); PG8_MMA(0, 0, At, B0); PG8_BAR; PG8_SCHED;
            PG8_LDB(B1, 0, 1); PG8_STAGE(PG8_SB(0, 0), b2, voffB);
            PG8_BAR; PG8_WAIT_L(0); PG8_MMA(0, 1, At, B1); PG8_BAR;
            PG8_LDA(At, 0, 1); PG8_STAGE(PG8_SA(0, 0), a2, voffA);
            PG8_BAR; PG8_WAIT_L(0); PG8_MMA(1, 0, At, B0); PG8_BAR; PG8_SCHED;
            PG8_STAGE(PG8_SB(0, 1), b2 + hstep, voffB);
            PG8_WAIT_V(6); PG8_BAR; PG8_MMA(1, 1, At, B1); PG8_BAR;
            PG8_LDB(B0, 1, 0); PG8_SCHED; PG8_LDA(At, 1, 0); PG8_STAGE(PG8_SA(0, 1), a2 + hstepA, voffA);
            PG8_WAIT_L(8); PG8_BAR; PG8_WAIT_L(0); PG8_MMA(0, 0, At, B0); PG8_BAR; PG8_SCHED;
            PG8_LDB(B1, 1, 1); PG8_STAGE(PG8_SB(1, 0), b3, voffB);
            PG8_BAR; PG8_WAIT_L(0); PG8_MMA(0, 1, At, B1); PG8_BAR;
            PG8_LDA(At, 1, 1); PG8_STAGE(PG8_SA(1, 0), a3, voffA);
            PG8_BAR; PG8_WAIT_L(0); PG8_MMA(1, 0, At, B0); PG8_BAR; PG8_SCHED;
            PG8_STAGE(PG8_SB(1, 1), b3 + hstep, voffB);
            PG8_WAIT_V(6); PG8_BAR; PG8_MMA(1, 1, At, B1); PG8_BAR;
        }
        PG8_STAMP();
        if constexpr (!Epi::AFTER_DRAIN) { E(acc, cur, wr, wc, fr, fq); S.done(cur); }
        PG8_STAMP();
        if (!has_next) break;
#pragma unroll
        for (int a = 0; a < 2; ++a)
#pragma unroll
            for (int b = 0; b < 2; ++b)
#pragma unroll
                for (int m = 0; m < 4; ++m)
#pragma unroll
                    for (int n = 0; n < 2; ++n) acc[a][b][m][n] = (f32x4){0.f, 0.f, 0.f, 0.f};
        cur = nxt; cA = nA; cB = nB; ++ui;
    }
    PG8_WAIT_V(0);
    if (wr == 0) PG8_BAR;
    PG8_BAR;
    if constexpr (Epi::AFTER_DRAIN) { E.fused(acc, cur, wr, wc, fr, fq, lds, wid, lane); S.done(cur); }
    PG8_STAMP();
    if (STAMP && wid == 0) { stamps[lane] = lane < nts ? (((unsigned long long)(unsigned)ts_hi << 32) | (unsigned)ts_lo) : 0ull;
        if (lane == 62) stamps[62] = rt_entry; if (lane == 63) stamps[63] = (unsigned long long)wall_clock64(); }
#undef PG8_STAMP
#undef PG8_SA
#undef PG8_SB
#undef PG8_STAGE
#undef PG8_LDA
#undef PG8_LDB
#undef PG8_MMA
#undef PG8_WAIT_V
#undef PG8_WAIT_L
#undef PG8_BAR
#undef PG8_SCHED
}
}
using pg8::bf16_t; using pg8::bf16x8; using pg8::f32x4; using pg8::u32x4;
#define LAS __attribute__((address_space(3)))
typedef short s16x4 __attribute__((ext_vector_type(4)));
typedef float f32x16 __attribute__((ext_vector_type(16)));
typedef unsigned u32x2 __attribute__((ext_vector_type(2)));
typedef LAS unsigned char* ldsp;

constexpr int MT = 32768, DM = 1024, SEQ = 8192, DFF = 2816, NTHR = 512;
constexpr int LDS_BYTES = 155648;
constexpr float ALPHA = 1.6817928305074290f;
constexpr float LN_EPS = 1e-5f, RMS_EPS = 1e-6f;
constexpr size_t WL_F1IN = 0, WL_F1OUT = 11534336, WL_F2IN = 17301504, WL_F2OUT = 28835840, WL_MIX = 34603008, WL_SIZE = 49807360;
constexpr size_t WM_AIN = 0, WM_UK = 4194304, WM_UV = 4718592, WM_AOUT = 5242880;
constexpr size_t WM_SIN = 0, WM_SOUT = 11010048;
constexpr size_t WS_WL = 4096, WS_XB = WS_WL + WL_SIZE, WS_TMP = WS_XB + 67108864;
constexpr size_t T_H = 0;
constexpr size_t T_QB = 0, T_CKV = 117440512, T_CKVN = 150994944, T_IDX = 167772160, T_O = 184549376;
constexpr size_t T_ZX = 0, T_DT = 335544320, T_SSQ = 339738624;
constexpr size_t WS_END = WS_TMP + 340262912;
constexpr int QBLD = 1792, ZXLD = 5120;

struct Params {
    const float* in[20]; float* out; unsigned char* ws;
};

__device__ __forceinline__ int obx() { int b = blockIdx.x; asm volatile("" : "+s"(b)); return b; }
__device__ __forceinline__ int ogd() { int b = gridDim.x; asm volatile("" : "+s"(b)); return b; }
#define AS4 __attribute__((address_space(4)))
__device__ __forceinline__ Params load_params() {
    Params q; const AS4 unsigned long long* kp = (const AS4 unsigned long long*)__builtin_amdgcn_kernarg_segment_ptr(); asm volatile("" : "+s"(kp));
#pragma unroll
    for (int i = 0; i < 20; ++i) q.in[i] = (const float*)(const __attribute__((address_space(1))) float*)kp[i];
    q.out = (float*)(__attribute__((address_space(1))) float*)kp[20]; q.ws = (unsigned char*)(__attribute__((address_space(1))) unsigned char*)kp[21]; return q; }
__device__ __forceinline__ int otid() { int t = threadIdx.x; asm volatile("" : "+v"(t)); return t; }
__device__ __forceinline__ float bf2f(unsigned v) { return __uint_as_float(v << 16); }
__device__ __forceinline__ float bflo(unsigned v) { return __uint_as_float(v << 16); }
__device__ __forceinline__ float bfhi(unsigned v) { return __uint_as_float(v & 0xFFFF0000u); }
__device__ __forceinline__ unsigned pk2(float a, float b) { return pg8::cvt_pk_bf16(a, b); }
__device__ __forceinline__ float wave_sum(float v) {
#pragma unroll
    for (int d = 32; d >= 1; d >>= 1) v += __shfl_xor(v, d);
    return v;
}
__device__ __forceinline__ f32x4 mfma16(bf16x8 a, bf16x8 b, f32x4 c) { return __builtin_amdgcn_mfma_f32_16x16x32_bf16(a, b, c, 0, 0, 0); }
__device__ __forceinline__ bf16x8 ld_lds128(ldsp p) { return *(LAS const bf16x8*)p; }

__device__ __forceinline__ int map_col(int kind, int j, int nsrc) {
    if (kind == 0) return j < nsrc ? j : -1;
    if (kind == 1) { const int pn = j >> 8, bj = (j >> 7) & 1, i = j & 127; return bj * DFF + pn * 128 + i; }
    if (j < 1024) return j;
    if (j < 1536) return j - 1024 + 1280;
    if (j < 1600) return j - 1536 + 1792;
    if (j < 1608) return j - 1600 + 1856;
    if (j < 1792) return -1;
    return j - 1792 + 1024;
}
__device__ __forceinline__ void conv_job(ldsp lds, const float* src, bf16_t* dst, int K, int nsrc, int ndst, int kind, const float* kscale) {
    LAS float* tile = (LAS float*)lds;
    const int tid = otid(), ntk = K >> 6, ntiles = (ndst >> 6) * ntk;
    for (int t = obx(); t < ntiles; t += ogd()) {
        const int j0 = (t / ntk) << 6, k0 = (t % ntk) << 6;
#pragma unroll
        for (int e = 0; e < 8; ++e) { const int idx = tid + e * NTHR, kk = idx >> 6, jj = idx & 63; const int c = map_col(kind, j0 + jj, nsrc);
            float v = c >= 0 ? src[(size_t)(k0 + kk) * nsrc + c] : 0.f; if (kscale) v *= kscale[k0 + kk]; tile[kk * 65 + jj] = v; }
        __syncthreads();
        { const int jj = tid >> 3, kc = tid & 7; u32x4 w;
          w.x = pk2(tile[(kc * 8 + 0) * 65 + jj], tile[(kc * 8 + 1) * 65 + jj]); w.y = pk2(tile[(kc * 8 + 2) * 65 + jj], tile[(kc * 8 + 3) * 65 + jj]);
          w.z = pk2(tile[(kc * 8 + 4) * 65 + jj], tile[(kc * 8 + 5) * 65 + jj]); w.w = pk2(tile[(kc * 8 + 6) * 65 + jj], tile[(kc * 8 + 7) * 65 + jj]);
          *(u32x4*)(dst + (size_t)(j0 + jj) * K + k0 + kc * 8) = w; }
        __syncthreads();
    }
}
__device__ __forceinline__ void convert_layer(ldsp lds, const Params& p, int L) {
    unsigned char* wl = p.ws + WS_WL;
    conv_job(lds, p.in[3] + (size_t)L * 1024 * 5632, (bf16_t*)(wl + WL_F1IN), 1024, 5632, 5632, 1, nullptr);
    conv_job(lds, p.in[4] + (size_t)L * 2816 * 1024, (bf16_t*)(wl + WL_F1OUT), 2816, 1024, 1024, 0, nullptr);
    conv_job(lds, p.in[5] + (size_t)L * 1024 * 5632, (bf16_t*)(wl + WL_F2IN), 1024, 5632, 5632, 1, nullptr);
    conv_job(lds, p.in[6] + (size_t)L * 2816 * 1024, (bf16_t*)(wl + WL_F2OUT), 2816, 1024, 1024, 0, nullptr);
    const int j = L >> 1;
    if ((L & 1) == 0) {
        conv_job(lds, p.in[7] + (size_t)j * 1024 * 1864, (bf16_t*)(wl + WL_MIX + WM_AIN), 1024, 1864, 2048, 2, nullptr);
        for (int h = 0; h < 16; ++h) {
            conv_job(lds, p.in[9] + ((size_t)j * 16 + h) * 64 * 256, (bf16_t*)(wl + WL_MIX + WM_UK) + (size_t)h * 256 * 64, 64, 256, 256, 0, nullptr);
            conv_job(lds, p.in[10] + ((size_t)j * 16 + h) * 256 * 64, (bf16_t*)(wl + WL_MIX + WM_UV) + (size_t)h * 64 * 256, 256, 64, 64, 0, nullptr);
        }
        conv_job(lds, p.in[11] + (size_t)j * 1024 * 1024, (bf16_t*)(wl + WL_MIX + WM_AOUT), 1024, 1024, 1024, 0, nullptr);
    } else {
        conv_job(lds, p.in[12] + (size_t)j * 1024 * 5152, (bf16_t*)(wl + WL_MIX + WM_SIN), 1024, 5152, 5376, 0, nullptr);
        conv_job(lds, p.in[19] + (size_t)j * 2048 * 1024, (bf16_t*)(wl + WL_MIX + WM_SOUT), 2048, 1024, 1024, 0, p.in[18] + (size_t)j * 2048);
    }
}

__device__ __forceinline__ void ln_phase(float* x, bf16_t* xb, const float* g, const float* b) {
    const int tid_ = otid(); const int lane = tid_ & 63, gw = obx() * 8 + (tid_ >> 6), nw = ogd() * 8;
    for (int row = gw; row < MT; row += nw) {
        float* xr = x + (size_t)row * DM; f32x4 v[4]; float s = 0.f;
#pragma unroll
        for (int i = 0; i < 4; ++i) { v[i] = *(const f32x4*)(xr + i * 256 + lane * 4); s += v[i][0] + v[i][1] + v[i][2] + v[i][3]; }
        const float mu = wave_sum(s) * (1.0f / DM); float q = 0.f;
#pragma unroll
        for (int i = 0; i < 4; ++i) { v[i] = v[i] - mu; q += v[i][0] * v[i][0] + v[i][1] * v[i][1] + v[i][2] * v[i][2] + v[i][3] * v[i][3]; }
        const float rs = rsqrtf(wave_sum(q) * (1.0f / DM) + LN_EPS);
#pragma unroll
        for (int i = 0; i < 4; ++i) { const int c = i * 256 + lane * 4; const f32x4 gg = *(const f32x4*)(g + c), bb = *(const f32x4*)(b + c); const f32x4 o = v[i] * rs * gg + bb;
            *(f32x4*)(xr + c) = o; u32x2 w; w.x = pk2(o[0], o[1]); w.y = pk2(o[2], o[3]); *(u32x2*)(xb + (size_t)row * DM + c) = w; }
    }
}
__device__ __forceinline__ void cvt_x_phase(const float* x, bf16_t* xb) {
    const size_t n8 = (size_t)MT * DM / 8;
    for (size_t i = (size_t)obx() * NTHR + threadIdx.x; i < n8; i += (size_t)ogd() * NTHR) {
        const f32x4 a = *(const f32x4*)(x + i * 8), b = *(const f32x4*)(x + i * 8 + 4); u32x4 w;
        w.x = pk2(a[0], a[1]); w.y = pk2(a[2], a[3]); w.z = pk2(b[0], b[1]); w.w = pk2(b[2], b[3]); *(u32x4*)(xb + i * 8) = w; }
}

__device__ __forceinline__ void ckv_norm_phase(const float* ckv, bf16_t* ckvn, const float* g) {
    const int tid_ = otid(); const int lane = tid_ & 63, gw = obx() * 8 + (tid_ >> 6), nw = ogd() * 8;
    const f32x4 gg = *(const f32x4*)(g + lane * 4);
    for (int row = gw; row < MT; row += nw) {
        const f32x4 v = *(const f32x4*)(ckv + (size_t)row * 256 + lane * 4);
        const float ms = wave_sum(v[0] * v[0] + v[1] * v[1] + v[2] * v[2] + v[3] * v[3]) * (1.0f / 256.0f);
        const float rs = rsqrtf(ms + RMS_EPS); const f32x4 o = v * rs * gg; u32x2 w; w.x = pk2(o[0], o[1]); w.y = pk2(o[2], o[3]);
        *(u32x2*)(ckvn + (size_t)row * 256 + lane * 4) = w; }
}

__device__ __forceinline__ unsigned f2key(float s) { const unsigned u = __float_as_uint(s); return (u & 0x80000000u) ? ~u : (u | 0x80000000u); }
__device__ __forceinline__ void find_bin(ldsp hq, unsigned need, unsigned& bin, unsigned& newneed) {
    const int lane = otid() & 63;
    u32x4 w[4];
#pragma unroll
    for (int i = 0; i < 4; ++i) w[i] = *(LAS const u32x4*)(hq + lane * 64 + i * 16);
    unsigned sum = 0;
#pragma unroll
    for (int i = 0; i < 4; ++i)
#pragma unroll
        for (int k = 0; k < 4; ++k) sum += (w[i][k] & 0xFFFFu) + (w[i][k] >> 16);
    unsigned suf = sum;
#pragma unroll
    for (int d = 1; d < 64; d <<= 1) { const unsigned t = __shfl_down(suf, d); if (lane + d < 64) suf += t; }
    const unsigned above = suf - sum;
    const bool mine = (above < need) && (need <= suf);
    unsigned cum = above, fb = 0, fn = 0; bool found = false;
#pragma unroll
    for (int i = 3; i >= 0; --i)
#pragma unroll
        for (int k = 3; k >= 0; --k) {
            const unsigned hi16 = w[i][k] >> 16, lo16 = w[i][k] & 0xFFFFu; const int wi = i * 4 + k;
            if (!found && cum + hi16 >= need) { fb = lane * 32 + wi * 2 + 1; fn = need - cum; found = true; } cum += hi16;
            if (!found && cum + lo16 >= need) { fb = lane * 32 + wi * 2; fn = need - cum; found = true; } cum += lo16; }
    const unsigned long long bal = __ballot(mine);
    const int src = bal ? (int)__builtin_ctzll(bal) : 0;
    bin = __shfl(fb, src); newneed = __shfl(fn, src);
}

__device__ __forceinline__ void indexer_item(ldsp lds, const bf16_t* QB, unsigned short* IDX, int b, int qt) {
    const int tid = otid(), lane = tid & 63, wid = tid >> 6, c = lane & 31, hi = lane >> 5;
    const int q0 = qt * 32; const size_t tb = (size_t)b * SEQ;
    const int posb = q0 + 4 * wid + 2 * hi;
#ifdef IDX_SIMPLE
    if (true) {
#else
    if (q0 < 256) {
#endif
        for (int tq = 0; tq < 4; ++tq) { const int pos = q0 + 4 * wid + tq; unsigned short* o = IDX + (tb + pos) * 256;
#pragma unroll
            for (int k = 0; k < 4; ++k) { const int j = lane * 4 + k; o[j] = (unsigned short)(j <= pos ? j : 0xFFFF); } }
        return;
    }
    ldsp hist = lds + wid * 16384;
    ldsp kbuf = lds + 131072;
    bf16x8 af[4];
    { const int r = c, tk = ((r >> 2) & 1) * 2 + (r & 1), hd = (r >> 3) * 2 + ((r >> 1) & 1);
      const bf16_t* qp = QB + (tb + q0 + 4 * wid + tk) * QBLD + 1024 + hd * 64 + hi * 8;
#pragma unroll
      for (int ks = 0; ks < 4; ++ks) af[ks] = *(const bf16x8*)(qp + ks * 16); }
    float wq[2][8];
#pragma unroll
    for (int e = 0; e < 2; ++e) { const u32x4 wv = *(const u32x4*)(QB + (tb + posb + e) * QBLD + 1600);
#pragma unroll
        for (int k = 0; k < 4; ++k) { wq[e][2 * k] = bflo(wv[k]) * 0.04419417382415922f; wq[e][2 * k + 1] = bfhi(wv[k]) * 0.04419417382415922f; } }
    const int nch = (q0 + 32 + 63) >> 6;
    const bf16_t* kg = QB + (tb + (tid >> 3)) * QBLD + 1536 + (tid & 7) * 8;
    const int kst = (tid >> 3) * 144 + (tid & 7) * 16;
    unsigned pre[2] = {0u, 0u}, need[2] = {256u, 256u};
    unsigned cnt[2] = {0u, 0u}, tie[2] = {0u, 0u};
    for (int pass = 0; pass < 4; ++pass) {
        if (pass < 3) {
#pragma unroll
            for (int i = 0; i < 16; ++i) *(LAS u32x4*)(hist + i * 1024 + lane * 16) = (u32x4){0u, 0u, 0u, 0u};
        }
        __syncthreads();
        u32x4 kr = *(const u32x4*)kg;
        *(LAS u32x4*)(kbuf + kst) = kr;
        __syncthreads();
        for (int ch = 0; ch < nch; ++ch) {
            if (ch + 1 < nch) kr = *(const u32x4*)(kg + (size_t)(ch + 1) * 64 * QBLD);
            ldsp kb = kbuf + (ch & 1) * 9216;
#pragma unroll
            for (int ts = 0; ts < 2; ++ts) {
                f32x16 acc;
#pragma unroll
                for (int i = 0; i < 16; ++i) acc[i] = 0.f;
#pragma unroll
                for (int ks = 0; ks < 4; ++ks) { const bf16x8 bf = ld_lds128(kb + (ts * 32 + c) * 144 + ks * 32 + hi * 16); acc = __builtin_amdgcn_mfma_f32_32x32x16_bf16(af[ks], bf, acc, 0, 0, 0); }
                const int key = ch * 64 + ts * 32 + c;
#pragma unroll
                for (int e = 0; e < 2; ++e) {
                    float s = 0.f;
#pragma unroll
                    for (int h = 0; h < 8; ++h) s = fmaf(wq[e][h], fmaxf(acc[2 * h + e], 0.f), s);
                    s += 0.0f;
                    const unsigned u = f2key(s); const bool valid = key <= posb + e;
                    if (pass == 0) { if (valid) { const unsigned bin = u >> 21; __hip_atomic_fetch_add((LAS unsigned*)(hist + (2 * hi + e) * 4096 + (bin >> 1) * 4), 1u << ((bin & 1) * 16), __ATOMIC_RELAXED, __HIP_MEMORY_SCOPE_WORKGROUP); } }
                    else if (pass == 1) { if (valid && (u >> 21) == pre[e]) { const unsigned bin = (u >> 10) & 0x7FFu; __hip_atomic_fetch_add((LAS unsigned*)(hist + (2 * hi + e) * 4096 + (bin >> 1) * 4), 1u << ((bin & 1) * 16), __ATOMIC_RELAXED, __HIP_MEMORY_SCOPE_WORKGROUP); } }
                    else if (pass == 2) { if (valid && (u >> 10) == pre[e]) { const unsigned bin = u & 0x3FFu; __hip_atomic_fetch_add((LAS unsigned*)(hist + (2 * hi + e) * 4096 + (bin >> 1) * 4), 1u << ((bin & 1) * 16), __ATOMIC_RELAXED, __HIP_MEMORY_SCOPE_WORKGROUP); } }
                    else {
                        const bool gt = valid && (u > pre[e]), eq = valid && (u == pre[e]);
                        const unsigned long long beq = __ballot(eq); const unsigned meq = hi ? (unsigned)(beq >> 32) : (unsigned)beq;
                        const unsigned below = (1u << c) - 1u;
                        const bool emit = gt || (eq && (tie[e] + __popc(meq & below) < need[e]));
                        tie[e] += __popc(meq);
                        const unsigned long long bem = __ballot(emit); const unsigned mem = hi ? (unsigned)(bem >> 32) : (unsigned)bem;
                        const unsigned slot = cnt[e] + __popc(mem & below);
                        if (emit && slot < 256u) IDX[(tb + posb + e) * 256 + slot] = (unsigned short)key;
                        cnt[e] += __popc(mem);
                    }
                }
            }
            if (ch + 1 < nch) *(LAS u32x4*)(kbuf + ((ch + 1) & 1) * 9216 + kst) = kr;
            __syncthreads();
        }
        if (pass < 3) {
            unsigned nb[4], nn[4];
#pragma unroll
            for (int tq = 0; tq < 4; ++tq) {
                const unsigned nd = __shfl(need[tq & 1], (tq >> 1) * 32);
                find_bin(hist + tq * 4096, nd, nb[tq], nn[tq]); }
#pragma unroll
            for (int e = 0; e < 2; ++e) { const unsigned bsel = hi ? nb[2 + e] : nb[e], nsel = hi ? nn[2 + e] : nn[e];
                pre[e] = (pass == 0) ? bsel : (pass == 1 ? ((pre[e] << 11) | bsel) : ((pre[e] << 10) | bsel)); need[e] = nsel; }
        }
    }
}
__device__ __forceinline__ void indexer_phase(ldsp lds, const Params& p) {
    const bf16_t* QB = (const bf16_t*)(p.ws + WS_TMP + T_QB); unsigned short* IDX = (unsigned short*)(p.ws + WS_TMP + T_IDX);
    for (int s = obx(); s < 256; s += ogd()) {
        const int b = s >> 6, j = s & 63;
        indexer_item(lds, QB, IDX, b, 255 - j); __syncthreads();
        indexer_item(lds, QB, IDX, b, 128 + j); __syncthreads();
        indexer_item(lds, QB, IDX, b, 127 - j); __syncthreads();
        indexer_item(lds, QB, IDX, b, j); __syncthreads();
    }
}

__device__ __forceinline__ s16x4 tr_read(ldsp p) { typedef short v4i16_t __attribute__((ext_vector_type(4))); return __builtin_bit_cast(s16x4, __builtin_amdgcn_ds_read_tr16_b64_v4i16((LAS v4i16_t*)p)); }
constexpr int XS = 528, CS = 544;
__device__ __forceinline__ void sattn_step(ldsp lds, const Params& p, int b, int si) {
    const int tid = otid(), lane = tid & 63, wid = tid >> 6, fr = lane & 15, g = lane >> 4;
    const bf16_t* QB = (const bf16_t*)(p.ws + WS_TMP + T_QB); const bf16_t* CKVN = (const bf16_t*)(p.ws + WS_TMP + T_CKVN);
    const unsigned short* IDX = (const unsigned short*)(p.ws + WS_TMP + T_IDX); bf16_t* O = (bf16_t*)(p.ws + WS_TMP + T_O);
    const bf16_t* WUK = (const bf16_t*)(p.ws + WS_WL + WL_MIX + WM_UK); const bf16_t* WUV = (const bf16_t*)(p.ws + WS_WL + WL_MIX + WM_UV);
    const size_t tb = (size_t)b * SEQ; const int p0 = si * 8; const size_t t0 = tb + p0;
    ldsp X = lds; ldsp Cw = lds + wid * (32 * CS); ldsp IL = lds + 8 * 32 * CS + wid * 512;
#pragma unroll 1
    for (int hh = 0; hh < 2; ++hh) { const int h = wid * 2 + hh;
        bf16x8 bq[2]; { const bf16_t* qp = QB + (t0 + (fr & 7)) * QBLD + h * 64 + g * 8; bq[0] = *(const bf16x8*)qp; bq[1] = *(const bf16x8*)(qp + 32); }
#pragma unroll 4
        for (int rt = 0; rt < 16; ++rt) {
            const bf16_t* wp = WUK + ((size_t)(h * 256 + rt * 16 + fr)) * 64 + g * 8;
            f32x4 acc = {0.f, 0.f, 0.f, 0.f};
            acc = mfma16(*(const bf16x8*)wp, bq[0], acc); acc = mfma16(*(const bf16x8*)(wp + 32), bq[1], acc);
            if (fr < 8) { u32x2 w; w.x = pk2(acc[0], acc[1]); w.y = pk2(acc[2], acc[3]); *(LAS u32x2*)(X + (fr * 16 + h) * XS + (rt * 16 + 4 * g) * 2) = w; } } }
    { const u32x2 iv = *(const u32x2*)(IDX + (t0 + wid) * 256 + lane * 4); *(LAS u32x2*)(IL + lane * 8) = iv; }
    __syncthreads();
    bf16x8 qa[8];
#pragma unroll
    for (int ks = 0; ks < 8; ++ks) qa[ks] = ld_lds128(X + (wid * 16 + fr) * XS + ks * 64 + g * 16);
    __syncthreads();
    const int pos = p0 + wid;
    f32x4 o[16];
#pragma unroll
    for (int i = 0; i < 16; ++i) o[i] = (f32x4){0.f, 0.f, 0.f, 0.f};
    float mrun = -INFINITY, lsum = 0.f;
#pragma unroll 1
    for (int kt = 0; kt < 8; ++kt) {
#pragma unroll
        for (int hf = 0; hf < 2; ++hf) { u32x4 gv[8];
#pragma unroll
          for (int i = 0; i < 8; ++i) { const int row = (hf * 8 + i) * 2 + (lane >> 5); const int key = *(LAS const unsigned short*)(IL + (kt * 32 + row) * 2);
              const int kc = key <= pos ? key : 0; gv[i] = *(const u32x4*)(CKVN + (tb + kc) * 256 + (lane & 31) * 8); }
#pragma unroll
          for (int i = 0; i < 8; ++i) { const int row = (hf * 8 + i) * 2 + (lane >> 5); *(LAS u32x4*)(Cw + row * CS + (lane & 31) * 16) = gv[i]; }
          __builtin_amdgcn_sched_barrier(0); }
        f32x4 s0 = {0.f, 0.f, 0.f, 0.f}, s1 = {0.f, 0.f, 0.f, 0.f};
#pragma unroll
        for (int ks = 0; ks < 8; ++ks) { s0 = mfma16(ld_lds128(Cw + fr * CS + ks * 64 + g * 16), qa[ks], s0); s1 = mfma16(ld_lds128(Cw + (16 + fr) * CS + ks * 64 + g * 16), qa[ks], s1); }
        const u32x2 k0 = *(LAS const u32x2*)(IL + (kt * 32 + 4 * g) * 2), k1 = *(LAS const u32x2*)(IL + (kt * 32 + 16 + 4 * g) * 2);
        float sv[8];
        sv[0] = (int)(k0.x & 0xFFFFu) <= pos ? s0[0] * 0.125f : -INFINITY; sv[1] = (int)(k0.x >> 16) <= pos ? s0[1] * 0.125f : -INFINITY;
        sv[2] = (int)(k0.y & 0xFFFFu) <= pos ? s0[2] * 0.125f : -INFINITY; sv[3] = (int)(k0.y >> 16) <= pos ? s0[3] * 0.125f : -INFINITY;
        sv[4] = (int)(k1.x & 0xFFFFu) <= pos ? s1[0] * 0.125f : -INFINITY; sv[5] = (int)(k1.x >> 16) <= pos ? s1[1] * 0.125f : -INFINITY;
        sv[6] = (int)(k1.y & 0xFFFFu) <= pos ? s1[2] * 0.125f : -INFINITY; sv[7] = (int)(k1.y >> 16) <= pos ? s1[3] * 0.125f : -INFINITY;
        float tm = fmaxf(fmaxf(fmaxf(sv[0], sv[1]), fmaxf(sv[2], sv[3])), fmaxf(fmaxf(sv[4], sv[5]), fmaxf(sv[6], sv[7])));
        tm = fmaxf(tm, __shfl_xor(tm, 16)); tm = fmaxf(tm, __shfl_xor(tm, 32));
        const float mnew = fmaxf(mrun, tm); const float sc = __expf(mrun - mnew); mrun = mnew;
        float ps = 0.f;
#pragma unroll
        for (int i = 0; i < 8; ++i) { sv[i] = __expf(sv[i] - mnew); ps += sv[i]; }
        lsum = lsum * sc + ps;
#pragma unroll
        for (int i = 0; i < 16; ++i) o[i] = o[i] * sc;
        union { bf16x8 v; unsigned u[4]; } pb; pb.u[0] = pk2(sv[0], sv[1]); pb.u[1] = pk2(sv[2], sv[3]); pb.u[2] = pk2(sv[4], sv[5]); pb.u[3] = pk2(sv[6], sv[7]);
        ldsp tra = Cw + (4 * g + (fr >> 2)) * CS + (fr & 3) * 8;
#pragma unroll
        for (int rt = 0; rt < 16; ++rt) {
#ifndef NO_TR
            const s16x4 lo = tr_read(tra + rt * 32), hi4 = tr_read(tra + 16 * CS + rt * 32);
            bf16x8 a; a[0] = lo[0]; a[1] = lo[1]; a[2] = lo[2]; a[3] = lo[3]; a[4] = hi4[0]; a[5] = hi4[1]; a[6] = hi4[2]; a[7] = hi4[3];
#else
            bf16x8 a;
#pragma unroll
            for (int j = 0; j < 8; ++j) a[j] = *(LAS const short*)(Cw + ((j < 4 ? 4 * g + j : 16 + 4 * g + (j - 4))) * CS + (rt * 16 + fr) * 2);
#endif
            o[rt] = mfma16(a, pb.v, o[rt]); if ((rt & 3) == 3) __builtin_amdgcn_sched_barrier(0); }
    }
    lsum += __shfl_xor(lsum, 16); lsum += __shfl_xor(lsum, 32);
    const float inv = 1.0f / lsum;
    __syncthreads();
#pragma unroll
    for (int rt = 0; rt < 16; ++rt) { u32x2 w; w.x = pk2(o[rt][0] * inv, o[rt][1] * inv); w.y = pk2(o[rt][2] * inv, o[rt][3] * inv);
        *(LAS u32x2*)(X + (wid * 16 + fr) * XS + (rt * 16 + 4 * g) * 2) = w; }
    __syncthreads();
#pragma unroll 1
    for (int hh = 0; hh < 2; ++hh) { const int h = wid * 2 + hh;
        bf16x8 ao[8];
#pragma unroll
        for (int ks = 0; ks < 8; ++ks) ao[ks] = ld_lds128(X + ((fr & 7) * 16 + h) * XS + ks * 64 + g * 16);
#pragma unroll 1
        for (int dt = 0; dt < 4; ++dt) {
            const bf16_t* wp = WUV + ((size_t)(h * 64 + dt * 16 + fr)) * 256 + g * 8;
            f32x4 acc = {0.f, 0.f, 0.f, 0.f};
#pragma unroll
            for (int ks = 0; ks < 8; ++ks) acc = mfma16(ao[ks], *(const bf16x8*)(wp + ks * 32), acc);
            if (g < 2) {
#pragma unroll
                for (int j = 0; j < 4; ++j) {
#ifdef SANITIZE_O
                    if (!(fabsf(acc[j]) < 1e30f)) acc[j] = 0.f;
#endif
                    O[(t0 + 4 * g + j) * 1024 + h * 64 + dt * 16 + fr] = (bf16_t)(pk2(acc[j], 0.f) & 0xFFFFu); } } } }
    __syncthreads();
}
__device__ __forceinline__ void sattn_phase(ldsp lds, const Params& p) {
    const int G = ogd(), bx = obx();
    if ((G & 7) == 0) {
        const int b = (bx & 7) >> 1, wb = (bx >> 3) * 2 + (bx & 1), nwb = G >> 2;
        for (int si = wb; si < 1024; si += nwb) sattn_step(lds, p, b, si);
    } else {
        for (int s = bx; s < 4096; s += G) sattn_step(lds, p, s >> 10, s & 1023);
    }
}

constexpr int RS = 272;
__device__ __forceinline__ void conv8(const u32x4 (&raw)[7], const float* cw, const float* cb, int c0, float (&out)[4][8]) {
    float w[4][8], bias[8];
#pragma unroll
    for (int k = 0; k < 4; ++k) { const f32x4 a = *(const f32x4*)(cw + k * 3072 + c0), b = *(const f32x4*)(cw + k * 3072 + c0 + 4);
        w[k][0] = a[0]; w[k][1] = a[1]; w[k][2] = a[2]; w[k][3] = a[3]; w[k][4] = b[0]; w[k][5] = b[1]; w[k][6] = b[2]; w[k][7] = b[3]; }
    { const f32x4 a = *(const f32x4*)(cb + c0), b = *(const f32x4*)(cb + c0 + 4); bias[0] = a[0]; bias[1] = a[1]; bias[2] = a[2]; bias[3] = a[3]; bias[4] = b[0]; bias[5] = b[1]; bias[6] = b[2]; bias[7] = b[3]; }
#pragma unroll
    for (int li = 0; li < 4; ++li)
#pragma unroll
        for (int i = 0; i < 8; ++i) { float v = bias[i];
#pragma unroll
            for (int k = 0; k < 4; ++k) { const unsigned wv = raw[li + k][i >> 1]; v = fmaf(w[k][i], (i & 1) ? bfhi(wv) : bflo(wv), v); }
            out[li][i] = pg8::silu_f(v); }
}
__device__ __forceinline__ void load7(const bf16_t* ZX, size_t tb, int posl0, int col, u32x4 (&raw)[7]) {
#pragma unroll
    for (int r = 0; r < 7; ++r) { const int pos = posl0 - 3 + r; raw[r] = pos >= 0 ? *(const u32x4*)(ZX + (tb + pos) * ZXLD + col) : (u32x4){0u, 0u, 0u, 0u}; }
}
__device__ __forceinline__ void ssd_item(ldsp lds, const Params& p, int sl, int item) {
    const int tid = otid(), lane = tid & 63, wid = tid >> 6, fr = lane & 15, g = lane >> 4;
    const int b = item >> 6, h = (item >> 1) & 31, ph = item & 1, grp = h >> 3;
    bf16_t* ZX = (bf16_t*)(p.ws + WS_TMP + T_ZX); const float* DT = (const float*)(p.ws + WS_TMP + T_DT); float* SSQ = (float*)(p.ws + WS_TMP + T_SSQ);
    const float* cw = p.in[13] + (size_t)sl * 4 * 3072; const float* cb = p.in[14] + (size_t)sl * 3072;
    const float dtb = p.in[15][sl * 32 + h], av = -__expf(p.in[16][sl * 32 + h]), dsk = p.in[17][sl * 32 + h];
    const size_t tb = (size_t)b * SEQ;
    ldsp Cc = lds, Bc = lds + 34816, BcT = lds + 69632, XdT = lds + 104448, XwT = lds + 113152, Hb = lds + 121856, Xs = lds + 130560;
    LAS float* dtv = (LAS float*)(lds + 140800); LAS float* acs = (LAS float*)(lds + 141312);
    f32x4 hst[2] = {{0.f, 0.f, 0.f, 0.f}, {0.f, 0.f, 0.f, 0.f}};
    for (int i = tid; i < 32 * RS / 4; i += NTHR) ((LAS unsigned*)Hb)[i] = 0u;
    __syncthreads();
#pragma unroll 1
    for (int c = 0; c < 64; ++c) {
        const int cp = c * 128;
        if (wid == 7) {
            const float r0 = DT[(tb + cp + 2 * lane) * 32 + h] + dtb, r1 = DT[(tb + cp + 2 * lane + 1) * 32 + h] + dtb;
            const float d0 = r0 > 20.f ? r0 : log1pf(__expf(r0)), d1 = r1 > 20.f ? r1 : log1pf(__expf(r1));
            const float a0 = d0 * av, a1 = d1 * av; float sc = a0 + a1;
#pragma unroll
            for (int d = 1; d < 64; d <<= 1) { const float t = __shfl_up(sc, d); if (lane >= d) sc += t; }
            dtv[2 * lane] = d0; dtv[2 * lane + 1] = d1; acs[2 * lane] = sc - a1; acs[2 * lane + 1] = sc;
        }
        { const int cgi = tid & 15, l0 = (tid >> 4) * 4;
#pragma unroll 1
          for (int which = 0; which < 2; ++which) {
              const int c0 = 2048 + which * 512 + grp * 128 + cgi * 8;
              u32x4 raw[7]; load7(ZX, tb, cp + l0, 2048 + c0, raw);
              float out[4][8]; conv8(raw, cw, cb, c0, out);
              ldsp dstp = which ? Cc : Bc;
#pragma unroll
              for (int li = 0; li < 4; ++li) { u32x4 w; w.x = pk2(out[li][0], out[li][1]); w.y = pk2(out[li][2], out[li][3]); w.z = pk2(out[li][4], out[li][5]); w.w = pk2(out[li][6], out[li][7]);
                  *(LAS u32x4*)(dstp + (l0 + li) * RS + cgi * 16) = w; }
              if (which == 0) {
#pragma unroll
                  for (int i = 0; i < 8; ++i) { u32x2 w; w.x = pk2(out[0][i], out[1][i]); w.y = pk2(out[2][i], out[3][i]); *(LAS u32x2*)(BcT + (cgi * 8 + i) * RS + l0 * 2) = w; } }
          } }
        __syncthreads();
        const float aend = acs[127];
        if (tid < 128) {
            const int cgx = tid & 3, l0 = (tid >> 2) * 4, c0 = h * 64 + ph * 32 + cgx * 8;
            u32x4 raw[7]; load7(ZX, tb, cp + l0, 2048 + c0, raw);
            float out[4][8]; conv8(raw, cw, cb, c0, out);
            float dl[4], wl[4];
#pragma unroll
            for (int li = 0; li < 4; ++li) { dl[li] = dtv[l0 + li]; wl[li] = dl[li] * __expf(aend - acs[l0 + li]); }
#pragma unroll
            for (int li = 0; li < 4; ++li) { u32x4 w; w.x = pk2(out[li][0], out[li][1]); w.y = pk2(out[li][2], out[li][3]); w.z = pk2(out[li][4], out[li][5]); w.w = pk2(out[li][6], out[li][7]);
                *(LAS u32x4*)(Xs + (l0 + li) * 80 + cgx * 16) = w; }
#pragma unroll
            for (int i = 0; i < 8; ++i) { const int pp = cgx * 8 + i; u32x2 w;
                w.x = pk2(out[0][i] * dl[0], out[1][i] * dl[1]); w.y = pk2(out[2][i] * dl[2], out[3][i] * dl[3]); *(LAS u32x2*)(XdT + pp * RS + l0 * 2) = w;
                w.x = pk2(out[0][i] * wl[0], out[1][i] * wl[1]); w.y = pk2(out[2][i] * wl[2], out[3][i] * wl[3]); *(LAS u32x2*)(XwT + pp * RS + l0 * 2) = w; }
        }
        u32x2 mm[8];
        { bf16x8 a[4];
#pragma unroll
          for (int ks = 0; ks < 4; ++ks) a[ks] = ld_lds128(Bc + (16 * wid + fr) * RS + ks * 64 + g * 16);
          float as4[4];
#pragma unroll
          for (int j = 0; j < 4; ++j) as4[j] = acs[16 * wid + 4 * g + j];
#pragma unroll
          for (int lt = 0; lt < 8; ++lt) {
              mm[lt] = (u32x2){0u, 0u};
              if (lt >= wid) {
                  f32x4 acc = {0.f, 0.f, 0.f, 0.f};
#pragma unroll
                  for (int ks = 0; ks < 4; ++ks) acc = mfma16(a[ks], ld_lds128(Cc + (lt * 16 + fr) * RS + ks * 64 + g * 16), acc);
                  const int l = lt * 16 + fr; const float al = acs[l]; float v[4];
#pragma unroll
                  for (int j = 0; j < 4; ++j) { const int s = 16 * wid + 4 * g + j; v[j] = (s <= l) ? acc[j] * __expf(al - as4[j]) : 0.f; }
                  mm[lt].x = pk2(v[0], v[1]); mm[lt].y = pk2(v[2], v[3]); } } }
        __syncthreads();
#pragma unroll
        for (int lt = 0; lt < 8; ++lt) *(LAS u32x2*)(Bc + (lt * 16 + fr) * RS + (16 * wid + 4 * g) * 2) = mm[lt];
        __syncthreads();
        { f32x4 y1[2] = {{0.f, 0.f, 0.f, 0.f}, {0.f, 0.f, 0.f, 0.f}}, y2[2] = {{0.f, 0.f, 0.f, 0.f}, {0.f, 0.f, 0.f, 0.f}};
          const int l = 16 * wid + fr;
#pragma unroll
          for (int ks = 0; ks < 4; ++ks) {
              const bf16x8 bm = ld_lds128(Bc + l * RS + ks * 64 + g * 16), bc = ld_lds128(Cc + l * RS + ks * 64 + g * 16);
#pragma unroll
              for (int pt = 0; pt < 2; ++pt) { y1[pt] = mfma16(ld_lds128(XdT + (pt * 16 + fr) * RS + ks * 64 + g * 16), bm, y1[pt]); y2[pt] = mfma16(ld_lds128(Hb + (pt * 16 + fr) * RS + ks * 64 + g * 16), bc, y2[pt]); } }
          const float el = __expf(acs[l]); const size_t tg = tb + cp + l; float sq = 0.f;
#pragma unroll
          for (int pt = 0; pt < 2; ++pt) { const int pp = pt * 16 + 4 * g;
              const u32x2 xs2 = *(LAS const u32x2*)(Xs + l * 80 + pp * 2); bf16_t* zp = ZX + tg * ZXLD + h * 64 + ph * 32 + pp; const u32x2 z2 = *(const u32x2*)zp;
              float yv[4], xv[4] = {bflo(xs2.x), bfhi(xs2.x), bflo(xs2.y), bfhi(xs2.y)}, zv[4] = {bflo(z2.x), bfhi(z2.x), bflo(z2.y), bfhi(z2.y)};
#pragma unroll
              for (int j = 0; j < 4; ++j) { yv[j] = (y1[pt][j] + el * y2[pt][j] + xv[j] * dsk) * pg8::silu_f(zv[j]); sq += yv[j] * yv[j]; }
              u32x2 w; w.x = pk2(yv[0], yv[1]); w.y = pk2(yv[2], yv[3]); *(u32x2*)zp = w; }
          sq += __shfl_xor(sq, 16); sq += __shfl_xor(sq, 32);
          if (g == 0) atomicAdd(SSQ + tg * 4 + grp, sq); }
        { const float dec = __expf(aend);
          hst[0] = hst[0] * dec; hst[1] = hst[1] * dec;
#pragma unroll
          for (int ks = 0; ks < 4; ++ks) { const bf16x8 ab = ld_lds128(BcT + (16 * wid + fr) * RS + ks * 64 + g * 16);
#pragma unroll
              for (int pt = 0; pt < 2; ++pt) hst[pt] = mfma16(ab, ld_lds128(XwT + (pt * 16 + fr) * RS + ks * 64 + g * 16), hst[pt]); } }
        __syncthreads();
#pragma unroll
        for (int pt = 0; pt < 2; ++pt) { u32x2 w; w.x = pk2(hst[pt][0], hst[pt][1]); w.y = pk2(hst[pt][2], hst[pt][3]); *(LAS u32x2*)(Hb + (pt * 16 + fr) * RS + (16 * wid + 4 * g) * 2) = w; }
    }
    __syncthreads();
}
__device__ __forceinline__ void ssd_norm_phase(const Params& p) {
    bf16_t* ZX = (bf16_t*)(p.ws + WS_TMP + T_ZX); const float* SSQ = (const float*)(p.ws + WS_TMP + T_SSQ);
    const int tid_ = otid(); const int lane = tid_ & 63, gw = obx() * 8 + (tid_ >> 6), nw = ogd() * 8;
    for (int row = gw; row < MT; row += nw) {
        const f32x4 sq = *(const f32x4*)(SSQ + (size_t)row * 4);
#pragma unroll
        for (int i = 0; i < 4; ++i) { const float rs = rsqrtf(sq[i] * (1.0f / 512.0f) + RMS_EPS); bf16_t* zp = ZX + (size_t)row * ZXLD + i * 512 + lane * 8; const u32x4 v = *(const u32x4*)zp; u32x4 w;
#pragma unroll
            for (int k = 0; k < 4; ++k) w[k] = pk2(bflo(v[k]) * rs, bfhi(v[k]) * rs);
            *(u32x4*)zp = w; } }
}

__global__ void __launch_bounds__(NTHR, 2) fwd_megakernel(Params p) {
    extern __shared__ __attribute__((aligned(16))) unsigned char smem[];
    ldsp lds = (ldsp)smem;
    cg::grid_group grid = cg::this_grid();
    { const Params q = load_params(); cvt_x_phase(q.in[0], (bf16_t*)(q.ws + WS_XB)); }
#ifndef NO_CONV
    { const Params q = load_params(); convert_layer(lds, q, 0); }
#endif
    grid.sync();
#pragma unroll 1
    for (int sub = 0; sub < 12; ++sub) {
        const int L = sub / 3, kind = sub % 3, sl = L >> 1; const bool attn = (L & 1) == 0;
#if defined(SKIP_ATTN) || defined(SKIP_SSM)
        {
#if defined(SKIP_ATTN) && defined(SKIP_SSM)
            const bool skip = kind == 1;
#elif defined(SKIP_ATTN)
            const bool skip = kind == 1 && attn;
#else
            const bool skip = kind == 1 && !attn;
#endif
            if (skip) { const Params q = load_params(); ln_phase(q.out, (bf16_t*)(q.ws + WS_XB), q.in[1] + (size_t)(L * 3 + kind) * DM, q.in[2] + (size_t)(L * 3 + kind) * DM); grid.sync(); continue; }
        }
#endif
        if (kind != 1) {
            const Params q = load_params(); const int G = ogd(), bx = obx();
            pg8::Gemm gm{(const bf16_t*)(q.ws + WS_XB), (const bf16_t*)(q.ws + WS_WL + (kind == 0 ? WL_F1IN : WL_F2IN)), MT, 5632, 1024, 1024}; pg8::StaticOrder S; S.init(MT, 5632, G, bx);
            pg8::EpiSwiglu E{(bf16_t*)(q.ws + WS_TMP + T_H)};
            pg8::gemm_phase<pg8::EpiSwiglu, pg8::StaticOrder>((PG8_LAS unsigned char*)lds, gm, S, E, nullptr);
        } else {
            const Params q = load_params(); const int G = ogd(), bx = obx(); unsigned char* tmp = q.ws + WS_TMP;
            if (!attn) { float* SSQ = (float*)(tmp + T_SSQ); for (int i = bx * NTHR + otid(); i < MT * 4; i += G * NTHR) SSQ[i] = 0.f; }
            const int N = attn ? 2048 : 5376;
            pg8::Gemm gm{(const bf16_t*)(q.ws + WS_XB), (const bf16_t*)(q.ws + WS_WL + WL_MIX), MT, N, 1024, 1024}; pg8::StaticOrder S; S.init(MT, N, G, bx);
            pg8::EpiSplit E{(bf16_t*)tmp, attn ? QBLD : ZXLD, attn ? 7 : 20, (float*)(tmp + (attn ? T_CKV : T_DT)), attn ? 256 : 32, attn ? 256 : 32};
            pg8::gemm_phase<pg8::EpiSplit, pg8::StaticOrder>((PG8_LAS unsigned char*)lds, gm, S, E, nullptr);
        }
        grid.sync();
        if (kind == 1) {
            if (attn) {
                { const Params q = load_params(); ckv_norm_phase((const float*)(q.ws + WS_TMP + T_CKV), (bf16_t*)(q.ws + WS_TMP + T_CKVN), q.in[8] + (size_t)sl * 256); }
#ifndef NO_IDX
                { const Params q = load_params(); indexer_phase(lds, q); }
#endif
                grid.sync();
#ifndef NO_SATTN
                { const Params q = load_params(); sattn_phase(lds, q); }
#else
                { const Params q = load_params(); u32x4* Oz = (u32x4*)(q.ws + WS_TMP + T_O); for (size_t i = (size_t)obx() * NTHR + otid(); i < (size_t)MT * 1024 / 8; i += (size_t)ogd() * NTHR) Oz[i] = (u32x4){0u, 0u, 0u, 0u}; }
#endif
                grid.sync();
            } else {
#ifndef NO_SSD
                { const Params q = load_params(); const int G = ogd(); for (int it = obx(); it < 256; it += G) ssd_item(lds, q, sl, it); }
#endif
                grid.sync();
                { const Params q = load_params(); ssd_norm_phase(q); }
                grid.sync();
            }
        }
        {
            const Params q = load_params(); const int G = ogd(), bx = obx(); unsigned char* tmp = q.ws + WS_TMP; unsigned char* wl = q.ws + WS_WL;
            const bf16_t* A2 = (const bf16_t*)(tmp + T_H); int K2 = DFF, lda2 = DFF; const bf16_t* B2 = (const bf16_t*)(wl + (kind == 0 ? WL_F1OUT : WL_F2OUT)); float sc2 = 0.5f;
            if (kind == 1) { sc2 = 1.0f;
                if (attn) { A2 = (const bf16_t*)(tmp + T_O); K2 = 1024; lda2 = 1024; B2 = (const bf16_t*)(wl + WL_MIX + WM_AOUT); }
                else { A2 = (const bf16_t*)(tmp + T_ZX); K2 = 2048; lda2 = ZXLD; B2 = (const bf16_t*)(wl + WL_MIX + WM_SOUT); } }
            const float* resid = sub == 0 ? q.in[0] : q.out;
            pg8::Gemm gm{A2, B2, MT, 1024, K2, lda2}; pg8::StaticOrder S; S.init(MT, 1024, G, bx);
            pg8::EpiResid E{resid, q.out, ALPHA, sc2};
            pg8::gemm_phase<pg8::EpiResid, pg8::StaticOrder>((PG8_LAS unsigned char*)lds, gm, S, E, nullptr);
        }
        grid.sync();
        { const Params q = load_params(); ln_phase(q.out, (bf16_t*)(q.ws + WS_XB), q.in[1] + (size_t)(L * 3 + kind) * DM, q.in[2] + (size_t)(L * 3 + kind) * DM); }
#ifndef NO_CONV
        if (kind == 2 && L < 3) { const Params q = load_params(); convert_layer(lds, q, L + 1); }
#endif
        grid.sync();
    }
}

extern "C" void kernel_launch(void* const* d_in, const int* in_sizes, int n_in, void* d_out, int out_size, void* d_ws, size_t ws_size, hipStream_t stream) {
    static int grid_blocks = 0;
    if (grid_blocks == 0) {
        if (n_in != 20 || ws_size < WS_END) { fprintf(stderr, "kernel_launch: unexpected inputs (n_in %d, ws %zu < %zu)\n", n_in, ws_size, (size_t)WS_END); grid_blocks = -1; return; }
        int dev = 0, cus = 0, per_cu = 0;
        hipGetDevice(&dev); hipDeviceGetAttribute(&cus, hipDeviceAttributeMultiprocessorCount, dev);
        if (hipFuncSetAttribute((const void*)fwd_megakernel, hipFuncAttributeMaxDynamicSharedMemorySize, LDS_BYTES) != hipSuccess) { fprintf(stderr, "kernel_launch: hipFuncSetAttribute failed\n"); grid_blocks = -1; return; }
        hipOccupancyMaxActiveBlocksPerMultiprocessor(&per_cu, (const void*)fwd_megakernel, NTHR, LDS_BYTES);
        if (per_cu < 1) { fprintf(stderr, "kernel_launch: occupancy query says %d blocks per CU\n", per_cu); per_cu = 1; }
        (void)hipGetLastError();
        grid_blocks = cus * per_cu;
    }
    if (grid_blocks < 0) return;
    Params p{};
    for (int i = 0; i < 20; ++i) p.in[i] = (const float*)d_in[i];
    p.out = (float*)d_out; p.ws = (unsigned char*)d_ws;
    void* args[] = {&p};
    hipError_t e = hipLaunchCooperativeKernel((const void*)fwd_megakernel, dim3(grid_blocks), dim3(NTHR), args, LDS_BYTES, stream);
    if (e != hipSuccess) fprintf(stderr, "cooperative launch failed: %s (grid %d)\n", hipGetErrorString(e), grid_blocks);
}
```

```cpp
#include <hip/hip_runtime.h>
#include <hip/hip_cooperative_groups.h>
#include <cstdio>
namespace cg = cooperative_groups;
namespace pg8 {
#define PG8_LAS __attribute__((address_space(3)))
typedef unsigned short bf16_t;
typedef short bf16x8 __attribute__((ext_vector_type(8)));
typedef float f32x4 __attribute__((ext_vector_type(4)));
typedef unsigned u32x4 __attribute__((ext_vector_type(4)));
constexpr int BM = 256, BK = 64, HALF = 128, HTB = HALF * BK * 2  , STAGE_BYTES = 8 * HTB, NXCD = 8, WGM = 8;

__host__ __device__ __forceinline__ int lds_byte(int r, int c) { const int st = (r >> 4) * 2 + (c >> 5), rr = r & 15, cc = c & 31, ob = rr * 64 + cc * 2; return st * 1024 + (ob ^ (((ob >> 9) & 1) << 5)); }
__host__ __device__ __forceinline__ void stage_rc(int b, int& R, int& C) { const int st = b / 1024, sb = b % 1024, swz = sb ^ (((sb >> 9) & 1) << 5); R = (st >> 1) * 16 + swz / 64; C = (st & 1) * 32 + (swz % 64) / 2; }
__host__ __device__ __forceinline__ int perm32(int rho) { const int n = rho >> 4, i = rho & 15; return 8 * (i >> 2) + 4 * n + (i & 3); }

struct Unit { int pm, pn; };
struct Gemm { const bf16_t* A; const bf16_t* Bt; int M, N, K, lda; };

struct StaticOrder {
    int nM, nN, nwg, G, c;
    __host__ __device__ void init(int M, int N, int G_, int c_) { nM = M / BM; nN = N / BM; nwg = nM * nN; G = G_; c = c_; }
    __host__ __device__ bool next(int i, Unit& u) const {
        const long L = (long)i * G + c; if (L >= nwg) return false;
        int wgid = (int)L; { const int q = nwg / NXCD, r = nwg % NXCD, xcd = wgid % NXCD, off = wgid / NXCD; wgid = (xcd < r ? xcd * (q + 1) : r * (q + 1) + (xcd - r) * q) + off; }
        const int nig = WGM * nN, gid = wgid / nig, fm = gid * WGM, gsz = (nM - fm) < WGM ? (nM - fm) : WGM;
        u.pm = fm + ((wgid % nig) % gsz); u.pn = (wgid % nig) / gsz; return true;
    }
    __device__ __forceinline__ void a_ready(const Unit&) const {}
    __device__ __forceinline__ void done(const Unit&) const {}
};
typedef __bf16 bf16x2_t __attribute__((ext_vector_type(2)));
typedef float f32x2_t __attribute__((ext_vector_type(2)));
__device__ __forceinline__ unsigned cvt_pk_bf16(float lo, float hi) { const f32x2_t f = {lo, hi}; const bf16x2_t v = __builtin_convertvector(f, bf16x2_t); return __builtin_bit_cast(unsigned, v); }
__device__ __forceinline__ float silu_f(float x) { return x * __builtin_amdgcn_rcpf(1.0f + __expf(-x)); }
struct EpiSwiglu {
    static constexpr bool PERM = true, AFTER_DRAIN = false;
    bf16_t* H;
    __device__ __forceinline__ void operator()(const f32x4 (&acc)[2][2][4][2], const Unit& u, int wr, int wc, int fr, int fq) const {
        const int row0 = u.pm * BM + wr * 64 + fr, col0 = u.pn * 128 + wc * 32 + 8 * fq;
#pragma unroll
        for (int ai = 0; ai < 2; ++ai)
#pragma unroll
            for (int m = 0; m < 4; ++m) {
                bf16_t* rowp = H + (size_t)(row0 + ai * HALF + m * 16) * 2816 + col0;
                const f32x4 g0 = acc[ai][0][m][0], g1 = acc[ai][0][m][1], u0 = acc[ai][1][m][0], u1 = acc[ai][1][m][1];
                u32x4 w;
                w.x = cvt_pk_bf16(silu_f(g0[0]) * u0[0], silu_f(g0[1]) * u0[1]); w.y = cvt_pk_bf16(silu_f(g0[2]) * u0[2], silu_f(g0[3]) * u0[3]);
                w.z = cvt_pk_bf16(silu_f(g1[0]) * u1[0], silu_f(g1[1]) * u1[1]); w.w = cvt_pk_bf16(silu_f(g1[2]) * u1[2], silu_f(g1[3]) * u1[3]);
                *(u32x4*)rowp = w; }
    }
};
struct EpiResid {
    static constexpr bool PERM = false, AFTER_DRAIN = false;
    bf16_t* X; float alpha, scale;
    __device__ __forceinline__ void operator()(const f32x4 (&acc)[2][2][4][2], const Unit& u, int wr, int wc, int fr, int fq) const {
        const int row0 = u.pm * BM + wr * 64 + fr, col0 = u.pn * BM + wc * 32 + 4 * fq;
        typedef unsigned u32x2_t __attribute__((ext_vector_type(2)));
#pragma unroll
        for (int ai = 0; ai < 2; ++ai)
#pragma unroll
            for (int m = 0; m < 4; ++m) { const size_t ro = (size_t)(row0 + ai * HALF + m * 16) * 1024 + col0;
#pragma unroll
                for (int bj = 0; bj < 2; ++bj)
#pragma unroll
                    for (int n = 0; n < 2; ++n) { const size_t o = ro + bj * HALF + n * 16; const u32x2_t rb = *(const u32x2_t*)(X + o);
                        f32x4 r; r[0] = __uint_as_float(rb.x << 16); r[1] = __uint_as_float(rb.x & 0xFFFF0000u); r[2] = __uint_as_float(rb.y << 16); r[3] = __uint_as_float(rb.y & 0xFFFF0000u);
                        const f32x4 y = r * alpha + acc[ai][bj][m][n] * scale; u32x2_t w; w.x = cvt_pk_bf16(y[0], y[1]); w.y = cvt_pk_bf16(y[2], y[3]); *(u32x2_t*)(X + o) = w; } }
    }
};
struct EpiSplit {
    static constexpr bool PERM = true, AFTER_DRAIN = false;
    bf16_t* O; int ldo; int nb16; float* F; int ldf; int fcols; bf16_t* O2; int pn2;
    __device__ __forceinline__ void operator()(const f32x4 (&acc)[2][2][4][2], const Unit& u, int wr, int wc, int fr, int fq) const {
        const int row0 = u.pm * BM + wr * 64 + fr;
        if (u.pn < nb16) {
            const int col0 = u.pn * BM + wc * 32 + 8 * fq;
#pragma unroll
            for (int ai = 0; ai < 2; ++ai)
#pragma unroll
                for (int m = 0; m < 4; ++m) { bf16_t* rowp = O + (size_t)(row0 + ai * HALF + m * 16) * ldo + col0;
#pragma unroll
                    for (int bj = 0; bj < 2; ++bj) { const f32x4 v0 = acc[ai][bj][m][0], v1 = acc[ai][bj][m][1]; u32x4 w;
                        w.x = cvt_pk_bf16(v0[0], v0[1]); w.y = cvt_pk_bf16(v0[2], v0[3]); w.z = cvt_pk_bf16(v1[0], v1[1]); w.w = cvt_pk_bf16(v1[2], v1[3]);
                        *(u32x4*)(rowp + bj * HALF) = w;
                        if (u.pn == pn2 && bj == 0) *(u32x4*)(O2 + (size_t)(row0 + ai * HALF + m * 16) * 128 + wc * 32 + 8 * fq) = w; } }
        } else {
            const int col0 = (u.pn - nb16) * BM + wc * 32 + 8 * fq;
#pragma unroll
            for (int ai = 0; ai < 2; ++ai)
#pragma unroll
                for (int m = 0; m < 4; ++m) { float* rowp = F + (size_t)(row0 + ai * HALF + m * 16) * ldf;
#pragma unroll
                    for (int bj = 0; bj < 2; ++bj) { const int c = col0 + bj * HALF;
                        if (c < fcols) { *(f32x4*)(rowp + c) = acc[ai][bj][m][0]; *(f32x4*)(rowp + c + 4) = acc[ai][bj][m][1]; } } }
        }
    }
};
template <class Epi, class Sched, bool STAMP = false>
__device__ __forceinline__ void gemm_phase(PG8_LAS unsigned char* lds, const Gemm g, const Sched& S, const Epi& E, unsigned long long* stamps) {
    int tid = threadIdx.x; asm volatile("" : "+v"(tid)); const int wid = __builtin_amdgcn_readfirstlane(tid >> 6), lane = tid & 63, wr = wid >> 2, wc = wid & 3, fr = lane & 15, fq = lane >> 4;
    const int K = g.K, nt = K / BK;
    int ts_lo = 0, ts_hi = 0, nts = 0; const unsigned long long rt_entry = STAMP ? (unsigned long long)wall_clock64() : 0ull;
#define PG8_STAMP() do { if (STAMP && wid == 0 && nts < 64) { const unsigned long long _c = (unsigned long long)clock64(); \
        ts_lo = (lane == nts) ? (int)(unsigned)_c : ts_lo; ts_hi = (lane == nts) ? (int)(unsigned)(_c >> 32) : ts_hi; ++nts; } } while (0)
    PG8_STAMP();
    unsigned voffA[2], voffB[2];
#pragma unroll
    for (int i = 0; i < 2; ++i) { int R, C; stage_rc(tid * 16 + i * 8192, R, C); const int Rb = Epi::PERM ? ((R & ~31) + perm32(R & 31)) : R;
        voffA[i] = (unsigned)(R * g.lda + C) * 2u; voffB[i] = (unsigned)(Rb * K + C) * 2u; }
    const size_t kstep = (size_t)(BK * 2);
    const size_t hstep = (size_t)HALF * K * 2;
    const size_t tstep = 2 * hstep; const size_t hstepA = (size_t)HALF * g.lda * 2; const size_t tstepA = 2 * hstepA;
    const unsigned ldsw = (unsigned)wid * 1024u;
    const int aoff = lds_byte(wr * 64 + fr, fq * 8), boff = lds_byte(wc * 32 + fr, fq * 8);
#define PG8_SA(b, h) (((b) * 2 + (h)) * HTB)
#define PG8_SB(b, h) ((4 + (b) * 2 + (h)) * HTB)
#define PG8_STAGE(bufoff, gbase, voff) do { _Pragma("unroll") for (int _i = 0; _i < 2; ++_i) \
        __builtin_amdgcn_global_load_lds((const unsigned*)((const char*)(gbase) + (voff)[_i]), (PG8_LAS unsigned*)(lds + (bufoff) + ldsw + _i * 8192), 16, 0, 0); } while (0)
#define PG8_LDA(dst, b, h) do { _Pragma("unroll") for (int m = 0; m < 4; ++m) _Pragma("unroll") for (int k = 0; k < 2; ++k) dst[m][k] = *(const PG8_LAS bf16x8*)(lds + PG8_SA(b, h) + aoff + m * 2048 + k * 1024); } while (0)
#define PG8_LDB(dst, b, h) do { _Pragma("unroll") for (int n = 0; n < 2; ++n) _Pragma("unroll") for (int k = 0; k < 2; ++k) dst[n][k] = *(const PG8_LAS bf16x8*)(lds + PG8_SB(b, h) + boff + n * 2048 + k * 1024); } while (0)
#define PG8_MMA(ai, bj, At, Bt) do { __builtin_amdgcn_s_setprio(1); _Pragma("unroll") for (int m = 0; m < 4; ++m) _Pragma("unroll") for (int n = 0; n < 2; ++n) _Pragma("unroll") for (int k = 0; k < 2; ++k) \
        acc[ai][bj][m][n] = __builtin_amdgcn_mfma_f32_16x16x32_bf16(Bt[n][k], At[m][k], acc[ai][bj][m][n], 0, 0, 0); __builtin_amdgcn_s_setprio(0); } while (0)
#define PG8_WAIT_V(n) asm volatile("s_waitcnt vmcnt(" #n ")" ::: "memory")
#define PG8_WAIT_L(n) asm volatile("s_waitcnt lgkmcnt(" #n ")" ::: "memory")
#define PG8_BAR __builtin_amdgcn_s_barrier()
#define PG8_SCHED __builtin_amdgcn_sched_barrier(0)
    Unit cur, nxt; int ui = 0;
    if (!S.next(0, cur)) return;
    f32x4 acc[2][2][4][2];
#pragma unroll
    for (int a = 0; a < 2; ++a)
#pragma unroll
        for (int b = 0; b < 2; ++b)
#pragma unroll
            for (int m = 0; m < 4; ++m)
#pragma unroll
                for (int n = 0; n < 2; ++n) acc[a][b][m][n] = (f32x4){0.f, 0.f, 0.f, 0.f};
    bf16x8 At[4][2], B0[2][2], B1[2][2];
    const char* cA = (const char*)g.A + (size_t)cur.pm * tstepA; const char* cB = (const char*)g.Bt + (size_t)cur.pn * tstep;
    S.a_ready(cur);
    PG8_STAGE(PG8_SB(0, 0), cB, voffB); PG8_STAGE(PG8_SA(0, 0), cA, voffA); PG8_STAGE(PG8_SB(0, 1), cB + hstep, voffB); PG8_STAGE(PG8_SA(0, 1), cA + hstepA, voffA);
    if (wr == 1) PG8_BAR;
    PG8_WAIT_V(4); PG8_BAR;
    PG8_STAGE(PG8_SB(1, 0), cB + kstep, voffB); PG8_STAGE(PG8_SA(1, 0), cA + kstep, voffA); PG8_STAGE(PG8_SB(1, 1), cB + hstep + kstep, voffB);
    PG8_WAIT_V(6); PG8_BAR;
    PG8_STAMP();
    for (;;) {
        const bool has_next = S.next(ui + 1, nxt);
        const char* nA = has_next ? (const char*)g.A + (size_t)nxt.pm * tstepA : cA; const char* nB = has_next ? (const char*)g.Bt + (size_t)nxt.pn * tstep : cB;
        for (int t = 0; t < nt; t += 2) {
            const bool last = (t == nt - 2);
            const char* a1 = cA + (size_t)(t + 1) * kstep;
            const char* a2 = last ? nA : cA + (size_t)(t + 2) * kstep; const char* b2 = last ? nB : cB + (size_t)(t + 2) * kstep;
            const char* a3 = a2 + kstep; const char* b3 = b2 + kstep;
            if (last && has_next) S.a_ready(nxt);
            PG8_LDB(B0, 0, 0); PG8_SCHED; PG8_LDA(At, 0, 0); PG8_STAGE(PG8_SA(1, 1), a1 + hstepA, voffA);
            PG8_WAIT_L(8); PG8_BAR; PG8_WAIT_L(0); PG8_MMA(0, 0, At, B0); PG8_BAR; PG8_SCHED;
            PG8_LDB(B1, 0, 1); PG8_STAGE(PG8_SB(0, 0), b2, voffB);
            PG8_BAR; PG8_WAIT_L(0); PG8_MMA(0, 1, At, B1); PG8_BAR;
            PG8_LDA(At, 0, 1); PG8_STAGE(PG8_SA(0, 0), a2, voffA);
            PG8_BAR; PG8_WAIT_L(0); PG8_MMA(1, 0, At, B0); PG8_BAR; PG8_SCHED;
            PG8_STAGE(PG8_SB(0, 1), b2 + hstep, voffB);
            PG8_WAIT_V(6); PG8_BAR; PG8_MMA(1, 1, At, B1); PG8_BAR;
            PG8_LDB(B0, 1, 0); PG8_SCHED; PG8_LDA(At, 1, 0); PG8_STAGE(PG8_SA(0, 1), a2 + hstepA, voffA);
            PG8_WAIT_L(8); PG8_BAR; PG8_WAIT_L(0); PG8_MMA(0, 0, At, B0); PG8_BAR; PG8_SCHED;
            PG8_LDB(B1, 1, 1); PG8_STAGE(PG8_SB(1, 0), b3, voffB);
            PG8_BAR; PG8_WAIT_L(0); PG8_MMA(0, 1, At, B1); PG8_BAR;
            PG8_LDA(At, 1, 1); PG8_STAGE(PG8_SA(1, 0), a3, voffA);
            PG8_BAR; PG8_WAIT_L(0); PG8_MMA(1, 0, At, B0); PG8_BAR; PG8_SCHED;
            PG8_STAGE(PG8_SB(1, 1), b3 + hstep, voffB);
            PG8_WAIT_V(6); PG8_BAR; PG8_MMA(1, 1, At, B1); PG8_BAR;
        }
        PG8_STAMP();
        if constexpr (!Epi::AFTER_DRAIN) { E(acc, cur, wr, wc, fr, fq); S.done(cur); }
        PG8_STAMP();
        if (!has_next) break;
#pragma unroll
        for (int a = 0; a < 2; ++a)
#pragma unroll
            for (int b = 0; b < 2; ++b)
#pragma unroll
                for (int m = 0; m < 4; ++m)
#pragma unroll
                    for (int n = 0; n < 2; ++n) acc[a][b][m][n] = (f32x4){0.f, 0.f, 0.f, 0.f};
        cur = nxt; cA = nA; cB = nB; ++ui;
    }
    PG8_WAIT_V(0);
    if (wr == 0) PG8_BAR;
    PG8_BAR;
    if constexpr (Epi::AFTER_DRAIN) { E.fused(acc, cur, wr, wc, fr, fq, lds, wid, lane); S.done(cur); }
    PG8_STAMP();
    if (STAMP && wid == 0) { stamps[lane] = lane < nts ? (((unsigned long long)(unsigned)ts_hi << 32) | (unsigned)ts_lo) : 0ull;
        if (lane == 62) stamps[62] = rt_entry; if (lane == 63) stamps[63] = (unsigned long long)wall_clock64(); }
#undef PG8_STAMP
#undef PG8_SA
#undef PG8_SB
#undef PG8_STAGE
#undef PG8_LDA
#undef PG8_LDB
#undef PG8_MMA
#undef PG8_WAIT_V
#undef PG8_WAIT_L
#undef PG8_BAR
#undef PG8_SCHED
}
}
using pg8::bf16_t; using pg8::bf16x8; using pg8::f32x4; using pg8::u32x4;
#define LAS __attribute__((address_space(3)))
typedef short s16x4 __attribute__((ext_vector_type(4)));
typedef float f32x16 __attribute__((ext_vector_type(16)));
typedef unsigned u32x2 __attribute__((ext_vector_type(2)));
typedef LAS unsigned char* ldsp;

constexpr int MT = 32768, DM = 1024, SEQ = 8192, DFF = 2816, NTHR = 512;
constexpr int LDS_BYTES = 155648;
constexpr float ALPHA = 1.6817928305074290f;
constexpr float LN_EPS = 1e-5f, RMS_EPS = 1e-6f;
constexpr size_t WL_F1IN = 0, WL_F1OUT = 11534336, WL_F2IN = 17301504, WL_F2OUT = 28835840, WL_MIX = 34603008, WL_SIZE = 49807360;
constexpr size_t WM_AIN = 0, WM_UK = 4194304, WM_UV = 4718592, WM_AOUT = 5242880;
constexpr size_t WM_SIN = 0, WM_SOUT = 11010048;
constexpr size_t WS_WL = 4096, WS_XB = WS_WL + WL_SIZE, WS_TMP = WS_XB + 67108864;
constexpr size_t T_H = 0;
constexpr size_t T_KW = 251658240;
constexpr size_t T_QB = 0, T_CKV = 117440512, T_CKVN = 150994944, T_IDX = 167772160, T_O = 184549376;
constexpr size_t T_ZX = 0, T_DT = 335544320, T_SSQ = 339738624;
constexpr size_t WS_END = WS_TMP + 348127232;
constexpr int QBLD = 1792, ZXLD = 5120;

struct Params {
    const float* in[20]; float* out; unsigned char* ws;
};

__device__ __forceinline__ int obx() { int b = blockIdx.x; asm volatile("" : "+s"(b)); return b; }
__device__ __forceinline__ int ogd() { int b = gridDim.x; asm volatile("" : "+s"(b)); return b; }
#define AS4 __attribute__((address_space(4)))
__device__ __forceinline__ Params load_params() {
    Params q; const AS4 unsigned long long* kp = (const AS4 unsigned long long*)__builtin_amdgcn_kernarg_segment_ptr(); asm volatile("" : "+s"(kp));
#pragma unroll
    for (int i = 0; i < 20; ++i) q.in[i] = (const float*)(const __attribute__((address_space(1))) float*)kp[i];
    q.out = (float*)(__attribute__((address_space(1))) float*)kp[20]; q.ws = (unsigned char*)(__attribute__((address_space(1))) unsigned char*)kp[21]; return q; }
__device__ __forceinline__ int otid() { int t = threadIdx.x; asm volatile("" : "+v"(t)); return t; }
__device__ __forceinline__ float bf2f(unsigned v) { return __uint_as_float(v << 16); }
__device__ __forceinline__ float bflo(unsigned v) { return __uint_as_float(v << 16); }
__device__ __forceinline__ float bfhi(unsigned v) { return __uint_as_float(v & 0xFFFF0000u); }
__device__ __forceinline__ unsigned pk2(float a, float b) { return pg8::cvt_pk_bf16(a, b); }
__device__ __forceinline__ float wave_sum(float v) {
#pragma unroll
    for (int d = 32; d >= 1; d >>= 1) v += __shfl_xor(v, d);
    return v;
}
__device__ __forceinline__ f32x4 mfma16(bf16x8 a, bf16x8 b, f32x4 c) { return __builtin_amdgcn_mfma_f32_16x16x32_bf16(a, b, c, 0, 0, 0); }
__device__ __forceinline__ bf16x8 ld_lds128(ldsp p) { return *(LAS const bf16x8*)p; }

__device__ __forceinline__ int map_col(int kind, int j, int nsrc) {
    if (kind == 0) return j < nsrc ? j : -1;
    if (kind == 1) { const int pn = j >> 8, bj = (j >> 7) & 1, i = j & 127; return bj * DFF + pn * 128 + i; }
    if (j < 1024) return j;
    if (j < 1536) return j - 1024 + 1280;
    if (j < 1600) return j - 1536 + 1792;
    if (j < 1608) return j - 1600 + 1856;
    if (j < 1792) return -1;
    return j - 1792 + 1024;
}
__device__ __forceinline__ void conv_job(ldsp lds, const float* src0, bf16_t* dst0, int K, int nsrc, int ndst, int kind, const float* kscale, int nb = 1) {
    LAS float* tile = (LAS float*)lds;
    const int tid = otid(), ntk = K >> 6, ntm = (ndst >> 6) * ntk, ntiles = ntm * nb, G = ogd();
    for (int t0 = obx(); t0 < ntiles; t0 += 4 * G) {
        float v[4][8];
#pragma unroll
        for (int s = 0; s < 4; ++s) { const int t = t0 + s * G; const bool on = t < ntiles; const int tt = on ? t : t0; const int mb = tt / ntm, tm = tt - mb * ntm; const int j0 = (tm / ntk) << 6, k0 = (tm % ntk) << 6; const float* src = src0 + (size_t)mb * K * nsrc;
#pragma unroll
            for (int e = 0; e < 8; ++e) { const int idx = tid + e * NTHR, kk = idx >> 6, jj = idx & 63; const int c = map_col(kind, j0 + jj, nsrc);
                float x = (on && c >= 0) ? src[(size_t)(k0 + kk) * nsrc + c] : 0.f; if (kscale) x *= kscale[k0 + kk]; v[s][e] = x; } }
#pragma unroll
        for (int s = 0; s < 4; ++s)
#pragma unroll
            for (int e = 0; e < 8; ++e) { const int idx = tid + e * NTHR, kk = idx >> 6, jj = idx & 63; tile[s * 4160 + kk * 65 + jj] = v[s][e]; }
        __syncthreads();
#pragma unroll
        for (int s = 0; s < 4; ++s) { const int t = t0 + s * G;
            if (t < ntiles) { const int mb = t / ntm, tm = t - mb * ntm; const int j0 = (tm / ntk) << 6, k0 = (tm % ntk) << 6; bf16_t* dst = dst0 + (size_t)mb * ndst * K; const int jj = tid >> 3, kc = tid & 7; LAS const float* tl = tile + s * 4160; u32x4 w;
                w.x = pk2(tl[(kc * 8 + 0) * 65 + jj], tl[(kc * 8 + 1) * 65 + jj]); w.y = pk2(tl[(kc * 8 + 2) * 65 + jj], tl[(kc * 8 + 3) * 65 + jj]);
                w.z = pk2(tl[(kc * 8 + 4) * 65 + jj], tl[(kc * 8 + 5) * 65 + jj]); w.w = pk2(tl[(kc * 8 + 6) * 65 + jj], tl[(kc * 8 + 7) * 65 + jj]);
                *(u32x4*)(dst + (size_t)(j0 + jj) * K + k0 + kc * 8) = w; } }
        __syncthreads();
    }
}
__device__ __forceinline__ void convert_layer(ldsp lds, const Params& p, int L) {
    unsigned char* wl = p.ws + WS_WL;
    conv_job(lds, p.in[3] + (size_t)L * 1024 * 5632, (bf16_t*)(wl + WL_F1IN), 1024, 5632, 5632, 1, nullptr);
    conv_job(lds, p.in[4] + (size_t)L * 2816 * 1024, (bf16_t*)(wl + WL_F1OUT), 2816, 1024, 1024, 0, nullptr);
    conv_job(lds, p.in[5] + (size_t)L * 1024 * 5632, (bf16_t*)(wl + WL_F2IN), 1024, 5632, 5632, 1, nullptr);
    conv_job(lds, p.in[6] + (size_t)L * 2816 * 1024, (bf16_t*)(wl + WL_F2OUT), 2816, 1024, 1024, 0, nullptr);
    const int j = L >> 1;
    if ((L & 1) == 0) {
        conv_job(lds, p.in[7] + (size_t)j * 1024 * 1864, (bf16_t*)(wl + WL_MIX + WM_AIN), 1024, 1864, 2048, 2, nullptr);
        conv_job(lds, p.in[9] + (size_t)j * 16 * 64 * 256, (bf16_t*)(wl + WL_MIX + WM_UK), 64, 256, 256, 0, nullptr, 16);
        conv_job(lds, p.in[10] + (size_t)j * 16 * 256 * 64, (bf16_t*)(wl + WL_MIX + WM_UV), 256, 64, 64, 0, nullptr, 16);
        conv_job(lds, p.in[11] + (size_t)j * 1024 * 1024, (bf16_t*)(wl + WL_MIX + WM_AOUT), 1024, 1024, 1024, 0, nullptr);
    } else {
        conv_job(lds, p.in[12] + (size_t)j * 1024 * 5152, (bf16_t*)(wl + WL_MIX + WM_SIN), 1024, 5152, 5376, 0, nullptr);
        conv_job(lds, p.in[19] + (size_t)j * 2048 * 1024, (bf16_t*)(wl + WL_MIX + WM_SOUT), 2048, 1024, 1024, 0, p.in[18] + (size_t)j * 2048);
    }
}

template <bool DRY>
__device__ __forceinline__ void ln_phase(float* x, bf16_t* xb, const float* g, const float* b, unsigned char* dummy, bool write_f32) {
    const int tid_ = otid(); const int lane = tid_ & 63, gw = obx() * 8 + (tid_ >> 6), nw = ogd() * 8;
    for (int row0 = gw; row0 < MT; row0 += 4 * nw) {
        f32x4 v[4][4]; float s[4];
#pragma unroll
        for (int r = 0; r < 4; ++r) { const int row = row0 + r * nw; const bf16_t* xr = xb + (size_t)(row < MT ? row : row0) * DM; s[r] = 0.f;
#pragma unroll
            for (int i = 0; i < 4; ++i) { const u32x2 w = *(const u32x2*)(xr + i * 256 + lane * 4); v[r][i][0] = bflo(w.x); v[r][i][1] = bfhi(w.x); v[r][i][2] = bflo(w.y); v[r][i][3] = bfhi(w.y); } }
#pragma unroll
        for (int r = 0; r < 4; ++r) {
#pragma unroll
            for (int i = 0; i < 4; ++i) s[r] += v[r][i][0] + v[r][i][1] + v[r][i][2] + v[r][i][3];
            s[r] = wave_sum(s[r]) * (1.0f / DM); }
        float q[4];
#pragma unroll
        for (int r = 0; r < 4; ++r) { q[r] = 0.f;
#pragma unroll
            for (int i = 0; i < 4; ++i) { v[r][i] = v[r][i] - s[r]; q[r] += v[r][i][0] * v[r][i][0] + v[r][i][1] * v[r][i][1] + v[r][i][2] * v[r][i][2] + v[r][i][3] * v[r][i][3]; }
            q[r] = rsqrtf(wave_sum(q[r]) * (1.0f / DM) + LN_EPS); }
#pragma unroll
        for (int i = 0; i < 4; ++i) { const int c = i * 256 + lane * 4; const f32x4 gg = *(const f32x4*)(g + c), bb = *(const f32x4*)(b + c);
#pragma unroll
            for (int r = 0; r < 4; ++r) { const int row = row0 + r * nw;
                if (row < MT) { const f32x4 o = v[r][i] * q[r] * gg + bb; u32x2 w; w.x = pk2(o[0], o[1]); w.y = pk2(o[2], o[3]);
                    if (write_f32) *(f32x4*)(x + (size_t)row * DM + c) = o;
                    *(u32x2*)(xb + (size_t)row * DM + c) = w; } } }
    }
}
__device__ __forceinline__ void cvt_x_phase(const float* x, bf16_t* xb) {
    const size_t n8 = (size_t)MT * DM / 8, stride = (size_t)ogd() * NTHR;
    for (size_t i0 = (size_t)obx() * NTHR + otid(); i0 < n8; i0 += 4 * stride) {
        f32x4 a[4], b[4];
#pragma unroll
        for (int s = 0; s < 4; ++s) { const size_t i = i0 + s * stride; const size_t ii = i < n8 ? i : i0; a[s] = *(const f32x4*)(x + ii * 8); b[s] = *(const f32x4*)(x + ii * 8 + 4); }
#pragma unroll
        for (int s = 0; s < 4; ++s) { const size_t i = i0 + s * stride;
            if (i < n8) { u32x4 w; w.x = pk2(a[s][0], a[s][1]); w.y = pk2(a[s][2], a[s][3]); w.z = pk2(b[s][0], b[s][1]); w.w = pk2(b[s][2], b[s][3]); *(u32x4*)(xb + i * 8) = w; } }
    }
}

__device__ __forceinline__ void ckv_norm_phase(const float* ckv, bf16_t* ckvn, const float* g) {
    const int tid_ = otid(); const int lane = tid_ & 63, gw = obx() * 8 + (tid_ >> 6), nw = ogd() * 8;
    const f32x4 gg = *(const f32x4*)(g + lane * 4);
    for (int row0 = gw; row0 < MT; row0 += 4 * nw) {
        f32x4 v[4];
#pragma unroll
        for (int r = 0; r < 4; ++r) { const int row = row0 + r * nw; v[r] = *(const f32x4*)(ckv + (size_t)(row < MT ? row : row0) * 256 + lane * 4); }
#pragma unroll
        for (int r = 0; r < 4; ++r) { const int row = row0 + r * nw;
            const float ms = wave_sum(v[r][0] * v[r][0] + v[r][1] * v[r][1] + v[r][2] * v[r][2] + v[r][3] * v[r][3]) * (1.0f / 256.0f);
            const float rs = rsqrtf(ms + RMS_EPS); const f32x4 o = v[r] * rs * gg; u32x2 w; w.x = pk2(o[0], o[1]); w.y = pk2(o[2], o[3]);
            if (row < MT) *(u32x2*)(ckvn + (size_t)row * 256 + lane * 4) = w; }
    }
}

__device__ __forceinline__ unsigned f2key(float s) { const unsigned u = __float_as_uint(s); return (u & 0x80000000u) ? ~u : (u | 0x80000000u); }
__device__ __forceinline__ void find_bin(ldsp hq, unsigned need, unsigned& bin, unsigned& newneed) {
    const int lane = otid() & 63;
    u32x4 w[4];
#pragma unroll
    for (int i = 0; i < 4; ++i) w[i] = *(LAS const u32x4*)(hq + lane * 64 + i * 16);
    unsigned sum = 0;
#pragma unroll
    for (int i = 0; i < 4; ++i)
#pragma unroll
        for (int k = 0; k < 4; ++k) sum += (w[i][k] & 0xFFFFu) + (w[i][k] >> 16);
    unsigned suf = sum;
#pragma unroll
    for (int d = 1; d < 64; d <<= 1) { const unsigned t = __shfl_down(suf, d); if (lane + d < 64) suf += t; }
    const unsigned above = suf - sum;
    const bool mine = (above < need) && (need <= suf);
    unsigned cum = above, fb = 0, fn = 0; bool found = false;
#pragma unroll
    for (int i = 3; i >= 0; --i)
#pragma unroll
        for (int k = 3; k >= 0; --k) {
            const unsigned hi16 = w[i][k] >> 16, lo16 = w[i][k] & 0xFFFFu; const int wi = i * 4 + k;
            if (!found && cum + hi16 >= need) { fb = lane * 32 + wi * 2 + 1; fn = need - cum; found = true; } cum += hi16;
            if (!found && cum + lo16 >= need) { fb = lane * 32 + wi * 2; fn = need - cum; found = true; } cum += lo16; }
    const unsigned long long bal = __ballot(mine);
    const int src = bal ? (int)__builtin_ctzll(bal) : 0;
    bin = __shfl(fb, src); newneed = __shfl(fn, src);
}

__device__ __forceinline__ void indexer_item(ldsp lds, const bf16_t* QB, unsigned short* IDX, int b, int qt) {
    const int tid = otid(), lane = tid & 63, wid = tid >> 6, c = lane & 31, hi = lane >> 5;
    const int q0 = qt * 32; const size_t tb = (size_t)b * SEQ;
    const int posb = q0 + 4 * wid + 2 * hi;
#ifdef IDX_SIMPLE
    if (true) {
#else
    if (q0 < 256) {
#endif
        for (int tq = 0; tq < 4; ++tq) { const int pos = q0 + 4 * wid + tq; unsigned short* o = IDX + (tb + pos) * 256;
#pragma unroll
            for (int k = 0; k < 4; ++k) { const int j = lane * 4 + k; o[j] = (unsigned short)(j <= pos ? j : 0xFFFF); } }
        return;
    }
    ldsp hist = lds + wid * 16384;
    ldsp kbuf = lds + 131072;
    bf16x8 af[4];
    { const int r = c, tk = ((r >> 2) & 1) * 2 + (r & 1), hd = (r >> 3) * 2 + ((r >> 1) & 1);
      const bf16_t* qp = QB + (tb + q0 + 4 * wid + tk) * QBLD + 1024 + hd * 64 + hi * 8;
#pragma unroll
      for (int ks = 0; ks < 4; ++ks) af[ks] = *(const bf16x8*)(qp + ks * 16); }
    float wq[2][8];
#pragma unroll
    for (int e = 0; e < 2; ++e) { const u32x4 wv = *(const u32x4*)(QB + T_KW / 2 + (tb + posb + e) * 128 + 64);
#pragma unroll
        for (int k = 0; k < 4; ++k) { wq[e][2 * k] = bflo(wv[k]) * 0.04419417382415922f; wq[e][2 * k + 1] = bfhi(wv[k]) * 0.04419417382415922f; } }
    const int nch = (q0 + 32 + 63) >> 6;
    const bf16_t* KW = QB + T_KW / 2;
    const bf16_t* kg = KW + (tb + (tid >> 3)) * 128 + (tid & 7) * 8;
    const int kst = (tid >> 3) * 144 + (tid & 7) * 16;
    unsigned pre[2] = {0u, 0u}, need[2] = {256u, 256u};
    unsigned cnt[2] = {0u, 0u}, tie[2] = {0u, 0u};
    for (int pass = 0; pass < 4; ++pass) {
        if (pass < 3) {
#pragma unroll
            for (int i = 0; i < 16; ++i) *(LAS u32x4*)(hist + i * 1024 + lane * 16) = (u32x4){0u, 0u, 0u, 0u};
        }
        __syncthreads();
        u32x4 kr = *(const u32x4*)kg;
        *(LAS u32x4*)(kbuf + kst) = kr;
        __syncthreads();
        for (int ch = 0; ch < nch; ++ch) {
            if (ch + 1 < nch) kr = *(const u32x4*)(kg + (size_t)(ch + 1) * 64 * 128);
            ldsp kb = kbuf + (ch & 1) * 9216;
#pragma unroll
            for (int ts = 0; ts < 2; ++ts) {
                f32x16 acc;
#pragma unroll
                for (int i = 0; i < 16; ++i) acc[i] = 0.f;
#pragma unroll
                for (int ks = 0; ks < 4; ++ks) { const bf16x8 bf = ld_lds128(kb + (ts * 32 + c) * 144 + ks * 32 + hi * 16); acc = __builtin_amdgcn_mfma_f32_32x32x16_bf16(af[ks], bf, acc, 0, 0, 0); }
                const int key = ch * 64 + ts * 32 + c;
#pragma unroll
                for (int e = 0; e < 2; ++e) {
                    float s = 0.f;
#pragma unroll
                    for (int h = 0; h < 8; ++h) s = fmaf(wq[e][h], fmaxf(acc[2 * h + e], 0.f), s);
                    s += 0.0f;
                    const unsigned u = f2key(s); const bool valid = key <= posb + e;
                    if (pass == 0) { if (valid) { const unsigned bin = u >> 21; __hip_atomic_fetch_add((LAS unsigned*)(hist + (2 * hi + e) * 4096 + (bin >> 1) * 4), 1u << ((bin & 1) * 16), __ATOMIC_RELAXED, __HIP_MEMORY_SCOPE_WORKGROUP); } }
                    else if (pass == 1) { if (valid && (u >> 21) == pre[e]) { const unsigned bin = (u >> 10) & 0x7FFu; __hip_atomic_fetch_add((LAS unsigned*)(hist + (2 * hi + e) * 4096 + (bin >> 1) * 4), 1u << ((bin & 1) * 16), __ATOMIC_RELAXED, __HIP_MEMORY_SCOPE_WORKGROUP); } }
                    else if (pass == 2) { if (valid && (u >> 10) == pre[e]) { const unsigned bin = u & 0x3FFu; __hip_atomic_fetch_add((LAS unsigned*)(hist + (2 * hi + e) * 4096 + (bin >> 1) * 4), 1u << ((bin & 1) * 16), __ATOMIC_RELAXED, __HIP_MEMORY_SCOPE_WORKGROUP); } }
                    else {
                        const bool gt = valid && (u > pre[e]), eq = valid && (u == pre[e]);
                        const unsigned long long beq = __ballot(eq); const unsigned meq = hi ? (unsigned)(beq >> 32) : (unsigned)beq;
                        const unsigned below = (1u << c) - 1u;
                        const bool emit = gt || (eq && (tie[e] + __popc(meq & below) < need[e]));
                        tie[e] += __popc(meq);
                        const unsigned long long bem = __ballot(emit); const unsigned mem = hi ? (unsigned)(bem >> 32) : (unsigned)bem;
                        const unsigned slot = cnt[e] + __popc(mem & below);
                        if (emit && slot < 256u) IDX[(tb + posb + e) * 256 + slot] = (unsigned short)key;
                        cnt[e] += __popc(mem);
                    }
                }
            }
            if (ch + 1 < nch) *(LAS u32x4*)(kbuf + ((ch + 1) & 1) * 9216 + kst) = kr;
            __syncthreads();
        }
        if (pass < 3) {
            unsigned nb[4], nn[4];
#pragma unroll
            for (int tq = 0; tq < 4; ++tq) {
                const unsigned nd = __shfl(need[tq & 1], (tq >> 1) * 32);
                find_bin(hist + tq * 4096, nd, nb[tq], nn[tq]); }
#pragma unroll
            for (int e = 0; e < 2; ++e) { const unsigned bsel = hi ? nb[2 + e] : nb[e], nsel = hi ? nn[2 + e] : nn[e];
                pre[e] = (pass == 0) ? bsel : (pass == 1 ? ((pre[e] << 11) | bsel) : ((pre[e] << 10) | bsel)); need[e] = nsel; }
        }
    }
}
__device__ __forceinline__ void find_bin1k(ldsp hq, unsigned need, unsigned& bin, unsigned& newneed) {
    const int lane = otid() & 63;
    u32x4 w[2];
#pragma unroll
    for (int i = 0; i < 2; ++i) w[i] = *(LAS const u32x4*)(hq + lane * 32 + i * 16);
    unsigned sum = 0;
#pragma unroll
    for (int i = 0; i < 2; ++i)
#pragma unroll
        for (int k = 0; k < 4; ++k) sum += (w[i][k] & 0xFFFFu) + (w[i][k] >> 16);
    unsigned suf = sum;
#pragma unroll
    for (int d = 1; d < 64; d <<= 1) { const unsigned t = __shfl_down(suf, d); if (lane + d < 64) suf += t; }
    const unsigned above = suf - sum;
    const bool mine = (above < need) && (need <= suf);
    unsigned cum = above, fb = 0, fn = 0; bool found = false;
#pragma unroll
    for (int i = 1; i >= 0; --i)
#pragma unroll
        for (int k = 3; k >= 0; --k) {
            const unsigned hi16 = w[i][k] >> 16, lo16 = w[i][k] & 0xFFFFu; const int wi = i * 4 + k;
            if (!found && cum + hi16 >= need) { fb = lane * 16 + wi * 2 + 1; fn = need - cum; found = true; } cum += hi16;
            if (!found && cum + lo16 >= need) { fb = lane * 16 + wi * 2; fn = need - cum; found = true; } cum += lo16; }
    const unsigned long long bal = __ballot(mine);
    const int src = bal ? (int)__builtin_ctzll(bal) : 0;
    bin = __shfl(fb, src); newneed = __shfl(fn, src);
}
struct IdxState { bf16x8 af[4]; float wq[2][8], bsc[2], bof[2]; unsigned tbin[2], cnt[2], ccnt[2]; };
template <int PASS>
__device__ __forceinline__ void idx_update(float sv, unsigned bin, int e, int key, IdxState& st, ldsp hist, ldsp cand, ldsp ctrs, unsigned short* IDX, size_t tb, int posb, int hi) {
    const bool valid = key <= posb + e;
    if (PASS == 2) { if (valid && sv == 123456.789f) IDX[(tb + posb + e) * 256] = (unsigned short)bin; }
    else if (PASS == 0) { __hip_atomic_fetch_add((LAS unsigned*)(hist + (2 * hi + e) * 2048 + (bin >> 1) * 4), valid ? (1u << ((bin & 1) * 16)) : 0u, __ATOMIC_RELAXED, __HIP_MEMORY_SCOPE_WORKGROUP); }
    else if (valid && bin >= st.tbin[e]) {
        LAS unsigned* ctr = (LAS unsigned*)(ctrs + (2 * hi + e) * 8);
        if (bin > st.tbin[e]) { const unsigned slot = __hip_atomic_fetch_add(ctr, 1u, __ATOMIC_RELAXED, __HIP_MEMORY_SCOPE_WORKGROUP);
            if (slot < 256u) IDX[(tb + posb + e) * 256 + slot] = (unsigned short)key; }
        else { const unsigned cp = __hip_atomic_fetch_add(ctr + 1, 1u, __ATOMIC_RELAXED, __HIP_MEMORY_SCOPE_WORKGROUP);
            if (cp < 256u) { u32x2 cv; cv.x = f2key(sv); cv.y = (unsigned)key; *(LAS u32x2*)(cand + ((2 * hi + e) * 256 + cp) * 8) = cv; } }
    }
}
__device__ __forceinline__ void idx_mfma(ldsp kb, const IdxState& st, f32x16 (&acc)[4]) {
#pragma unroll
    for (int tl = 0; tl < 4; ++tl)
#pragma unroll
        for (int i = 0; i < 16; ++i) acc[tl][i] = 0.f;
#pragma unroll
    for (int tp = 0; tp < 2; ++tp) { bf16x8 b0[4], b1[4];
#pragma unroll
        for (int ks = 0; ks < 4; ++ks) { b0[ks] = ld_lds128(kb + (2 * tp) * 32 * 144 + ks * 32); b1[ks] = ld_lds128(kb + (2 * tp + 1) * 32 * 144 + ks * 32); }
#pragma unroll
        for (int ks = 0; ks < 4; ++ks) { acc[2 * tp] = __builtin_amdgcn_mfma_f32_32x32x16_bf16(st.af[ks], b0[ks], acc[2 * tp], 0, 0, 0); acc[2 * tp + 1] = __builtin_amdgcn_mfma_f32_32x32x16_bf16(st.af[ks], b1[ks], acc[2 * tp + 1], 0, 0, 0); } }
}
template <int PASS>
__device__ __forceinline__ void idx_pass(ldsp lds, IdxState& st, const bf16_t* kg, unsigned short* IDX, size_t tb, int q0, int posb, int wid, int c, int hi, int kst, int nch) {
    ldsp hist = lds + wid * 8192; ldsp cand = hist; ldsp ctrs = lds + 65536 + wid * 32; ldsp kbuf = lds + 81920; const int lo = c * 144 + hi * 16;
    __syncthreads();
    u32x4 kr0 = *(const u32x4*)kg, kr1 = *(const u32x4*)(kg + (size_t)64 * 128);
    *(LAS u32x4*)(kbuf + kst) = kr0; *(LAS u32x4*)(kbuf + 9216 + kst) = kr1;
    if (1 < nch) { kr0 = *(const u32x4*)(kg + (size_t)128 * 128); kr1 = *(const u32x4*)(kg + (size_t)(128 + 64) * 128); *(LAS u32x4*)(kbuf + 18432 + kst) = kr0; *(LAS u32x4*)(kbuf + 18432 + 9216 + kst) = kr1; }
    u32x4 kn0 = kr0, kn1 = kr1;
    if (2 < nch) { kr0 = *(const u32x4*)(kg + (size_t)256 * 128); kr1 = *(const u32x4*)(kg + (size_t)(256 + 64) * 128); }
    if (3 < nch) { kn0 = *(const u32x4*)(kg + (size_t)384 * 128); kn1 = *(const u32x4*)(kg + (size_t)(384 + 64) * 128); }
    __syncthreads();
    f32x16 accA[4], accB[4];
    idx_mfma(kbuf + lo, st, accA);
    int bcur = 0;
#define IDX_STEP(CH, CUR, NXT) do { const int ch_ = (CH); const int bn = bcur == 2 ? 0 : bcur + 1, bw = bn == 2 ? 0 : bn + 1; \
        ldsp kb_ = kbuf + bn * 18432 + lo; float sv_[4][2]; unsigned bin_[4][2]; \
          \
        _Pragma("unroll") for (int tl = 0; tl < 4; ++tl) _Pragma("unroll") for (int i = 0; i < 16; ++i) NXT[tl][i] = 0.f; \
        _Pragma("unroll") for (int ks = 0; ks < 4; ++ks) { \
            bf16x8 f0 = ld_lds128(kb_ + ks * 32), f1 = ld_lds128(kb_ + 4608 + ks * 32), f2 = ld_lds128(kb_ + 9216 + ks * 32), f3 = ld_lds128(kb_ + 13824 + ks * 32); \
            NXT[0] = __builtin_amdgcn_mfma_f32_32x32x16_bf16(st.af[ks], f0, NXT[0], 0, 0, 0); NXT[1] = __builtin_amdgcn_mfma_f32_32x32x16_bf16(st.af[ks], f1, NXT[1], 0, 0, 0); \
            NXT[2] = __builtin_amdgcn_mfma_f32_32x32x16_bf16(st.af[ks], f2, NXT[2], 0, 0, 0); NXT[3] = __builtin_amdgcn_mfma_f32_32x32x16_bf16(st.af[ks], f3, NXT[3], 0, 0, 0); \
            { const int tl = ks;                                     \
              _Pragma("unroll") for (int e = 0; e < 2; ++e) { float s = 0.f; \
                  _Pragma("unroll") for (int h = 0; h < 8; ++h) s = fmaf(st.wq[e][h], __builtin_amdgcn_fmed3f(CUR[tl][2 * h + e], 0.f, 3.0e38f), s); \
                  sv_[tl][e] = s + 0.0f; bin_[tl][e] = (unsigned)__builtin_amdgcn_fmed3f(fmaf(sv_[tl][e], st.bsc[e], st.bof[e]), 0.f, 1023.f); } } } \
        _Pragma("unroll") for (int i = 0; i < 16; ++i) { __builtin_amdgcn_sched_group_barrier(0x008, 1, 0); __builtin_amdgcn_sched_group_barrier(0x002, 14, 0); } \
          \
        _Pragma("unroll") for (int tl = 0; tl < 4; ++tl) { \
            _Pragma("unroll") for (int e = 0; e < 2; ++e) idx_update<PASS>(sv_[tl][e], bin_[tl][e], e, ch_ * 128 + tl * 32 + c, st, hist, cand, ctrs, IDX, tb, posb, hi); } \
        if (ch_ + 2 < nch) { *(LAS u32x4*)(kbuf + bw * 18432 + kst) = kr0; *(LAS u32x4*)(kbuf + bw * 18432 + 9216 + kst) = kr1; } \
        kr0 = kn0; kr1 = kn1; \
        if (ch_ + 4 < nch) { kn0 = *(const u32x4*)(kg + (size_t)(ch_ + 4) * 128 * 128); kn1 = *(const u32x4*)(kg + (size_t)((ch_ + 4) * 128 + 64) * 128); } \
        bcur = bn; __syncthreads(); } while (0)
#pragma unroll 1
    for (int ch = 0; ch < nch; ch += 2) {
        IDX_STEP(ch, accA, accB);
        if (ch + 1 < nch) IDX_STEP(ch + 1, accB, accA);
    }
#undef IDX_STEP
}
__device__ __forceinline__ int indexer_item_fast(ldsp lds, const bf16_t* QB, unsigned short* IDX, int b, int qt) {
    const int tid = otid(), lane = tid & 63, wid = tid >> 6, c = lane & 31, hi = lane >> 5;
    const int q0 = qt * 32; const size_t tb = (size_t)b * SEQ;
    const int posb = q0 + 4 * wid + 2 * hi;
    ldsp hist = lds + wid * 8192;
    ldsp cand = hist;
    ldsp ctrs = lds + 65536 + wid * 32;
    IdxState st;
    { const int r = c, tk = ((r >> 2) & 1) * 2 + (r & 1), hd = (r >> 3) * 2 + ((r >> 1) & 1);
      const bf16_t* qp = QB + (tb + q0 + 4 * wid + tk) * QBLD + 1024 + hd * 64 + hi * 8;
#pragma unroll
      for (int ks = 0; ks < 4; ++ks) st.af[ks] = *(const bf16x8*)(qp + ks * 16); }
#pragma unroll
    for (int e = 0; e < 2; ++e) { const u32x4 wv = *(const u32x4*)(QB + T_KW / 2 + (tb + posb + e) * 128 + 64); float sw = 0.f, sw2 = 0.f;
#pragma unroll
        for (int k = 0; k < 4; ++k) { st.wq[e][2 * k] = bflo(wv[k]) * 0.04419417382415922f; st.wq[e][2 * k + 1] = bfhi(wv[k]) * 0.04419417382415922f; }
#pragma unroll
        for (int h = 0; h < 8; ++h) { sw += st.wq[e][h]; sw2 += st.wq[e][h] * st.wq[e][h]; }
        const float mu = sw * 3.1915382f, sg = sqrtf(sw2 * 21.81f) + 1e-20f;
        st.bsc[e] = 128.0f / sg; st.bof[e] = 256.0f - mu * st.bsc[e];
        st.tbin[e] = 0u; st.cnt[e] = 0u; st.ccnt[e] = 0u; }
    const int nch = (q0 + 32 + 127) >> 7;
    const bf16_t* kg = QB + T_KW / 2 + (tb + (tid >> 3)) * 128 + (tid & 7) * 8;
    const int kst = (tid >> 3) * 144 + (tid & 7) * 16;
#pragma unroll
    for (int i = 0; i < 8; ++i) *(LAS u32x4*)(hist + i * 1024 + lane * 16) = (u32x4){0u, 0u, 0u, 0u};
#ifdef DUMMY_PASS
    idx_pass<2>(lds, st, kg, IDX, tb, q0, posb, wid, c, hi, kst, nch);
#endif
    idx_pass<0>(lds, st, kg, IDX, tb, q0, posb, wid, c, hi, kst, nch);
    unsigned need[2];
    { unsigned nb[4], nn[4];
#pragma unroll
      for (int tq = 0; tq < 4; ++tq) find_bin1k(hist + tq * 2048, 256u, nb[tq], nn[tq]);
#pragma unroll
      for (int e = 0; e < 2; ++e) { st.tbin[e] = hi ? nb[2 + e] : nb[e]; need[e] = hi ? nn[2 + e] : nn[e]; } }
    if (lane < 8) *(LAS unsigned*)(ctrs + lane * 4) = 0u;
    idx_pass<1>(lds, st, kg, IDX, tb, q0, posb, wid, c, hi, kst, nch);
    int ovf = 0;
#pragma unroll 1
    for (int tq = 0; tq < 4; ++tq) {
        const unsigned base = *(LAS const unsigned*)(ctrs + tq * 8), n = *(LAS const unsigned*)(ctrs + tq * 8 + 4);
        const unsigned nd = __shfl(need[tq & 1], (tq >> 1) * 32);
        if (n > 256u) { ovf = 1; }
        else {
#pragma unroll 1
            for (unsigned g0 = 0; g0 < n; g0 += 64) {
                const unsigned ci = g0 + lane;
                const u32x2 mine = ci < n ? *(LAS const u32x2*)(cand + (tq * 256 + ci) * 8) : (u32x2){0u, 0u};
                unsigned rank = 0;
                for (unsigned j = 0; j < n; ++j) { const u32x2 o = *(LAS const u32x2*)(cand + (tq * 256 + j) * 8); rank += (o.x > mine.x || (o.x == mine.x && o.y < mine.y)) ? 1u : 0u; }
                if (ci < n && rank < nd && base + rank < 256u) IDX[(tb + q0 + 4 * wid + tq) * 256 + base + rank] = (unsigned short)mine.y;
            }
        }
    }
    return __syncthreads_or(ovf);
}
__device__ __forceinline__ void indexer_phase(ldsp lds, const Params& p) {
    const bf16_t* QB = (const bf16_t*)(p.ws + WS_TMP + T_QB); unsigned short* IDX = (unsigned short*)(p.ws + WS_TMP + T_IDX);
    for (int s = obx(); s < 256; s += ogd()) {
        int b = s >> 6, j = s & 63;
        if (ogd() == 256) { b = (s & 7) >> 1; j = (s >> 3) * 2 + (s & 1); }
#pragma unroll 1
        for (int k = 0; k < 4; ++k) {
            const int qt = k == 0 ? 255 - j : (k == 1 ? 128 + j : (k == 2 ? 127 - j : j));
#ifndef IDX_SLOW
            if (qt * 32 >= 256) { if (indexer_item_fast(lds, QB, IDX, b, qt)) { indexer_item(lds, QB, IDX, b, qt); __syncthreads(); } }
            else
#endif
            { indexer_item(lds, QB, IDX, b, qt); __syncthreads(); }
        }
    }
}

__device__ __forceinline__ s16x4 tr_read(ldsp p) { typedef short v4i16_t __attribute__((ext_vector_type(4))); return __builtin_bit_cast(s16x4, __builtin_amdgcn_ds_read_tr16_b64_v4i16((LAS v4i16_t*)p)); }
constexpr int XS = 528, CS = 544;
__device__ __forceinline__ void sattn_step(ldsp lds, const Params& p, int b, int si) {
    const int tid = otid(), lane = tid & 63, wid = tid >> 6, fr = lane & 15, g = lane >> 4;
    const bf16_t* QB = (const bf16_t*)(p.ws + WS_TMP + T_QB); const bf16_t* CKVN = (const bf16_t*)(p.ws + WS_TMP + T_CKVN);
    const unsigned short* IDX = (const unsigned short*)(p.ws + WS_TMP + T_IDX); bf16_t* O = (bf16_t*)(p.ws + WS_TMP + T_O);
    const bf16_t* WUK = (const bf16_t*)(p.ws + WS_WL + WL_MIX + WM_UK); const bf16_t* WUV = (const bf16_t*)(p.ws + WS_WL + WL_MIX + WM_UV);
    const size_t tb = (size_t)b * SEQ; const int p0 = si * 16; const size_t t0 = tb + p0;
    ldsp X = lds; ldsp Cw = lds + wid * (32 * CS); ldsp IL = lds + 8 * 32 * CS + wid * 1024;
#pragma unroll 1
    for (int hh = 0; hh < 2; ++hh) { const int h = wid * 2 + hh;
        bf16x8 bq[2]; { const bf16_t* qp = QB + (t0 + fr) * QBLD + h * 64 + g * 8; bq[0] = *(const bf16x8*)qp; bq[1] = *(const bf16x8*)(qp + 32); }
#pragma unroll 16
        for (int rt = 0; rt < 16; ++rt) {
            const bf16_t* wp = WUK + ((size_t)(h * 256 + rt * 16 + fr)) * 64 + g * 8;
            f32x4 acc = {0.f, 0.f, 0.f, 0.f};
            acc = mfma16(*(const bf16x8*)wp, bq[0], acc); acc = mfma16(*(const bf16x8*)(wp + 32), bq[1], acc);
            u32x2 w; w.x = pk2(acc[0], acc[1]); w.y = pk2(acc[2], acc[3]); *(LAS u32x2*)(X + (fr * 16 + h) * XS + (rt * 16 + 4 * g) * 2) = w; } }
    { const u32x2 iv0 = *(const u32x2*)(IDX + (t0 + wid) * 256 + lane * 4), iv1 = *(const u32x2*)(IDX + (t0 + wid + 8) * 256 + lane * 4);
      *(LAS u32x2*)(IL + lane * 8) = iv0; *(LAS u32x2*)(IL + 512 + lane * 8) = iv1; }
    __syncthreads();
    bf16x8 qa[8], qb[8];
#pragma unroll
    for (int ks = 0; ks < 8; ++ks) { qa[ks] = ld_lds128(X + (wid * 16 + fr) * XS + ks * 64 + g * 16); qb[ks] = ld_lds128(X + ((wid + 8) * 16 + fr) * XS + ks * 64 + g * 16); }
    __syncthreads();
    u32x2 olat[2][16];
#pragma unroll 1
    for (int tk = 0; tk < 2; ++tk) {
        const int pos = p0 + wid + 8 * tk; ldsp ILt = IL + tk * 512;
        f32x4 o[16];
#pragma unroll
        for (int i = 0; i < 16; ++i) o[i] = (f32x4){0.f, 0.f, 0.f, 0.f};
        float mrun = -INFINITY, lsum = 0.f;
#pragma unroll 1
        for (int kt = 0; kt < 8; ++kt) {
#pragma unroll
            for (int hf = 0; hf < 2; ++hf) { u32x4 gv[8];
#pragma unroll
              for (int i = 0; i < 8; ++i) { const int row = (hf * 8 + i) * 2 + (lane >> 5); const int key = *(LAS const unsigned short*)(ILt + (kt * 32 + row) * 2);
                  const int kc = key <= pos ? key : 0; gv[i] = *(const u32x4*)(CKVN + (tb + kc) * 256 + (lane & 31) * 8); }
#pragma unroll
              for (int i = 0; i < 8; ++i) { const int row = (hf * 8 + i) * 2 + (lane >> 5); *(LAS u32x4*)(Cw + row * CS + (lane & 31) * 16) = gv[i]; }
              __builtin_amdgcn_sched_barrier(0); }
            f32x4 s0 = {0.f, 0.f, 0.f, 0.f}, s1 = {0.f, 0.f, 0.f, 0.f};
#pragma unroll
            for (int ks = 0; ks < 8; ++ks) { s0 = mfma16(ld_lds128(Cw + fr * CS + ks * 64 + g * 16), qa[ks], s0); s1 = mfma16(ld_lds128(Cw + (16 + fr) * CS + ks * 64 + g * 16), qa[ks], s1); }
            const u32x2 k0 = *(LAS const u32x2*)(ILt + (kt * 32 + 4 * g) * 2), k1 = *(LAS const u32x2*)(ILt + (kt * 32 + 16 + 4 * g) * 2);
            float sv[8];
            sv[0] = (int)(k0.x & 0xFFFFu) <= pos ? s0[0] * 0.125f : -INFINITY; sv[1] = (int)(k0.x >> 16) <= pos ? s0[1] * 0.125f : -INFINITY;
            sv[2] = (int)(k0.y & 0xFFFFu) <= pos ? s0[2] * 0.125f : -INFINITY; sv[3] = (int)(k0.y >> 16) <= pos ? s0[3] * 0.125f : -INFINITY;
            sv[4] = (int)(k1.x & 0xFFFFu) <= pos ? s1[0] * 0.125f : -INFINITY; sv[5] = (int)(k1.x >> 16) <= pos ? s1[1] * 0.125f : -INFINITY;
            sv[6] = (int)(k1.y & 0xFFFFu) <= pos ? s1[2] * 0.125f : -INFINITY; sv[7] = (int)(k1.y >> 16) <= pos ? s1[3] * 0.125f : -INFINITY;
            float tm = fmaxf(fmaxf(fmaxf(sv[0], sv[1]), fmaxf(sv[2], sv[3])), fmaxf(fmaxf(sv[4], sv[5]), fmaxf(sv[6], sv[7])));
            tm = fmaxf(tm, __shfl_xor(tm, 16)); tm = fmaxf(tm, __shfl_xor(tm, 32));
            const float mnew = fmaxf(mrun, tm); const float sc = __expf(mrun - mnew); mrun = mnew;
            float ps = 0.f;
#pragma unroll
            for (int i = 0; i < 8; ++i) { sv[i] = __expf(sv[i] - mnew); ps += sv[i]; }
            lsum = lsum * sc + ps;
#pragma unroll
            for (int i = 0; i < 16; ++i) o[i] = o[i] * sc;
            union { bf16x8 v; unsigned u[4]; } pb; pb.u[0] = pk2(sv[0], sv[1]); pb.u[1] = pk2(sv[2], sv[3]); pb.u[2] = pk2(sv[4], sv[5]); pb.u[3] = pk2(sv[6], sv[7]);
            ldsp tra = Cw + (4 * g + (fr >> 2)) * CS + (fr & 3) * 8;
#pragma unroll
            for (int rt = 0; rt < 16; ++rt) {
                const s16x4 lo = tr_read(tra + rt * 32), hi4 = tr_read(tra + 16 * CS + rt * 32);
                bf16x8 a; a[0] = lo[0]; a[1] = lo[1]; a[2] = lo[2]; a[3] = lo[3]; a[4] = hi4[0]; a[5] = hi4[1]; a[6] = hi4[2]; a[7] = hi4[3];
                o[rt] = mfma16(a, pb.v, o[rt]); if ((rt & 3) == 3) __builtin_amdgcn_sched_barrier(0); }
        }
        lsum += __shfl_xor(lsum, 16); lsum += __shfl_xor(lsum, 32);
        const float inv = 1.0f / lsum;
        if (tk == 0) {
#pragma unroll
            for (int rt = 0; rt < 16; ++rt) { olat[0][rt].x = pk2(o[rt][0] * inv, o[rt][1] * inv); olat[0][rt].y = pk2(o[rt][2] * inv, o[rt][3] * inv); }
#pragma unroll
            for (int ks = 0; ks < 8; ++ks) qa[ks] = qb[ks];
        } else {
#pragma unroll
            for (int rt = 0; rt < 16; ++rt) { olat[1][rt].x = pk2(o[rt][0] * inv, o[rt][1] * inv); olat[1][rt].y = pk2(o[rt][2] * inv, o[rt][3] * inv); }
        }
    }
    __syncthreads();
#pragma unroll
    for (int rt = 0; rt < 16; ++rt) { *(LAS u32x2*)(X + (wid * 16 + fr) * XS + (rt * 16 + 4 * g) * 2) = olat[0][rt]; *(LAS u32x2*)(X + ((wid + 8) * 16 + fr) * XS + (rt * 16 + 4 * g) * 2) = olat[1][rt]; }
    __syncthreads();
#pragma unroll 1
    for (int hh = 0; hh < 2; ++hh) { const int h = wid * 2 + hh;
        bf16x8 ao[8];
#pragma unroll
        for (int ks = 0; ks < 8; ++ks) ao[ks] = ld_lds128(X + (fr * 16 + h) * XS + ks * 64 + g * 16);
#pragma unroll 4
        for (int dt = 0; dt < 4; ++dt) {
            const bf16_t* wp = WUV + ((size_t)(h * 64 + dt * 16 + fr)) * 256 + g * 8;
            f32x4 acc = {0.f, 0.f, 0.f, 0.f};
#pragma unroll
            for (int ks = 0; ks < 8; ++ks) acc = mfma16(ao[ks], *(const bf16x8*)(wp + ks * 32), acc);
#pragma unroll
            for (int j = 0; j < 4; ++j) O[(t0 + 4 * g + j) * 1024 + h * 64 + dt * 16 + fr] = (bf16_t)(pk2(acc[j], 0.f) & 0xFFFFu); } }
    __syncthreads();
}
__device__ __forceinline__ void sattn_phase(ldsp lds, const Params& p) {
    const int G = ogd(), bx = obx();
    if ((G & 7) == 0) {
        const int b = (bx & 7) >> 1, wb = (bx >> 3) * 2 + (bx & 1), nwb = G >> 2;
        for (int si = wb; si < 512; si += nwb) sattn_step(lds, p, b, si);
    } else {
        for (int s = bx; s < 2048; s += G) sattn_step(lds, p, s >> 9, s & 511);
    }
}

constexpr int RS = 272;
__device__ __forceinline__ void conv8(const u32x4 (&raw)[7], const float* cw, const float* cb, int c0, float (&out)[4][8]) {
    float w[4][8], bias[8];
#pragma unroll
    for (int k = 0; k < 4; ++k) { const f32x4 a = *(const f32x4*)(cw + k * 3072 + c0), b = *(const f32x4*)(cw + k * 3072 + c0 + 4);
        w[k][0] = a[0]; w[k][1] = a[1]; w[k][2] = a[2]; w[k][3] = a[3]; w[k][4] = b[0]; w[k][5] = b[1]; w[k][6] = b[2]; w[k][7] = b[3]; }
    { const f32x4 a = *(const f32x4*)(cb + c0), b = *(const f32x4*)(cb + c0 + 4); bias[0] = a[0]; bias[1] = a[1]; bias[2] = a[2]; bias[3] = a[3]; bias[4] = b[0]; bias[5] = b[1]; bias[6] = b[2]; bias[7] = b[3]; }
#pragma unroll
    for (int li = 0; li < 4; ++li)
#pragma unroll
        for (int i = 0; i < 8; ++i) { float v = bias[i];
#pragma unroll
            for (int k = 0; k < 4; ++k) { const unsigned wv = raw[li + k][i >> 1]; v = fmaf(w[k][i], (i & 1) ? bfhi(wv) : bflo(wv), v); }
            out[li][i] = pg8::silu_f(v); }
}
__device__ __forceinline__ float softplus_f(float x) {
    const float u = __expf(-fabsf(x));
    const float l = u < 0.03f ? u * (1.0f - u * (0.5f - u * (0.33333334f - 0.25f * u))) : __logf(1.0f + u);
    return fmaxf(x, 0.f) + l;
}
__device__ __forceinline__ void conv8l(const u32x4 (&raw)[7], LAS const float* wl, int stride, float (&out)[4][8]) {
    { const f32x4 a = *(LAS const f32x4*)(wl + 4 * stride), b = *(LAS const f32x4*)(wl + 4 * stride + 4);
#pragma unroll
      for (int li = 0; li < 4; ++li) { out[li][0] = a[0]; out[li][1] = a[1]; out[li][2] = a[2]; out[li][3] = a[3]; out[li][4] = b[0]; out[li][5] = b[1]; out[li][6] = b[2]; out[li][7] = b[3]; } }
#pragma unroll
    for (int k = 0; k < 4; ++k) { const f32x4 a = *(LAS const f32x4*)(wl + k * stride), b = *(LAS const f32x4*)(wl + k * stride + 4); const float w8[8] = {a[0], a[1], a[2], a[3], b[0], b[1], b[2], b[3]};
#pragma unroll
        for (int li = 0; li < 4; ++li)
#pragma unroll
            for (int i = 0; i < 8; ++i) { const unsigned wv = raw[li + k][i >> 1]; out[li][i] = fmaf(w8[i], (i & 1) ? bfhi(wv) : bflo(wv), out[li][i]); } }
#pragma unroll
    for (int li = 0; li < 4; ++li)
#pragma unroll
        for (int i = 0; i < 8; ++i) out[li][i] = pg8::silu_f(out[li][i]);
}
__device__ __forceinline__ void conv1l(const u32x4 (&raw)[4], LAS const float* wl, int stride, float (&out)[8]) {
#pragma unroll
    for (int i = 0; i < 8; ++i) out[i] = wl[4 * stride + i];
#pragma unroll
    for (int k = 0; k < 4; ++k) { const f32x4 a = *(LAS const f32x4*)(wl + k * stride), b = *(LAS const f32x4*)(wl + k * stride + 4); const float w8[8] = {a[0], a[1], a[2], a[3], b[0], b[1], b[2], b[3]};
#pragma unroll
        for (int i = 0; i < 8; ++i) { const unsigned wv = raw[k][i >> 1]; out[i] = fmaf(w8[i], (i & 1) ? bfhi(wv) : bflo(wv), out[i]); } }
#pragma unroll
    for (int i = 0; i < 8; ++i) out[i] = pg8::silu_f(out[i]);
}
__device__ __forceinline__ void load4(const bf16_t* ZX, size_t tb, int posl, int col, u32x4 (&raw)[4]) {
#pragma unroll
    for (int r = 0; r < 4; ++r) { const int pos = posl - 3 + r; raw[r] = pos >= 0 ? *(const u32x4*)(ZX + (tb + pos) * ZXLD + col) : (u32x4){0u, 0u, 0u, 0u}; }
}
__device__ __forceinline__ void load7(const bf16_t* ZX, size_t tb, int posl0, int col, u32x4 (&raw)[7]) {
#pragma unroll
    for (int r = 0; r < 7; ++r) { const int pos = posl0 - 3 + r; raw[r] = pos >= 0 ? *(const u32x4*)(ZX + (tb + pos) * ZXLD + col) : (u32x4){0u, 0u, 0u, 0u}; }
}
template <bool DRY>
__device__ __forceinline__ void ssd_item(ldsp lds, const Params& p, int sl, int item) {
    const int tid = otid(), lane = tid & 63, wid = tid >> 6, fr = lane & 15, g = lane >> 4;
    const int b = item >> 6, h = (item >> 1) & 31, ph = item & 1, grp = h >> 3;
    bf16_t* ZX = (bf16_t*)(p.ws + WS_TMP + T_ZX); const float* DT = (const float*)(p.ws + WS_TMP + T_DT); float* SSQ = (float*)(p.ws + WS_TMP + T_SSQ);
    const float* cw_ = p.in[13] + (size_t)sl * 4 * 3072; const float* cb_ = p.in[14] + (size_t)sl * 3072;
    const float dtb = p.in[15][sl * 32 + h], av = -__expf(p.in[16][sl * 32 + h]), dsk = p.in[17][sl * 32 + h];
    const size_t tb = (size_t)b * SEQ;
    ldsp Cc = lds, Bc = lds + 34816, BcT = lds + 69632, XdT = lds + 104448, XwT = lds + 113152, Hb = lds + 121856, Xs = lds + 130560;
    LAS float* dtv = (LAS float*)(lds + 140800); LAS float* acs = (LAS float*)(lds + 141312);
    f32x4 hst[2] = {{0.f, 0.f, 0.f, 0.f}, {0.f, 0.f, 0.f, 0.f}};
    for (int i = tid; i < 32 * RS / 4; i += NTHR) ((LAS unsigned*)Hb)[i] = 0u;
    LAS float* cwl = (LAS float*)(lds + 141824);
    for (int i = tid; i < 1440; i += NTHR) { int which, k, ch, chan;
        if (i < 640) { which = 0; k = i >> 7; ch = i & 127; chan = 2048 + grp * 128 + ch; } else if (i < 1280) { which = 1; k = (i - 640) >> 7; ch = (i - 640) & 127; chan = 2560 + grp * 128 + ch; }
        else { which = 2; k = (i - 1280) >> 5; ch = (i - 1280) & 31; chan = h * 64 + ph * 32 + ch; }
        (void)which; cwl[i] = k < 4 ? cw_[k * 3072 + chan] : cb_[chan]; }
    __syncthreads();
    const int cgi = tid & 15, l0s = (tid >> 4) * 4, c0B = 2048 + grp * 128 + cgi * 8, c0C = c0B + 512;
    const int cgx = tid & 3, lx = tid >> 2, c0X = h * 64 + ph * 32 + cgx * 8;
    u32x4 rawB[7], rawC[7], rawX[4]; float dtr0 = 0.f, dtr1 = 0.f;
    load7(ZX, tb, l0s, 2048 + c0C, rawC); load4(ZX, tb, lx, 2048 + c0X, rawX);
    load7(ZX, tb, l0s, 2048 + c0B, rawB);
    if (wid == 7) { dtr0 = DT[(tb + 2 * lane) * 32 + h]; dtr1 = DT[(tb + 2 * lane + 1) * 32 + h]; }
#pragma unroll 1
    for (int c = 0; c < 64; ++c) {
        const int cp = c * 128;
        int tidc = tid; asm volatile("" : "+v"(tidc));
        const int lane = tidc & 63, wid = tidc >> 6, fr = lane & 15, g = lane >> 4;
        const int cgi = tidc & 15, l0s = (tidc >> 4) * 4, c0B = 2048 + grp * 128 + cgi * 8, c0C = c0B + 512;
        const int cgx = tidc & 3, lx = tidc >> 2, c0X = h * 64 + ph * 32 + cgx * 8;
        u32x2 zpre[2];
        { bf16_t* zp = ZX + (tb + cp + 16 * wid + fr) * ZXLD + h * 64 + ph * 32 + 4 * g; zpre[0] = *(const u32x2*)zp; zpre[1] = *(const u32x2*)(zp + 16); }
        if (wid == 7) {
            const float r0 = dtr0 + dtb, r1 = dtr1 + dtb;
            if (c + 1 < 64) { dtr0 = DT[(tb + cp + 128 + 2 * lane) * 32 + h]; dtr1 = DT[(tb + cp + 128 + 2 * lane + 1) * 32 + h]; }
            const float d0 = softplus_f(r0), d1 = softplus_f(r1);
            const float a0 = d0 * av, a1 = d1 * av; float sc = a0 + a1;
#pragma unroll
            for (int d = 1; d < 64; d <<= 1) { const float t = __shfl_up(sc, d); if (lane >= d) sc += t; }
            dtv[2 * lane] = d0; dtv[2 * lane + 1] = d1; acs[2 * lane] = sc - a1; acs[2 * lane + 1] = sc;
        }
        { const int l0 = l0s; float out[4][8];
          conv8l(rawB, cwl + cgi * 8, 128, out);
#pragma unroll
          for (int li = 0; li < 4; ++li) { u32x4 w; w.x = pk2(out[li][0], out[li][1]); w.y = pk2(out[li][2], out[li][3]); w.z = pk2(out[li][4], out[li][5]); w.w = pk2(out[li][6], out[li][7]);
              *(LAS u32x4*)(Bc + (l0 + li) * RS + cgi * 16) = w; }
#pragma unroll
          for (int i = 0; i < 8; ++i) { u32x2 w; w.x = pk2(out[0][i], out[1][i]); w.y = pk2(out[2][i], out[3][i]); *(LAS u32x2*)(BcT + (cgi * 8 + i) * RS + l0 * 2) = w; }
          conv8l(rawC, cwl + 640 + cgi * 8, 128, out);
#pragma unroll
          for (int li = 0; li < 4; ++li) { u32x4 w; w.x = pk2(out[li][0], out[li][1]); w.y = pk2(out[li][2], out[li][3]); w.z = pk2(out[li][4], out[li][5]); w.w = pk2(out[li][6], out[li][7]);
              *(LAS u32x4*)(Cc + (l0 + li) * RS + cgi * 16) = w; }
          if (c + 1 < 64) load7(ZX, tb, cp + 128 + l0, 2048 + c0B, rawB); }
        __syncthreads();
        const float aend = acs[127];
        { float o8[8]; conv1l(rawX, cwl + 1280 + cgx * 8, 32, o8);
          const float dl = dtv[lx], wl = dl * __expf(aend - acs[lx]);
          u32x4 w; w.x = pk2(o8[0], o8[1]); w.y = pk2(o8[2], o8[3]); w.z = pk2(o8[4], o8[5]); w.w = pk2(o8[6], o8[7]);
          *(LAS u32x4*)(Xs + lx * 80 + cgx * 16) = w;
#pragma unroll
          for (int i = 0; i < 8; i += 2) { const int pp = cgx * 8 + i; const unsigned a2 = pk2(o8[i] * dl, o8[i + 1] * dl), b2 = pk2(o8[i] * wl, o8[i + 1] * wl);
              *(LAS unsigned short*)(XdT + pp * RS + lx * 2) = (unsigned short)(a2 & 0xFFFFu); *(LAS unsigned short*)(XdT + (pp + 1) * RS + lx * 2) = (unsigned short)(a2 >> 16);
              *(LAS unsigned short*)(XwT + pp * RS + lx * 2) = (unsigned short)(b2 & 0xFFFFu); *(LAS unsigned short*)(XwT + (pp + 1) * RS + lx * 2) = (unsigned short)(b2 >> 16); } }
        u32x2 mm[8];
        { bf16x8 a[4];
#pragma unroll
          for (int ks = 0; ks < 4; ++ks) a[ks] = ld_lds128(Bc + (16 * wid + fr) * RS + ks * 64 + g * 16);
          float as4[4];
#pragma unroll
          for (int j = 0; j < 4; ++j) as4[j] = acs[16 * wid + 4 * g + j];
#pragma unroll
          for (int lt = 0; lt < 8; ++lt) {
              mm[lt] = (u32x2){0u, 0u};
              if (lt >= wid) {
                  f32x4 acc = {0.f, 0.f, 0.f, 0.f};
#pragma unroll
                  for (int ks = 0; ks < 4; ++ks) acc = mfma16(a[ks], ld_lds128(Cc + (lt * 16 + fr) * RS + ks * 64 + g * 16), acc);
                  const int l = lt * 16 + fr; const float al = acs[l]; float v[4];
#pragma unroll
                  for (int j = 0; j < 4; ++j) { const int s = 16 * wid + 4 * g + j; v[j] = (s <= l) ? acc[j] * __expf(al - as4[j]) : 0.f; }
                  mm[lt].x = pk2(v[0], v[1]); mm[lt].y = pk2(v[2], v[3]); } } }
        __syncthreads();
#pragma unroll
        for (int lt = 0; lt < 8; ++lt) *(LAS u32x2*)(Bc + (lt * 16 + fr) * RS + (16 * wid + 4 * g) * 2) = mm[lt];
        __syncthreads();
        if (c + 1 < 64) { load7(ZX, tb, cp + 128 + l0s, 2048 + c0C, rawC); load4(ZX, tb, cp + 128 + lx, 2048 + c0X, rawX); }
        { f32x4 y1[2] = {{0.f, 0.f, 0.f, 0.f}, {0.f, 0.f, 0.f, 0.f}}, y2[2] = {{0.f, 0.f, 0.f, 0.f}, {0.f, 0.f, 0.f, 0.f}};
          const int l = 16 * wid + fr;
#pragma unroll
          for (int ks = 0; ks < 4; ++ks) {
              const bf16x8 bm = ld_lds128(Bc + l * RS + ks * 64 + g * 16), bc = ld_lds128(Cc + l * RS + ks * 64 + g * 16);
#pragma unroll
              for (int pt = 0; pt < 2; ++pt) { y1[pt] = mfma16(ld_lds128(XdT + (pt * 16 + fr) * RS + ks * 64 + g * 16), bm, y1[pt]); y2[pt] = mfma16(ld_lds128(Hb + (pt * 16 + fr) * RS + ks * 64 + g * 16), bc, y2[pt]); } }
          const float el = __expf(acs[l]); const size_t tg = tb + cp + l; float sq = 0.f;
#pragma unroll
          for (int pt = 0; pt < 2; ++pt) { const int pp = pt * 16 + 4 * g;
              const u32x2 xs2 = *(LAS const u32x2*)(Xs + l * 80 + pp * 2); bf16_t* zp = ZX + tg * ZXLD + h * 64 + ph * 32 + pp; const u32x2 z2 = zpre[pt];
              float yv[4], xv[4] = {bflo(xs2.x), bfhi(xs2.x), bflo(xs2.y), bfhi(xs2.y)}, zv[4] = {bflo(z2.x), bfhi(z2.x), bflo(z2.y), bfhi(z2.y)};
#pragma unroll
              for (int j = 0; j < 4; ++j) { yv[j] = (y1[pt][j] + el * y2[pt][j] + xv[j] * dsk) * pg8::silu_f(zv[j]); sq += yv[j] * yv[j]; }
              u32x2 w; w.x = pk2(yv[0], yv[1]); w.y = pk2(yv[2], yv[3]);
              if (DRY) *(u32x2*)((bf16_t*)(p.ws + WS_END + 65536) + (((size_t)(zp - ZX)) & 0xFFFFFCull)) = w; else *(u32x2*)zp = w; }
          sq += __shfl_xor(sq, 16); sq += __shfl_xor(sq, 32);
          if (g == 0) { if (DRY) ((float*)(p.ws + WS_END + 65536 + 40000000))[(tg * 64 + h * 2 + ph) & 0xFFFFF] = sq; else SSQ[tg * 64 + h * 2 + ph] = sq; } }
        { const float dec = __expf(aend);
          hst[0] = hst[0] * dec; hst[1] = hst[1] * dec;
#pragma unroll
          for (int ks = 0; ks < 4; ++ks) { const bf16x8 ab = ld_lds128(BcT + (16 * wid + fr) * RS + ks * 64 + g * 16);
#pragma unroll
              for (int pt = 0; pt < 2; ++pt) hst[pt] = mfma16(ab, ld_lds128(XwT + (pt * 16 + fr) * RS + ks * 64 + g * 16), hst[pt]); } }
        __syncthreads();
#pragma unroll
        for (int pt = 0; pt < 2; ++pt) { u32x2 w; w.x = pk2(hst[pt][0], hst[pt][1]); w.y = pk2(hst[pt][2], hst[pt][3]); *(LAS u32x2*)(Hb + (pt * 16 + fr) * RS + (16 * wid + 4 * g) * 2) = w; }
    }
    __syncthreads();
}
__device__ __forceinline__ void ssd_norm_phase(const Params& p) {
    bf16_t* ZX = (bf16_t*)(p.ws + WS_TMP + T_ZX); const float* SSQ = (const float*)(p.ws + WS_TMP + T_SSQ);
    const int tid_ = otid(); const int lane = tid_ & 63, gw = obx() * 8 + (tid_ >> 6), nw = ogd() * 8;
    for (int row0 = gw; row0 < MT; row0 += 2 * nw) {
        float part[2]; u32x4 v[2][4];
#pragma unroll
        for (int r = 0; r < 2; ++r) { const int row = row0 + r * nw; const size_t rr = (size_t)(row < MT ? row : row0);
            part[r] = SSQ[rr * 64 + lane];
#pragma unroll
            for (int i = 0; i < 4; ++i) v[r][i] = *(const u32x4*)(ZX + rr * ZXLD + i * 512 + lane * 8); }
#pragma unroll
        for (int r = 0; r < 2; ++r) { const int row = row0 + r * nw;
            float pt = part[r]; pt += __shfl_xor(pt, 1); pt += __shfl_xor(pt, 2); pt += __shfl_xor(pt, 4); pt += __shfl_xor(pt, 8);
#pragma unroll
            for (int i = 0; i < 4; ++i) { const float rs = rsqrtf(__shfl(pt, i * 16) * (1.0f / 512.0f) + RMS_EPS); u32x4 w;
#pragma unroll
                for (int k = 0; k < 4; ++k) w[k] = pk2(bflo(v[r][i][k]) * rs, bfhi(v[r][i][k]) * rs);
                if (row < MT) *(u32x4*)(ZX + (size_t)row * ZXLD + i * 512 + lane * 8) = w; } }
    }
}

#define XB_TMO      128
#define XB_XCNT(j)  (256  + 64 * (j))
#define XB_XSUB(j)  (1280 + 64 * (j))
#define XB_XGEN(j)  (2304 + 64 * (j))
#define XB_TOP      3328
#define XB_TOPGEN   3392
#define XCD_BAR_WORDS 3456
#define XB_SPIN_CAP (1u << 20)
__device__ __forceinline__ unsigned xb_ld(unsigned* p)              { return __hip_atomic_load(p, __ATOMIC_RELAXED, __HIP_MEMORY_SCOPE_AGENT); }
__device__ __forceinline__ unsigned xb_add(unsigned* p, unsigned v) { return __hip_atomic_fetch_add(p, v, __ATOMIC_RELAXED, __HIP_MEMORY_SCOPE_AGENT); }
__device__ __forceinline__ unsigned xb_xcc_id() { return (unsigned)__builtin_amdgcn_s_getreg((3 << 11) | 20) & 0xFu; }
#define XB_SPIN(cond, bar) do { unsigned _sp = 0; while (cond) { __builtin_amdgcn_s_sleep(1); \
    if ((++_sp & 255u) == 0u) { if (xb_ld(&(bar)[XB_TMO])) break; if (_sp > XB_SPIN_CAP) { atomicAdd(&(bar)[XB_TMO], 1u); break; } } } } while (0)
struct XcdBarrier { unsigned* bar; unsigned x; volatile LAS unsigned* st; };
__device__ __forceinline__ void xcd_barrier_complete(unsigned* bar, unsigned x, unsigned& nloc, unsigned& nx) {
    const unsigned G = gridDim.x * gridDim.y * gridDim.z;
    unsigned sum, cnt, mine, sp = 0u;
    for (;;) {
        sum = 0u; cnt = 0u; mine = 0u;
#pragma unroll
        for (unsigned j = 0; j < 16; ++j) { const unsigned c = xb_ld(&bar[XB_XCNT(j)]); sum += c; cnt += (c > 0u) ? 1u : 0u; mine = (j == x) ? c : mine; }
        if (sum == G) break;
        __builtin_amdgcn_s_sleep(1);
        if ((++sp & 255u) == 0u) { if (xb_ld(&bar[XB_TMO])) break; if (sp > XB_SPIN_CAP) { atomicAdd(&bar[XB_TMO], 1u); break; } }
    }
    nloc = mine > 0u ? mine : 1u; nx = cnt > 0u ? cnt : 1u;
}
__device__ __forceinline__ void xcd_barrier(const XcdBarrier& b) {
    asm volatile("s_waitcnt vmcnt(0)" ::: "memory");
    __syncthreads();
    if (otid() == 0) {
        unsigned* bar = b.bar;
        __builtin_amdgcn_s_waitcnt(0);
        unsigned nloc = b.st[0], nx = b.st[1];
        if (nloc == 0u) { xcd_barrier_complete(bar, b.x, nloc, nx); b.st[0] = nloc; b.st[1] = nx; }
        const unsigned old = xb_add(&bar[XB_XSUB(b.x)], 1u);
        const unsigned gen = old / nloc;
        if (old + 1u == (gen + 1u) * nloc) {
            __builtin_amdgcn_fence(__ATOMIC_RELEASE, "agent");
            asm volatile("s_waitcnt vmcnt(0)" ::: "memory");
            const unsigned og = xb_add(&bar[XB_TOP], 1u);
            const unsigned tg = og / nx;
            if (og + 1u == (tg + 1u) * nx) xb_add(&bar[XB_TOPGEN], 1u);
            else XB_SPIN(xb_ld(&bar[XB_TOPGEN]) == tg, bar);
            __builtin_amdgcn_fence(__ATOMIC_ACQUIRE, "agent");
            xb_add(&bar[XB_XGEN(b.x)], 1u);
            asm volatile("s_waitcnt vmcnt(0)" ::: "memory");
        } else {
            XB_SPIN(xb_ld(&bar[XB_XGEN(b.x)]) == gen, bar);
            __builtin_amdgcn_fence(__ATOMIC_ACQUIRE, "agent");
            asm volatile("s_waitcnt vmcnt(0)" ::: "memory");
        }
    }
    __syncthreads();
}
constexpr size_t WS_BAR = WS_END;
constexpr int LDS_BARST = LDS_BYTES - 16;
#define GRID_BAR() do { XcdBarrier _b; { const Params _q = load_params(); _b.bar = (unsigned*)(_q.ws + WS_BAR); } _b.x = xb_xcc_id(); _b.st = (volatile LAS unsigned*)(lds + LDS_BARST); xcd_barrier(_b); } while (0)

__global__ void __launch_bounds__(NTHR, 2) fwd_megakernel(Params p) {
    extern __shared__ __attribute__((aligned(16))) unsigned char smem[];
    ldsp lds = (ldsp)smem;
    cg::grid_group grid = cg::this_grid();
    if (otid() == 0) { ((volatile LAS unsigned*)(lds + LDS_BARST))[0] = 0u; ((volatile LAS unsigned*)(lds + LDS_BARST))[1] = 0u; }
    __syncthreads();
    { const Params q = load_params(); if (otid() == 0) (void)xb_add(&((unsigned*)(q.ws + WS_BAR))[XB_XCNT(xb_xcc_id())], 1u); }
    { const Params q = load_params(); cvt_x_phase(q.in[0], (bf16_t*)(q.ws + WS_XB)); }
#ifndef NO_CONV
    { const Params q = load_params(); convert_layer(lds, q, 0); }
#endif
    if (ogd() == 0x7FFFFFF) grid.sync();
    GRID_BAR();
#pragma unroll 1
    for (int sub = 0; sub < 12; ++sub) {
        const int L = sub / 3, kind = sub % 3, sl = L >> 1; const bool attn = (L & 1) == 0;
#if defined(SKIP_ATTN) || defined(SKIP_SSM)
        {
#if defined(SKIP_ATTN) && defined(SKIP_SSM)
            const bool skip = kind == 1;
#elif defined(SKIP_ATTN)
            const bool skip = kind == 1 && attn;
#else
            const bool skip = kind == 1 && !attn;
#endif
            if (skip) { const Params q = load_params(); ln_phase<false>(q.out, (bf16_t*)(q.ws + WS_XB), q.in[1] + (size_t)(L * 3 + kind) * DM, q.in[2] + (size_t)(L * 3 + kind) * DM, nullptr, sub == 11); GRID_BAR(); continue; }
        }
#endif
        if (kind != 1) {
            const Params q = load_params(); const int G = ogd(), bx = obx();
            pg8::Gemm gm{(const bf16_t*)(q.ws + WS_XB), (const bf16_t*)(q.ws + WS_WL + (kind == 0 ? WL_F1IN : WL_F2IN)), MT, 5632, 1024, 1024}; pg8::StaticOrder S; S.init(MT, 5632, G, bx);
            pg8::EpiSwiglu E{(bf16_t*)(q.ws + WS_TMP + T_H)};
            pg8::gemm_phase<pg8::EpiSwiglu, pg8::StaticOrder>((PG8_LAS unsigned char*)lds, gm, S, E, nullptr);
        } else {
            const Params q = load_params(); const int G = ogd(), bx = obx(); unsigned char* tmp = q.ws + WS_TMP;
            const int N = attn ? 2048 : 5376;
            pg8::Gemm gm{(const bf16_t*)(q.ws + WS_XB), (const bf16_t*)(q.ws + WS_WL + WL_MIX), MT, N, 1024, 1024}; pg8::StaticOrder S; S.init(MT, N, G, bx);
            pg8::EpiSplit E{(bf16_t*)tmp, attn ? QBLD : ZXLD, attn ? 7 : 20, (float*)(tmp + (attn ? T_CKV : T_DT)), attn ? 256 : 32, attn ? 256 : 32, (bf16_t*)(tmp + T_KW), attn ? 6 : -1};
            pg8::gemm_phase<pg8::EpiSplit, pg8::StaticOrder>((PG8_LAS unsigned char*)lds, gm, S, E, nullptr);
        }
        GRID_BAR();
        if (kind == 1) {
            if (attn) {
                { const Params q = load_params(); ckv_norm_phase((const float*)(q.ws + WS_TMP + T_CKV), (bf16_t*)(q.ws + WS_TMP + T_CKVN), q.in[8] + (size_t)sl * 256); }
#ifndef NO_IDX
                { const Params q = load_params(); indexer_phase(lds, q); }
#ifdef DBL_IDX
                { const Params q = load_params(); indexer_phase(lds, q); }
#endif
#endif
                GRID_BAR();
#ifndef NO_SATTN
                { const Params q = load_params(); sattn_phase(lds, q); }
#ifdef DBL_SATTN
                { const Params q = load_params(); sattn_phase(lds, q); }
#endif
#else
                { const Params q = load_params(); u32x4* Oz = (u32x4*)(q.ws + WS_TMP + T_O); for (size_t i = (size_t)obx() * NTHR + otid(); i < (size_t)MT * 1024 / 8; i += (size_t)ogd() * NTHR) Oz[i] = (u32x4){0u, 0u, 0u, 0u}; }
#endif
                GRID_BAR();
            } else {
#ifndef NO_SSD
#ifdef DBL_SSD
                { const Params q = load_params(); const int G = ogd(); for (int it = obx(); it < 256; it += G) ssd_item<true>(lds, q, sl, it); }
#endif
                { const Params q = load_params(); const int G = ogd();
                  for (int it = obx(); it < 256; it += G) { int item = it;
                      if (G == 256) { const int xcd = it & 7, slot = it >> 3, bg = xcd * 2 + (slot >> 4), wi = slot & 15; item = ((bg >> 2) << 6) | ((((bg & 3) * 8) + (wi >> 1)) << 1) | (wi & 1); }
                      ssd_item<false>(lds, q, sl, item); } }
#endif
                GRID_BAR();
                { const Params q = load_params(); ssd_norm_phase(q); }
                GRID_BAR();
            }
        }
        {
            const Params q = load_params(); const int G = ogd(), bx = obx(); unsigned char* tmp = q.ws + WS_TMP; unsigned char* wl = q.ws + WS_WL;
            const bf16_t* A2 = (const bf16_t*)(tmp + T_H); int K2 = DFF, lda2 = DFF; const bf16_t* B2 = (const bf16_t*)(wl + (kind == 0 ? WL_F1OUT : WL_F2OUT)); float sc2 = 0.5f;
            if (kind == 1) { sc2 = 1.0f;
                if (attn) { A2 = (const bf16_t*)(tmp + T_O); K2 = 1024; lda2 = 1024; B2 = (const bf16_t*)(wl + WL_MIX + WM_AOUT); }
                else { A2 = (const bf16_t*)(tmp + T_ZX); K2 = 2048; lda2 = ZXLD; B2 = (const bf16_t*)(wl + WL_MIX + WM_SOUT); } }
            pg8::Gemm gm{A2, B2, MT, 1024, K2, lda2}; pg8::StaticOrder S; S.init(MT, 1024, G, bx);
            pg8::EpiResid E{(bf16_t*)(q.ws + WS_XB), ALPHA, sc2};
            pg8::gemm_phase<pg8::EpiResid, pg8::StaticOrder>((PG8_LAS unsigned char*)lds, gm, S, E, nullptr);
        }
        GRID_BAR();
#ifdef DBL_LN
        { const Params q = load_params(); ln_phase<true>(q.out, (bf16_t*)(q.ws + WS_XB), q.in[1] + (size_t)(L * 3 + kind) * DM, q.in[2] + (size_t)(L * 3 + kind) * DM, q.ws + WS_END + 65536, sub == 11); }
#endif
        { const Params q = load_params(); ln_phase<false>(q.out, (bf16_t*)(q.ws + WS_XB), q.in[1] + (size_t)(L * 3 + kind) * DM, q.in[2] + (size_t)(L * 3 + kind) * DM, nullptr, sub == 11); }
#ifndef NO_CONV
        if (kind == 2 && L < 3) { const Params q = load_params(); convert_layer(lds, q, L + 1); }
#endif
        GRID_BAR();
    }
}

extern "C" void kernel_launch(void* const* d_in, const int* in_sizes, int n_in, void* d_out, int out_size, void* d_ws, size_t ws_size, hipStream_t stream) {
    static int grid_blocks = 0;
    if (grid_blocks == 0) {
        if (n_in != 20 || ws_size < WS_END + XCD_BAR_WORDS * 4) { fprintf(stderr, "kernel_launch: unexpected inputs (n_in %d, ws %zu < %zu)\n", n_in, ws_size, (size_t)WS_END); grid_blocks = -1; return; }
        int dev = 0, cus = 0, per_cu = 0;
        hipGetDevice(&dev); hipDeviceGetAttribute(&cus, hipDeviceAttributeMultiprocessorCount, dev);
        if (hipFuncSetAttribute((const void*)fwd_megakernel, hipFuncAttributeMaxDynamicSharedMemorySize, LDS_BYTES) != hipSuccess) { fprintf(stderr, "kernel_launch: hipFuncSetAttribute failed\n"); grid_blocks = -1; return; }
        hipOccupancyMaxActiveBlocksPerMultiprocessor(&per_cu, (const void*)fwd_megakernel, NTHR, LDS_BYTES);
        if (per_cu < 1) { fprintf(stderr, "kernel_launch: occupancy query says %d blocks per CU\n", per_cu); per_cu = 1; }
        (void)hipGetLastError();
        grid_blocks = cus * per_cu;
    }
    if (grid_blocks < 0) return;
    if (hipMemsetAsync((char*)d_ws + WS_BAR, 0, XCD_BAR_WORDS * 4, stream) != hipSuccess) { fprintf(stderr, "kernel_launch: memset of the barrier words failed\n"); return; }
    Params p{};
    for (int i = 0; i < 20; ++i) p.in[i] = (const float*)d_in[i];
    p.out = (float*)d_out; p.ws = (unsigned char*)d_ws;
    void* args[] = {&p};
    hipError_t e = hipLaunchCooperativeKernel((const void*)fwd_megakernel, dim3(grid_blocks), dim3(NTHR), args, LDS_BYTES, stream);
    if (e != hipSuccess) fprintf(stderr, "cooperative launch failed: %s (grid %d)\n", hipGetErrorString(e), grid_blocks);
}
```

```cpp
#include <hip/hip_runtime.h>
#include <hip/hip_cooperative_groups.h>
#include <cstdio>
namespace cg = cooperative_groups;
namespace pg8 {
#define PG8_LAS __attribute__((address_space(3)))
typedef unsigned short bf16_t;
typedef short bf16x8 __attribute__((ext_vector_type(8)));
typedef float f32x4 __attribute__((ext_vector_type(4)));
typedef unsigned u32x4 __attribute__((ext_vector_type(4)));
constexpr int BM = 256, BK = 64, HALF = 128, HTB = HALF * BK * 2  , STAGE_BYTES = 8 * HTB, NXCD = 8, WGM = 8;

__host__ __device__ __forceinline__ int lds_byte(int r, int c) { const int st = (r >> 4) * 2 + (c >> 5), rr = r & 15, cc = c & 31, ob = rr * 64 + cc * 2; return st * 1024 + (ob ^ (((ob >> 9) & 1) << 5)); }
__host__ __device__ __forceinline__ void stage_rc(int b, int& R, int& C) { const int st = b / 1024, sb = b % 1024, swz = sb ^ (((sb >> 9) & 1) << 5); R = (st >> 1) * 16 + swz / 64; C = (st & 1) * 32 + (swz % 64) / 2; }
__host__ __device__ __forceinline__ int perm32(int rho) { const int n = rho >> 4, i = rho & 15; return 8 * (i >> 2) + 4 * n + (i & 3); }

struct Unit { int pm, pn; };
struct Gemm { const bf16_t* A; const bf16_t* Bt; int M, N, K, lda; };

struct StaticOrder {
    int nM, nN, nwg, G, c;
    __host__ __device__ void init(int M, int N, int G_, int c_) { nM = M / BM; nN = N / BM; nwg = nM * nN; G = G_; c = c_; }
    __host__ __device__ bool next(int i, Unit& u) const {
        const long L = (long)i * G + c; if (L >= nwg) return false;
        int wgid = (int)L; { const int q = nwg / NXCD, r = nwg % NXCD, xcd = wgid % NXCD, off = wgid / NXCD; wgid = (xcd < r ? xcd * (q + 1) : r * (q + 1) + (xcd - r) * q) + off; }
        const int nig = WGM * nN, gid = wgid / nig, fm = gid * WGM, gsz = (nM - fm) < WGM ? (nM - fm) : WGM;
        u.pm = fm + ((wgid % nig) % gsz); u.pn = (wgid % nig) / gsz; return true;
    }
    __device__ __forceinline__ void a_ready(const Unit&) const {}
    __device__ __forceinline__ void done(const Unit&) const {}
};
typedef __bf16 bf16x2_t __attribute__((ext_vector_type(2)));
typedef float f32x2_t __attribute__((ext_vector_type(2)));
__device__ __forceinline__ unsigned cvt_pk_bf16(float lo, float hi) { const f32x2_t f = {lo, hi}; const bf16x2_t v = __builtin_convertvector(f, bf16x2_t); return __builtin_bit_cast(unsigned, v); }
__device__ __forceinline__ float silu_f(float x) { return x * __builtin_amdgcn_rcpf(1.0f + __expf(-x)); }
struct EpiSwiglu {
    static constexpr bool PERM = true, AFTER_DRAIN = false;
    bf16_t* H;
    __device__ __forceinline__ void operator()(const f32x4 (&acc)[2][2][4][2], const Unit& u, int wr, int wc, int fr, int fq) const {
        const int row0 = u.pm * BM + wr * 64 + fr, col0 = u.pn * 128 + wc * 32 + 8 * fq;
#pragma unroll
        for (int ai = 0; ai < 2; ++ai)
#pragma unroll
            for (int m = 0; m < 4; ++m) {
                bf16_t* rowp = H + (size_t)(row0 + ai * HALF + m * 16) * 2816 + col0;
                const f32x4 g0 = acc[ai][0][m][0], g1 = acc[ai][0][m][1], u0 = acc[ai][1][m][0], u1 = acc[ai][1][m][1];
                u32x4 w;
                w.x = cvt_pk_bf16(silu_f(g0[0]) * u0[0], silu_f(g0[1]) * u0[1]); w.y = cvt_pk_bf16(silu_f(g0[2]) * u0[2], silu_f(g0[3]) * u0[3]);
                w.z = cvt_pk_bf16(silu_f(g1[0]) * u1[0], silu_f(g1[1]) * u1[1]); w.w = cvt_pk_bf16(silu_f(g1[2]) * u1[2], silu_f(g1[3]) * u1[3]);
                *(u32x4*)rowp = w; }
    }
};
struct EpiResid {
    static constexpr bool PERM = false, AFTER_DRAIN = false;
    bf16_t* X; float alpha, scale;
    __device__ __forceinline__ void operator()(const f32x4 (&acc)[2][2][4][2], const Unit& u, int wr, int wc, int fr, int fq) const {
        const int row0 = u.pm * BM + wr * 64 + fr, col0 = u.pn * BM + wc * 32 + 4 * fq;
        typedef unsigned u32x2_t __attribute__((ext_vector_type(2)));
#pragma unroll
        for (int ai = 0; ai < 2; ++ai)
#pragma unroll
            for (int m = 0; m < 4; ++m) { const size_t ro = (size_t)(row0 + ai * HALF + m * 16) * 1024 + col0;
#pragma unroll
                for (int bj = 0; bj < 2; ++bj)
#pragma unroll
                    for (int n = 0; n < 2; ++n) { const size_t o = ro + bj * HALF + n * 16; const u32x2_t rb = *(const u32x2_t*)(X + o);
                        f32x4 r; r[0] = __uint_as_float(rb.x << 16); r[1] = __uint_as_float(rb.x & 0xFFFF0000u); r[2] = __uint_as_float(rb.y << 16); r[3] = __uint_as_float(rb.y & 0xFFFF0000u);
                        const f32x4 y = r * alpha + acc[ai][bj][m][n] * scale; u32x2_t w; w.x = cvt_pk_bf16(y[0], y[1]); w.y = cvt_pk_bf16(y[2], y[3]); *(u32x2_t*)(X + o) = w; } }
    }
};
struct EpiSplit {
    static constexpr bool PERM = true, AFTER_DRAIN = false;
    bf16_t* O; int ldo; int nb16; float* F; int ldf; int fcols; bf16_t* O2; int pn2;
    __device__ __forceinline__ void operator()(const f32x4 (&acc)[2][2][4][2], const Unit& u, int wr, int wc, int fr, int fq) const {
        const int row0 = u.pm * BM + wr * 64 + fr;
        if (u.pn < nb16) {
            const int col0 = u.pn * BM + wc * 32 + 8 * fq;
#pragma unroll
            for (int ai = 0; ai < 2; ++ai)
#pragma unroll
                for (int m = 0; m < 4; ++m) { bf16_t* rowp = O + (size_t)(row0 + ai * HALF + m * 16) * ldo + col0;
#pragma unroll
                    for (int bj = 0; bj < 2; ++bj) { const f32x4 v0 = acc[ai][bj][m][0], v1 = acc[ai][bj][m][1]; u32x4 w;
                        w.x = cvt_pk_bf16(v0[0], v0[1]); w.y = cvt_pk_bf16(v0[2], v0[3]); w.z = cvt_pk_bf16(v1[0], v1[1]); w.w = cvt_pk_bf16(v1[2], v1[3]);
                        *(u32x4*)(rowp + bj * HALF) = w;
                        if (u.pn == pn2 && bj == 0) *(u32x4*)(O2 + (size_t)(row0 + ai * HALF + m * 16) * 128 + wc * 32 + 8 * fq) = w; } }
        } else {
            const int col0 = (u.pn - nb16) * BM + wc * 32 + 8 * fq;
#pragma unroll
            for (int ai = 0; ai < 2; ++ai)
#pragma unroll
                for (int m = 0; m < 4; ++m) { float* rowp = F + (size_t)(row0 + ai * HALF + m * 16) * ldf;
#pragma unroll
                    for (int bj = 0; bj < 2; ++bj) { const int c = col0 + bj * HALF;
                        if (c < fcols) { *(f32x4*)(rowp + c) = acc[ai][bj][m][0]; *(f32x4*)(rowp + c + 4) = acc[ai][bj][m][1]; } } }
        }
    }
};
template <class Epi, class Sched, bool STAMP = false>
__device__ __forceinline__ void gemm_phase(PG8_LAS unsigned char* lds, const Gemm g, const Sched& S, const Epi& E, unsigned long long* stamps) {
    int tid = threadIdx.x; asm volatile("" : "+v"(tid)); const int wid = __builtin_amdgcn_readfirstlane(tid >> 6), lane = tid & 63, wr = wid >> 2, wc = wid & 3, fr = lane & 15, fq = lane >> 4;
    const int K = g.K, nt = K / BK;
    int ts_lo = 0, ts_hi = 0, nts = 0; const unsigned long long rt_entry = STAMP ? (unsigned long long)wall_clock64() : 0ull;
#define PG8_STAMP() do { if (STAMP && wid == 0 && nts < 64) { const unsigned long long _c = (unsigned long long)clock64(); \
        ts_lo = (lane == nts) ? (int)(unsigned)_c : ts_lo; ts_hi = (lane == nts) ? (int)(unsigned)(_c >> 32) : ts_hi; ++nts; } } while (0)
    PG8_STAMP();
    unsigned voffA[2], voffB[2];
#pragma unroll
    for (int i = 0; i < 2; ++i) { int R, C; stage_rc(tid * 16 + i * 8192, R, C); const int Rb = Epi::PERM ? ((R & ~31) + perm32(R & 31)) : R;
        voffA[i] = (unsigned)(R * g.lda + C) * 2u; voffB[i] = (unsigned)(Rb * K + C) * 2u; }
    const size_t kstep = (size_t)(BK * 2);
    const size_t hstep = (size_t)HALF * K * 2;
    const size_t tstep = 2 * hstep; const size_t hstepA = (size_t)HALF * g.lda * 2; const size_t tstepA = 2 * hstepA;
    const unsigned ldsw = (unsigned)wid * 1024u;
    const int aoff = lds_byte(wr * 64 + fr, fq * 8), boff = lds_byte(wc * 32 + fr, fq * 8);
#define PG8_SA(b, h) (((b) * 2 + (h)) * HTB)
#define PG8_SB(b, h) ((4 + (b) * 2 + (h)) * HTB)
#define PG8_STAGE(bufoff, gbase, voff) do { _Pragma("unroll") for (int _i = 0; _i < 2; ++_i) \
        __builtin_amdgcn_global_load_lds((const unsigned*)((const char*)(gbase) + (voff)[_i]), (PG8_LAS unsigned*)(lds + (bufoff) + ldsw + _i * 8192), 16, 0, 0); } while (0)
#define PG8_LDA(dst, b, h) do { _Pragma("unroll") for (int m = 0; m < 4; ++m) _Pragma("unroll") for (int k = 0; k < 2; ++k) dst[m][k] = *(const PG8_LAS bf16x8*)(lds + PG8_SA(b, h) + aoff + m * 2048 + k * 1024); } while (0)
#define PG8_LDB(dst, b, h) do { _Pragma("unroll") for (int n = 0; n < 2; ++n) _Pragma("unroll") for (int k = 0; k < 2; ++k) dst[n][k] = *(const PG8_LAS bf16x8*)(lds + PG8_SB(b, h) + boff + n * 2048 + k * 1024); } while (0)
#define PG8_MMA(ai, bj, At, Bt) do { __builtin_amdgcn_s_setprio(1); _Pragma("unroll") for (int m = 0; m < 4; ++m) _Pragma("unroll") for (int n = 0; n < 2; ++n) _Pragma("unroll") for (int k = 0; k < 2; ++k) \
        acc[ai][bj][m][n] = __builtin_amdgcn_mfma_f32_16x16x32_bf16(Bt[n][k], At[m][k], acc[ai][bj][m][n], 0, 0, 0); __builtin_amdgcn_s_setprio(0); } while (0)
#define PG8_WAIT_V(n) asm volatile("s_waitcnt vmcnt(" #n ")" ::: "memory")
#define PG8_WAIT_L(n) asm volatile("s_waitcnt lgkmcnt(" #n ")" ::: "memory")
#define PG8_BAR __builtin_amdgcn_s_barrier()
#define PG8_SCHED __builtin_amdgcn_sched_barrier(0)
    Unit cur, nxt; int ui = 0;
    if (!S.next(0, cur)) return;
    f32x4 acc[2][2][4][2];
#pragma unroll
    for (int a = 0; a < 2; ++a)
#pragma unroll
        for (int b = 0; b < 2; ++b)
#pragma unroll
            for (int m = 0; m < 4; ++m)
#pragma unroll
                for (int n = 0; n < 2; ++n) acc[a][b][m][n] = (f32x4){0.f, 0.f, 0.f, 0.f};
    bf16x8 At[4][2], B0[2][2], B1[2][2];
    const char* cA = (const char*)g.A + (size_t)cur.pm * tstepA; const char* cB = (const char*)g.Bt + (size_t)cur.pn * tstep;
    S.a_ready(cur);
    PG8_STAGE(PG8_SB(0, 0), cB, voffB); PG8_STAGE(PG8_SA(0, 0), cA, voffA); PG8_STAGE(PG8_SB(0, 1), cB + hstep, voffB); PG8_STAGE(PG8_SA(0, 1), cA + hstepA, voffA);
    if (wr == 1) PG8_BAR;
    PG8_WAIT_V(4); PG8_BAR;
    PG8_STAGE(PG8_SB(1, 0), cB + kstep, voffB); PG8_STAGE(PG8_SA(1, 0), cA + kstep, voffA); PG8_STAGE(PG8_SB(1, 1), cB + hstep + kstep, voffB);
    PG8_WAIT_V(6); PG8_BAR;
    PG8_STAMP();
    for (;;) {
        const bool has_next = S.next(ui + 1, nxt);
        const char* nA = has_next ? (const char*)g.A + (size_t)nxt.pm * tstepA : cA; const char* nB = has_next ? (const char*)g.Bt + (size_t)nxt.pn * tstep : cB;
        for (int t = 0; t < nt; t += 2) {
            const bool last = (t == nt - 2);
            const char* a1 = cA + (size_t)(t + 1) * kstep;
            const char* a2 = last ? nA : cA + (size_t)(t + 2) * kstep; const char* b2 = last ? nB : cB + (size_t)(t + 2) * kstep;
            const char* a3 = a2 + kstep; const char* b3 = b2 + kstep;
            if (last && has_next) S.a_ready(nxt);
            PG8_LDB(B0, 0, 0); PG8_SCHED; PG8_LDA(At, 0, 0); PG8_STAGE(PG8_SA(1, 1), a1 + hstepA, voffA);
            PG8_WAIT_L(8); PG8_BAR; PG8_WAIT_L(0); PG8_MMA(0, 0, At, B0); PG8_BAR; PG8_SCHED;
            PG8_LDB(B1, 0, 1); PG8_STAGE(PG8_SB(0, 0), b2, voffB);
            PG8_BAR; PG8_WAIT_L(0); PG8_MMA(0, 1, At, B1); PG8_BAR;
            PG8_LDA(At, 0, 1); PG8_STAGE(PG8_SA(0, 0), a2, voffA);
            PG8_BAR; PG8_WAIT_L(0); PG8_MMA(1, 0, At, B0); PG8_BAR; PG8_SCHED;
            PG8_STAGE(PG8_SB(0, 1), b2 + hstep, voffB);
            PG8_WAIT_V(6); PG8_BAR; PG8_MMA(1, 1, At, B1); PG8_BAR;
            PG8_LDB(B0, 1, 0); PG8_SCHED; PG8_LDA(At, 1, 0); PG8_STAGE(PG8_SA(0, 1), a2 + hstepA, voffA);
            PG8_WAIT_L(8); PG8_BAR; PG8_WAIT_L(0); PG8_MMA(0, 0, At, B0); PG8_BAR; PG8_SCHED;
            PG8_LDB(B1, 1, 1); PG8_STAGE(PG8_SB(1, 0), b3, voffB);
            PG8_BAR; PG8_WAIT_L(0); PG8_MMA(0, 1, At, B1); PG8_BAR;
            PG8_LDA(At, 1, 1); PG8_STAGE(PG8_SA(1, 0), a3, voffA);
            PG8_BAR; PG8_WAIT_L(0); PG8_MMA(1, 0, At, B0); PG8_BAR; PG8_SCHED;
            PG8_STAGE(PG8_SB(1, 1), b3 + hstep, voffB);
            PG8_WAIT_V(6); PG8_BAR; PG8_MMA(1, 1, At, B1); PG8_BAR;
        }
        PG8_STAMP();
        if constexpr (!Epi::AFTER_DRAIN) { E(acc, cur, wr, wc, fr, fq); S.done(cur); }
        PG8_STAMP();
        if (!has_next) break;
#pragma unroll
        for (int a = 0; a < 2; ++a)
#pragma unroll
            for (int b = 0; b < 2; ++b)
#pragma unroll
                for (int m = 0; m < 4; ++m)
#pragma unroll
                    for (int n = 0; n < 2; ++n) acc[a][b][m][n] = (f32x4){0.f, 0.f, 0.f, 0.f};
        cur = nxt; cA = nA; cB = nB; ++ui;
    }
    PG8_WAIT_V(0);
    if (wr == 0) PG8_BAR;
    PG8_BAR;
    if constexpr (Epi::AFTER_DRAIN) { E.fused(acc, cur, wr, wc, fr, fq, lds, wid, lane); S.done(cur); }
    PG8_STAMP();
    if (STAMP && wid == 0) { stamps[lane] = lane < nts ? (((unsigned long long)(unsigned)ts_hi << 32) | (unsigned)ts_lo) : 0ull;
        if (lane == 62) stamps[62] = rt_entry; if (lane == 63) stamps[63] = (unsigned long long)wall_clock64(); }
#undef PG8_STAMP
#undef PG8_SA
#undef PG8_SB
#undef PG8_STAGE
#undef PG8_LDA
#undef PG8_LDB
#undef PG8_MMA
#undef PG8_WAIT_V
#undef PG8_WAIT_L
#undef PG8_BAR
#undef PG8_SCHED
}
}
using pg8::bf16_t; using pg8::bf16x8; using pg8::f32x4; using pg8::u32x4;
#define LAS __attribute__((address_space(3)))
typedef short s16x4 __attribute__((ext_vector_type(4)));
typedef float f32x16 __attribute__((ext_vector_type(16)));
typedef unsigned u32x2 __attribute__((ext_vector_type(2)));
typedef LAS unsigned char* ldsp;

constexpr int MT = 32768, DM = 1024, SEQ = 8192, DFF = 2816, NTHR = 512;
constexpr int LDS_BYTES = 155648;
constexpr float ALPHA = 1.6817928305074290f;
constexpr float LN_EPS = 1e-5f, RMS_EPS = 1e-6f;
constexpr size_t WL_F1IN = 0, WL_F1OUT = 11534336, WL_F2IN = 17301504, WL_F2OUT = 28835840, WL_MIX = 34603008, WL_SIZE = 49807360;
constexpr size_t WM_AIN = 0, WM_UK = 4194304, WM_UV = 4718592, WM_AOUT = 5242880;
constexpr size_t WM_SIN = 0, WM_SOUT = 11010048;
constexpr size_t WS_WL = 4096, WS_XB = WS_WL + WL_SIZE, WS_TMP = WS_XB + 67108864;
constexpr size_t T_H = 0;
constexpr size_t T_KW = 251658240;
constexpr size_t T_QB = 0, T_CKV = 117440512, T_CKVN = 150994944, T_IDX = 167772160, T_O = 184549376;
constexpr size_t T_ZX = 0, T_DT = 335544320, T_SSQ = 339738624;
constexpr size_t WS_END = WS_TMP + 348127232;
constexpr size_t WS_BCC = WS_END + 65536;
constexpr int QBLD = 1792, ZXLD = 5120;

struct Params {
    const float* in[20]; float* out; unsigned char* ws;
};

__device__ __forceinline__ int obx() { int b = blockIdx.x; asm volatile("" : "+s"(b)); return b; }
__device__ __forceinline__ int ogd() { int b = gridDim.x; asm volatile("" : "+s"(b)); return b; }
#define AS4 __attribute__((address_space(4)))
__device__ __forceinline__ Params load_params() {
    Params q; const AS4 unsigned long long* kp = (const AS4 unsigned long long*)__builtin_amdgcn_kernarg_segment_ptr(); asm volatile("" : "+s"(kp));
#pragma unroll
    for (int i = 0; i < 20; ++i) q.in[i] = (const float*)(const __attribute__((address_space(1))) float*)kp[i];
    q.out = (float*)(__attribute__((address_space(1))) float*)kp[20]; q.ws = (unsigned char*)(__attribute__((address_space(1))) unsigned char*)kp[21]; return q; }
__device__ __forceinline__ int otid() { int t = threadIdx.x; asm volatile("" : "+v"(t)); return t; }
__device__ __forceinline__ float bf2f(unsigned v) { return __uint_as_float(v << 16); }
__device__ __forceinline__ float bflo(unsigned v) { return __uint_as_float(v << 16); }
__device__ __forceinline__ float bfhi(unsigned v) { return __uint_as_float(v & 0xFFFF0000u); }
__device__ __forceinline__ unsigned pk2(float a, float b) { return pg8::cvt_pk_bf16(a, b); }
__device__ __forceinline__ float wave_sum(float v) {
#pragma unroll
    for (int d = 32; d >= 1; d >>= 1) v += __shfl_xor(v, d);
    return v;
}
__device__ __forceinline__ f32x4 mfma16(bf16x8 a, bf16x8 b, f32x4 c) { return __builtin_amdgcn_mfma_f32_16x16x32_bf16(a, b, c, 0, 0, 0); }
__device__ __forceinline__ bf16x8 ld_lds128(ldsp p) { return *(LAS const bf16x8*)p; }

__device__ __forceinline__ int map_col(int kind, int j, int nsrc) {
    if (kind == 0) return j < nsrc ? j : -1;
    if (kind == 1) { const int pn = j >> 8, bj = (j >> 7) & 1, i = j & 127; return bj * DFF + pn * 128 + i; }
    if (j < 1024) return j;
    if (j < 1536) return j - 1024 + 1280;
    if (j < 1600) return j - 1536 + 1792;
    if (j < 1608) return j - 1600 + 1856;
    if (j < 1792) return -1;
    return j - 1792 + 1024;
}
__device__ __forceinline__ void conv_job(ldsp lds, const float* src0, bf16_t* dst0, int K, int nsrc, int ndst, int kind, const float* kscale, int nb = 1) {
    LAS float* tile = (LAS float*)lds;
    const int tid = otid(), ntk = K >> 6, ntm = (ndst >> 6) * ntk, ntiles = ntm * nb, G = ogd();
    for (int t0 = obx(); t0 < ntiles; t0 += 4 * G) {
        float v[4][8];
#pragma unroll
        for (int s = 0; s < 4; ++s) { const int t = t0 + s * G; const bool on = t < ntiles; const int tt = on ? t : t0; const int mb = tt / ntm, tm = tt - mb * ntm; const int j0 = (tm / ntk) << 6, k0 = (tm % ntk) << 6; const float* src = src0 + (size_t)mb * K * nsrc;
#pragma unroll
            for (int e = 0; e < 8; ++e) { const int idx = tid + e * NTHR, kk = idx >> 6, jj = idx & 63; const int c = map_col(kind, j0 + jj, nsrc);
                float x = (on && c >= 0) ? src[(size_t)(k0 + kk) * nsrc + c] : 0.f; if (kscale) x *= kscale[k0 + kk]; v[s][e] = x; } }
#pragma unroll
        for (int s = 0; s < 4; ++s)
#pragma unroll
            for (int e = 0; e < 8; ++e) { const int idx = tid + e * NTHR, kk = idx >> 6, jj = idx & 63; tile[s * 4160 + kk * 65 + jj] = v[s][e]; }
        __syncthreads();
#pragma unroll
        for (int s = 0; s < 4; ++s) { const int t = t0 + s * G;
            if (t < ntiles) { const int mb = t / ntm, tm = t - mb * ntm; const int j0 = (tm / ntk) << 6, k0 = (tm % ntk) << 6; bf16_t* dst = dst0 + (size_t)mb * ndst * K; const int jj = tid >> 3, kc = tid & 7; LAS const float* tl = tile + s * 4160; u32x4 w;
                w.x = pk2(tl[(kc * 8 + 0) * 65 + jj], tl[(kc * 8 + 1) * 65 + jj]); w.y = pk2(tl[(kc * 8 + 2) * 65 + jj], tl[(kc * 8 + 3) * 65 + jj]);
                w.z = pk2(tl[(kc * 8 + 4) * 65 + jj], tl[(kc * 8 + 5) * 65 + jj]); w.w = pk2(tl[(kc * 8 + 6) * 65 + jj], tl[(kc * 8 + 7) * 65 + jj]);
                *(u32x4*)(dst + (size_t)(j0 + jj) * K + k0 + kc * 8) = w; } }
        __syncthreads();
    }
}
__device__ __forceinline__ void convert_layer(ldsp lds, const Params& p, int L) {
    unsigned char* wl = p.ws + WS_WL;
    conv_job(lds, p.in[3] + (size_t)L * 1024 * 5632, (bf16_t*)(wl + WL_F1IN), 1024, 5632, 5632, 1, nullptr);
    conv_job(lds, p.in[4] + (size_t)L * 2816 * 1024, (bf16_t*)(wl + WL_F1OUT), 2816, 1024, 1024, 0, nullptr);
    conv_job(lds, p.in[5] + (size_t)L * 1024 * 5632, (bf16_t*)(wl + WL_F2IN), 1024, 5632, 5632, 1, nullptr);
    conv_job(lds, p.in[6] + (size_t)L * 2816 * 1024, (bf16_t*)(wl + WL_F2OUT), 2816, 1024, 1024, 0, nullptr);
    const int j = L >> 1;
    if ((L & 1) == 0) {
        conv_job(lds, p.in[7] + (size_t)j * 1024 * 1864, (bf16_t*)(wl + WL_MIX + WM_AIN), 1024, 1864, 2048, 2, nullptr);
        conv_job(lds, p.in[9] + (size_t)j * 16 * 64 * 256, (bf16_t*)(wl + WL_MIX + WM_UK), 64, 256, 256, 0, nullptr, 16);
        conv_job(lds, p.in[10] + (size_t)j * 16 * 256 * 64, (bf16_t*)(wl + WL_MIX + WM_UV), 256, 64, 64, 0, nullptr, 16);
        conv_job(lds, p.in[11] + (size_t)j * 1024 * 1024, (bf16_t*)(wl + WL_MIX + WM_AOUT), 1024, 1024, 1024, 0, nullptr);
    } else {
        conv_job(lds, p.in[12] + (size_t)j * 1024 * 5152, (bf16_t*)(wl + WL_MIX + WM_SIN), 1024, 5152, 5376, 0, nullptr);
        conv_job(lds, p.in[19] + (size_t)j * 2048 * 1024, (bf16_t*)(wl + WL_MIX + WM_SOUT), 2048, 1024, 1024, 0, p.in[18] + (size_t)j * 2048);
    }
}

template <bool DRY>
__device__ __forceinline__ void ln_phase(float* x, bf16_t* xb, const float* g, const float* b, unsigned char* dummy, bool write_f32) {
    const int tid_ = otid(); const int lane = tid_ & 63, gw = obx() * 8 + (tid_ >> 6), nw = ogd() * 8;
    for (int row0 = gw; row0 < MT; row0 += 4 * nw) {
        f32x4 v[4][4]; float s[4];
#pragma unroll
        for (int r = 0; r < 4; ++r) { const int row = row0 + r * nw; const bf16_t* xr = xb + (size_t)(row < MT ? row : row0) * DM; s[r] = 0.f;
#pragma unroll
            for (int i = 0; i < 4; ++i) { const u32x2 w = *(const u32x2*)(xr + i * 256 + lane * 4); v[r][i][0] = bflo(w.x); v[r][i][1] = bfhi(w.x); v[r][i][2] = bflo(w.y); v[r][i][3] = bfhi(w.y); } }
#pragma unroll
        for (int r = 0; r < 4; ++r) {
#pragma unroll
            for (int i = 0; i < 4; ++i) s[r] += v[r][i][0] + v[r][i][1] + v[r][i][2] + v[r][i][3];
            s[r] = wave_sum(s[r]) * (1.0f / DM); }
        float q[4];
#pragma unroll
        for (int r = 0; r < 4; ++r) { q[r] = 0.f;
#pragma unroll
            for (int i = 0; i < 4; ++i) { v[r][i] = v[r][i] - s[r]; q[r] += v[r][i][0] * v[r][i][0] + v[r][i][1] * v[r][i][1] + v[r][i][2] * v[r][i][2] + v[r][i][3] * v[r][i][3]; }
            q[r] = rsqrtf(wave_sum(q[r]) * (1.0f / DM) + LN_EPS); }
#pragma unroll
        for (int i = 0; i < 4; ++i) { const int c = i * 256 + lane * 4; const f32x4 gg = *(const f32x4*)(g + c), bb = *(const f32x4*)(b + c);
#pragma unroll
            for (int r = 0; r < 4; ++r) { const int row = row0 + r * nw;
                if (row < MT) { const f32x4 o = v[r][i] * q[r] * gg + bb; u32x2 w; w.x = pk2(o[0], o[1]); w.y = pk2(o[2], o[3]);
                    if (write_f32) *(f32x4*)(x + (size_t)row * DM + c) = o;
                    *(u32x2*)(xb + (size_t)row * DM + c) = w; } } }
    }
}
__device__ __forceinline__ void cvt_x_phase(const float* x, bf16_t* xb) {
    const size_t n8 = (size_t)MT * DM / 8, stride = (size_t)ogd() * NTHR;
    for (size_t i0 = (size_t)obx() * NTHR + otid(); i0 < n8; i0 += 4 * stride) {
        f32x4 a[4], b[4];
#pragma unroll
        for (int s = 0; s < 4; ++s) { const size_t i = i0 + s * stride; const size_t ii = i < n8 ? i : i0; a[s] = *(const f32x4*)(x + ii * 8); b[s] = *(const f32x4*)(x + ii * 8 + 4); }
#pragma unroll
        for (int s = 0; s < 4; ++s) { const size_t i = i0 + s * stride;
            if (i < n8) { u32x4 w; w.x = pk2(a[s][0], a[s][1]); w.y = pk2(a[s][2], a[s][3]); w.z = pk2(b[s][0], b[s][1]); w.w = pk2(b[s][2], b[s][3]); *(u32x4*)(xb + i * 8) = w; } }
    }
}

__device__ __forceinline__ void ckv_norm_phase(const float* ckv, bf16_t* ckvn, const float* g) {
    const int tid_ = otid(); const int lane = tid_ & 63, gw = obx() * 8 + (tid_ >> 6), nw = ogd() * 8;
    const f32x4 gg = *(const f32x4*)(g + lane * 4);
    for (int row0 = gw; row0 < MT; row0 += 4 * nw) {
        f32x4 v[4];
#pragma unroll
        for (int r = 0; r < 4; ++r) { const int row = row0 + r * nw; v[r] = *(const f32x4*)(ckv + (size_t)(row < MT ? row : row0) * 256 + lane * 4); }
#pragma unroll
        for (int r = 0; r < 4; ++r) { const int row = row0 + r * nw;
            const float ms = wave_sum(v[r][0] * v[r][0] + v[r][1] * v[r][1] + v[r][2] * v[r][2] + v[r][3] * v[r][3]) * (1.0f / 256.0f);
            const float rs = rsqrtf(ms + RMS_EPS); const f32x4 o = v[r] * rs * gg; u32x2 w; w.x = pk2(o[0], o[1]); w.y = pk2(o[2], o[3]);
            if (row < MT) *(u32x2*)(ckvn + (size_t)row * 256 + lane * 4) = w; }
    }
}

__device__ __forceinline__ unsigned f2key(float s) { const unsigned u = __float_as_uint(s); return (u & 0x80000000u) ? ~u : (u | 0x80000000u); }
__device__ __forceinline__ void find_bin(ldsp hq, unsigned need, unsigned& bin, unsigned& newneed) {
    const int lane = otid() & 63;
    u32x4 w[4];
#pragma unroll
    for (int i = 0; i < 4; ++i) w[i] = *(LAS const u32x4*)(hq + lane * 64 + i * 16);
    unsigned sum = 0;
#pragma unroll
    for (int i = 0; i < 4; ++i)
#pragma unroll
        for (int k = 0; k < 4; ++k) sum += (w[i][k] & 0xFFFFu) + (w[i][k] >> 16);
    unsigned suf = sum;
#pragma unroll
    for (int d = 1; d < 64; d <<= 1) { const unsigned t = __shfl_down(suf, d); if (lane + d < 64) suf += t; }
    const unsigned above = suf - sum;
    const bool mine = (above < need) && (need <= suf);
    unsigned cum = above, fb = 0, fn = 0; bool found = false;
#pragma unroll
    for (int i = 3; i >= 0; --i)
#pragma unroll
        for (int k = 3; k >= 0; --k) {
            const unsigned hi16 = w[i][k] >> 16, lo16 = w[i][k] & 0xFFFFu; const int wi = i * 4 + k;
            if (!found && cum + hi16 >= need) { fb = lane * 32 + wi * 2 + 1; fn = need - cum; found = true; } cum += hi16;
            if (!found && cum + lo16 >= need) { fb = lane * 32 + wi * 2; fn = need - cum; found = true; } cum += lo16; }
    const unsigned long long bal = __ballot(mine);
    const int src = bal ? (int)__builtin_ctzll(bal) : 0;
    bin = __shfl(fb, src); newneed = __shfl(fn, src);
}

__device__ __forceinline__ void indexer_item(ldsp lds, const bf16_t* QB, unsigned short* IDX, int b, int qt) {
    const int tid = otid(), lane = tid & 63, wid = tid >> 6, c = lane & 31, hi = lane >> 5;
    const int q0 = qt * 32; const size_t tb = (size_t)b * SEQ;
    const int posb = q0 + 4 * wid + 2 * hi;
#ifdef IDX_SIMPLE
    if (true) {
#else
    if (q0 < 256) {
#endif
        for (int tq = 0; tq < 4; ++tq) { const int pos = q0 + 4 * wid + tq; unsigned short* o = IDX + (tb + pos) * 256;
#pragma unroll
            for (int k = 0; k < 4; ++k) { const int j = lane * 4 + k; o[j] = (unsigned short)(j <= pos ? j : 0xFFFF); } }
        return;
    }
    ldsp hist = lds + wid * 16384;
    ldsp kbuf = lds + 131072;
    bf16x8 af[4];
    { const int r = c, tk = ((r >> 2) & 1) * 2 + (r & 1), hd = (r >> 3) * 2 + ((r >> 1) & 1);
      const bf16_t* qp = QB + (tb + q0 + 4 * wid + tk) * QBLD + 1024 + hd * 64 + hi * 8;
#pragma unroll
      for (int ks = 0; ks < 4; ++ks) af[ks] = *(const bf16x8*)(qp + ks * 16); }
    float wq[2][8];
#pragma unroll
    for (int e = 0; e < 2; ++e) { const u32x4 wv = *(const u32x4*)(QB + T_KW / 2 + (tb + posb + e) * 128 + 64);
#pragma unroll
        for (int k = 0; k < 4; ++k) { wq[e][2 * k] = bflo(wv[k]) * 0.04419417382415922f; wq[e][2 * k + 1] = bfhi(wv[k]) * 0.04419417382415922f; } }
    const int nch = (q0 + 32 + 63) >> 6;
    const bf16_t* KW = QB + T_KW / 2;
    const bf16_t* kg = KW + (tb + (tid >> 3)) * 128 + (tid & 7) * 8;
    const int kst = (tid >> 3) * 144 + (tid & 7) * 16;
    unsigned pre[2] = {0u, 0u}, need[2] = {256u, 256u};
    unsigned cnt[2] = {0u, 0u}, tie[2] = {0u, 0u};
    for (int pass = 0; pass < 4; ++pass) {
        if (pass < 3) {
#pragma unroll
            for (int i = 0; i < 16; ++i) *(LAS u32x4*)(hist + i * 1024 + lane * 16) = (u32x4){0u, 0u, 0u, 0u};
        }
        __syncthreads();
        u32x4 kr = *(const u32x4*)kg;
        *(LAS u32x4*)(kbuf + kst) = kr;
        __syncthreads();
        for (int ch = 0; ch < nch; ++ch) {
            if (ch + 1 < nch) kr = *(const u32x4*)(kg + (size_t)(ch + 1) * 64 * 128);
            ldsp kb = kbuf + (ch & 1) * 9216;
#pragma unroll
            for (int ts = 0; ts < 2; ++ts) {
                f32x16 acc;
#pragma unroll
                for (int i = 0; i < 16; ++i) acc[i] = 0.f;
#pragma unroll
                for (int ks = 0; ks < 4; ++ks) { const bf16x8 bf = ld_lds128(kb + (ts * 32 + c) * 144 + ks * 32 + hi * 16); acc = __builtin_amdgcn_mfma_f32_32x32x16_bf16(af[ks], bf, acc, 0, 0, 0); }
                const int key = ch * 64 + ts * 32 + c;
#pragma unroll
                for (int e = 0; e < 2; ++e) {
                    float s = 0.f;
#pragma unroll
                    for (int h = 0; h < 8; ++h) s = fmaf(wq[e][h], fmaxf(acc[2 * h + e], 0.f), s);
                    s += 0.0f;
                    const unsigned u = f2key(s); const bool valid = key <= posb + e;
                    if (pass == 0) { if (valid) { const unsigned bin = u >> 21; __hip_atomic_fetch_add((LAS unsigned*)(hist + (2 * hi + e) * 4096 + (bin >> 1) * 4), 1u << ((bin & 1) * 16), __ATOMIC_RELAXED, __HIP_MEMORY_SCOPE_WORKGROUP); } }
                    else if (pass == 1) { if (valid && (u >> 21) == pre[e]) { const unsigned bin = (u >> 10) & 0x7FFu; __hip_atomic_fetch_add((LAS unsigned*)(hist + (2 * hi + e) * 4096 + (bin >> 1) * 4), 1u << ((bin & 1) * 16), __ATOMIC_RELAXED, __HIP_MEMORY_SCOPE_WORKGROUP); } }
                    else if (pass == 2) { if (valid && (u >> 10) == pre[e]) { const unsigned bin = u & 0x3FFu; __hip_atomic_fetch_add((LAS unsigned*)(hist + (2 * hi + e) * 4096 + (bin >> 1) * 4), 1u << ((bin & 1) * 16), __ATOMIC_RELAXED, __HIP_MEMORY_SCOPE_WORKGROUP); } }
                    else {
                        const bool gt = valid && (u > pre[e]), eq = valid && (u == pre[e]);
                        const unsigned long long beq = __ballot(eq); const unsigned meq = hi ? (unsigned)(beq >> 32) : (unsigned)beq;
                        const unsigned below = (1u << c) - 1u;
                        const bool emit = gt || (eq && (tie[e] + __popc(meq & below) < need[e]));
                        tie[e] += __popc(meq);
                        const unsigned long long bem = __ballot(emit); const unsigned mem = hi ? (unsigned)(bem >> 32) : (unsigned)bem;
                        const unsigned slot = cnt[e] + __popc(mem & below);
                        if (emit && slot < 256u) IDX[(tb + posb + e) * 256 + slot] = (unsigned short)key;
                        cnt[e] += __popc(mem);
                    }
                }
            }
            if (ch + 1 < nch) *(LAS u32x4*)(kbuf + ((ch + 1) & 1) * 9216 + kst) = kr;
            __syncthreads();
        }
        if (pass < 3) {
            unsigned nb[4], nn[4];
#pragma unroll
            for (int tq = 0; tq < 4; ++tq) {
                const unsigned nd = __shfl(need[tq & 1], (tq >> 1) * 32);
                find_bin(hist + tq * 4096, nd, nb[tq], nn[tq]); }
#pragma unroll
            for (int e = 0; e < 2; ++e) { const unsigned bsel = hi ? nb[2 + e] : nb[e], nsel = hi ? nn[2 + e] : nn[e];
                pre[e] = (pass == 0) ? bsel : (pass == 1 ? ((pre[e] << 11) | bsel) : ((pre[e] << 10) | bsel)); need[e] = nsel; }
        }
    }
}
__device__ __forceinline__ void find_bin1k(ldsp hq, unsigned need, unsigned& bin, unsigned& newneed) {
    const int lane = otid() & 63;
    u32x4 w[2];
#pragma unroll
    for (int i = 0; i < 2; ++i) w[i] = *(LAS const u32x4*)(hq + lane * 32 + i * 16);
    unsigned sum = 0;
#pragma unroll
    for (int i = 0; i < 2; ++i)
#pragma unroll
        for (int k = 0; k < 4; ++k) sum += (w[i][k] & 0xFFFFu) + (w[i][k] >> 16);
    unsigned suf = sum;
#pragma unroll
    for (int d = 1; d < 64; d <<= 1) { const unsigned t = __shfl_down(suf, d); if (lane + d < 64) suf += t; }
    const unsigned above = suf - sum;
    const bool mine = (above < need) && (need <= suf);
    unsigned cum = above, fb = 0, fn = 0; bool found = false;
#pragma unroll
    for (int i = 1; i >= 0; --i)
#pragma unroll
        for (int k = 3; k >= 0; --k) {
            const unsigned hi16 = w[i][k] >> 16, lo16 = w[i][k] & 0xFFFFu; const int wi = i * 4 + k;
            if (!found && cum + hi16 >= need) { fb = lane * 16 + wi * 2 + 1; fn = need - cum; found = true; } cum += hi16;
            if (!found && cum + lo16 >= need) { fb = lane * 16 + wi * 2; fn = need - cum; found = true; } cum += lo16; }
    const unsigned long long bal = __ballot(mine);
    const int src = bal ? (int)__builtin_ctzll(bal) : 0;
    bin = __shfl(fb, src); newneed = __shfl(fn, src);
}
struct IdxState { bf16x8 af[4]; float wq[2][8], bsc[2], bof[2]; unsigned tbin[2], cnt[2], ccnt[2]; };
template <int PASS>
__device__ __forceinline__ void idx_update(float sv, unsigned bin, int e, int key, IdxState& st, ldsp hist, ldsp cand, ldsp ctrs, unsigned short* IDX, size_t tb, int posb, int hi) {
    const bool valid = key <= posb + e;
    if (PASS == 2) { if (valid && sv == 123456.789f) IDX[(tb + posb + e) * 256] = (unsigned short)bin; }
    else if (PASS == 0) { __hip_atomic_fetch_add((LAS unsigned*)(hist + (2 * hi + e) * 2048 + (bin >> 1) * 4), valid ? (1u << ((bin & 1) * 16)) : 0u, __ATOMIC_RELAXED, __HIP_MEMORY_SCOPE_WORKGROUP); }
    else if (valid && bin >= st.tbin[e]) {
        LAS unsigned* ctr = (LAS unsigned*)(ctrs + (2 * hi + e) * 8);
        if (bin > st.tbin[e]) { const unsigned slot = __hip_atomic_fetch_add(ctr, 1u, __ATOMIC_RELAXED, __HIP_MEMORY_SCOPE_WORKGROUP);
            if (slot < 256u) IDX[(tb + posb + e) * 256 + slot] = (unsigned short)key; }
        else { const unsigned cp = __hip_atomic_fetch_add(ctr + 1, 1u, __ATOMIC_RELAXED, __HIP_MEMORY_SCOPE_WORKGROUP);
            if (cp < 256u) { u32x2 cv; cv.x = f2key(sv); cv.y = (unsigned)key; *(LAS u32x2*)(cand + ((2 * hi + e) * 256 + cp) * 8) = cv; } }
    }
}
__device__ __forceinline__ void idx_mfma(ldsp kb, const IdxState& st, f32x16 (&acc)[4]) {
#pragma unroll
    for (int tl = 0; tl < 4; ++tl)
#pragma unroll
        for (int i = 0; i < 16; ++i) acc[tl][i] = 0.f;
#pragma unroll
    for (int tp = 0; tp < 2; ++tp) { bf16x8 b0[4], b1[4];
#pragma unroll
        for (int ks = 0; ks < 4; ++ks) { b0[ks] = ld_lds128(kb + (2 * tp) * 32 * 144 + ks * 32); b1[ks] = ld_lds128(kb + (2 * tp + 1) * 32 * 144 + ks * 32); }
#pragma unroll
        for (int ks = 0; ks < 4; ++ks) { acc[2 * tp] = __builtin_amdgcn_mfma_f32_32x32x16_bf16(st.af[ks], b0[ks], acc[2 * tp], 0, 0, 0); acc[2 * tp + 1] = __builtin_amdgcn_mfma_f32_32x32x16_bf16(st.af[ks], b1[ks], acc[2 * tp + 1], 0, 0, 0); } }
}
template <int PASS>
__device__ __forceinline__ void idx_pass(ldsp lds, IdxState& st, const bf16_t* kg, unsigned short* IDX, size_t tb, int q0, int posb, int wid, int c, int hi, int kst, int nch) {
    ldsp hist = lds + wid * 8192; ldsp cand = hist; ldsp ctrs = lds + 65536 + wid * 32; ldsp kbuf = lds + 81920; const int lo = c * 144 + hi * 16;
    __syncthreads();
    u32x4 kr0 = *(const u32x4*)kg, kr1 = *(const u32x4*)(kg + (size_t)64 * 128);
    *(LAS u32x4*)(kbuf + kst) = kr0; *(LAS u32x4*)(kbuf + 9216 + kst) = kr1;
    if (1 < nch) { kr0 = *(const u32x4*)(kg + (size_t)128 * 128); kr1 = *(const u32x4*)(kg + (size_t)(128 + 64) * 128); *(LAS u32x4*)(kbuf + 18432 + kst) = kr0; *(LAS u32x4*)(kbuf + 18432 + 9216 + kst) = kr1; }
    u32x4 kn0 = kr0, kn1 = kr1;
    if (2 < nch) { kr0 = *(const u32x4*)(kg + (size_t)256 * 128); kr1 = *(const u32x4*)(kg + (size_t)(256 + 64) * 128); }
    if (3 < nch) { kn0 = *(const u32x4*)(kg + (size_t)384 * 128); kn1 = *(const u32x4*)(kg + (size_t)(384 + 64) * 128); }
    __syncthreads();
    f32x16 accA[4], accB[4];
    idx_mfma(kbuf + lo, st, accA);
    int bcur = 0;
#define IDX_STEP(CH, CUR, NXT) do { const int ch_ = (CH); const int bn = bcur == 2 ? 0 : bcur + 1, bw = bn == 2 ? 0 : bn + 1; \
        ldsp kb_ = kbuf + bn * 18432 + lo; float sv_[4][2]; unsigned bin_[4][2]; \
          \
        _Pragma("unroll") for (int tl = 0; tl < 4; ++tl) _Pragma("unroll") for (int i = 0; i < 16; ++i) NXT[tl][i] = 0.f; \
        _Pragma("unroll") for (int ks = 0; ks < 4; ++ks) { \
            bf16x8 f0 = ld_lds128(kb_ + ks * 32), f1 = ld_lds128(kb_ + 4608 + ks * 32), f2 = ld_lds128(kb_ + 9216 + ks * 32), f3 = ld_lds128(kb_ + 13824 + ks * 32); \
            NXT[0] = __builtin_amdgcn_mfma_f32_32x32x16_bf16(st.af[ks], f0, NXT[0], 0, 0, 0); NXT[1] = __builtin_amdgcn_mfma_f32_32x32x16_bf16(st.af[ks], f1, NXT[1], 0, 0, 0); \
            NXT[2] = __builtin_amdgcn_mfma_f32_32x32x16_bf16(st.af[ks], f2, NXT[2], 0, 0, 0); NXT[3] = __builtin_amdgcn_mfma_f32_32x32x16_bf16(st.af[ks], f3, NXT[3], 0, 0, 0); \
            { const int tl = ks;                                     \
              _Pragma("unroll") for (int e = 0; e < 2; ++e) { float s = 0.f; \
                  _Pragma("unroll") for (int h = 0; h < 8; ++h) s = fmaf(st.wq[e][h], __builtin_amdgcn_fmed3f(CUR[tl][2 * h + e], 0.f, 3.0e38f), s); \
                  sv_[tl][e] = s + 0.0f; bin_[tl][e] = (unsigned)__builtin_amdgcn_fmed3f(fmaf(sv_[tl][e], st.bsc[e], st.bof[e]), 0.f, 1023.f); } } } \
        _Pragma("unroll") for (int i = 0; i < 16; ++i) { __builtin_amdgcn_sched_group_barrier(0x008, 1, 0); __builtin_amdgcn_sched_group_barrier(0x002, 9, 0); } \
          \
        _Pragma("unroll") for (int tl = 0; tl < 4; ++tl) { \
            _Pragma("unroll") for (int e = 0; e < 2; ++e) idx_update<PASS>(sv_[tl][e], bin_[tl][e], e, ch_ * 128 + tl * 32 + c, st, hist, cand, ctrs, IDX, tb, posb, hi); } \
        if (ch_ + 2 < nch) { *(LAS u32x4*)(kbuf + bw * 18432 + kst) = kr0; *(LAS u32x4*)(kbuf + bw * 18432 + 9216 + kst) = kr1; } \
        kr0 = kn0; kr1 = kn1; \
        if (ch_ + 4 < nch) { kn0 = *(const u32x4*)(kg + (size_t)(ch_ + 4) * 128 * 128); kn1 = *(const u32x4*)(kg + (size_t)((ch_ + 4) * 128 + 64) * 128); } \
        bcur = bn; __syncthreads(); } while (0)
#pragma unroll 1
    for (int ch = 0; ch < nch; ch += 2) {
        IDX_STEP(ch, accA, accB);
        if (ch + 1 < nch) IDX_STEP(ch + 1, accB, accA);
    }
#undef IDX_STEP
}
__device__ __forceinline__ int indexer_item_fast(ldsp lds, const bf16_t* QB, unsigned short* IDX, int b, int qt) {
    const int tid = otid(), lane = tid & 63, wid = tid >> 6, c = lane & 31, hi = lane >> 5;
    const int q0 = qt * 32; const size_t tb = (size_t)b * SEQ;
    const int posb = q0 + 4 * wid + 2 * hi;
    ldsp hist = lds + wid * 8192;
    ldsp cand = hist;
    ldsp ctrs = lds + 65536 + wid * 32;
    IdxState st;
    { const int r = c, tk = ((r >> 2) & 1) * 2 + (r & 1), hd = (r >> 3) * 2 + ((r >> 1) & 1);
      const bf16_t* qp = QB + (tb + q0 + 4 * wid + tk) * QBLD + 1024 + hd * 64 + hi * 8;
#pragma unroll
      for (int ks = 0; ks < 4; ++ks) st.af[ks] = *(const bf16x8*)(qp + ks * 16); }
#pragma unroll
    for (int e = 0; e < 2; ++e) { const u32x4 wv = *(const u32x4*)(QB + T_KW / 2 + (tb + posb + e) * 128 + 64); float sw = 0.f, sw2 = 0.f;
#pragma unroll
        for (int k = 0; k < 4; ++k) { st.wq[e][2 * k] = bflo(wv[k]) * 0.04419417382415922f; st.wq[e][2 * k + 1] = bfhi(wv[k]) * 0.04419417382415922f; }
#pragma unroll
        for (int h = 0; h < 8; ++h) { sw += st.wq[e][h]; sw2 += st.wq[e][h] * st.wq[e][h]; }
        const float mu = sw * 3.1915382f, sg = sqrtf(sw2 * 21.81f) + 1e-20f;
        st.bsc[e] = 128.0f / sg; st.bof[e] = 256.0f - mu * st.bsc[e];
        st.tbin[e] = 0u; st.cnt[e] = 0u; st.ccnt[e] = 0u; }
    const int nch = (q0 + 32 + 127) >> 7;
    const bf16_t* kg = QB + T_KW / 2 + (tb + (tid >> 3)) * 128 + (tid & 7) * 8;
    const int kst = (tid >> 3) * 144 + (tid & 7) * 16;
#pragma unroll
    for (int i = 0; i < 8; ++i) *(LAS u32x4*)(hist + i * 1024 + lane * 16) = (u32x4){0u, 0u, 0u, 0u};
#ifdef DUMMY_PASS
    idx_pass<2>(lds, st, kg, IDX, tb, q0, posb, wid, c, hi, kst, nch);
#endif
    idx_pass<0>(lds, st, kg, IDX, tb, q0, posb, wid, c, hi, kst, nch);
    unsigned need[2];
    { unsigned nb[4], nn[4];
#pragma unroll
      for (int tq = 0; tq < 4; ++tq) find_bin1k(hist + tq * 2048, 256u, nb[tq], nn[tq]);
#pragma unroll
      for (int e = 0; e < 2; ++e) { st.tbin[e] = hi ? nb[2 + e] : nb[e]; need[e] = hi ? nn[2 + e] : nn[e]; } }
    if (lane < 8) *(LAS unsigned*)(ctrs + lane * 4) = 0u;
    idx_pass<1>(lds, st, kg, IDX, tb, q0, posb, wid, c, hi, kst, nch);
    int ovf = 0;
#pragma unroll 1
    for (int tq = 0; tq < 4; ++tq) {
        const unsigned base = *(LAS const unsigned*)(ctrs + tq * 8), n = *(LAS const unsigned*)(ctrs + tq * 8 + 4);
        const unsigned nd = __shfl(need[tq & 1], (tq >> 1) * 32);
        if (n > 256u) { ovf = 1; }
        else {
#pragma unroll 1
            for (unsigned g0 = 0; g0 < n; g0 += 64) {
                const unsigned ci = g0 + lane;
                const u32x2 mine = ci < n ? *(LAS const u32x2*)(cand + (tq * 256 + ci) * 8) : (u32x2){0u, 0u};
                unsigned rank = 0;
                for (unsigned j = 0; j < n; ++j) { const u32x2 o = *(LAS const u32x2*)(cand + (tq * 256 + j) * 8); rank += (o.x > mine.x || (o.x == mine.x && o.y < mine.y)) ? 1u : 0u; }
                if (ci < n && rank < nd && base + rank < 256u) IDX[(tb + q0 + 4 * wid + tq) * 256 + base + rank] = (unsigned short)mine.y;
            }
        }
    }
    return __syncthreads_or(ovf);
}
__device__ __forceinline__ void indexer_phase(ldsp lds, const Params& p) {
    const bf16_t* QB = (const bf16_t*)(p.ws + WS_TMP + T_QB); unsigned short* IDX = (unsigned short*)(p.ws + WS_TMP + T_IDX);
    for (int s = obx(); s < 256; s += ogd()) {
        int b = s >> 6, j = s & 63;
        if (ogd() == 256) { b = (s & 7) >> 1; j = (s >> 3) * 2 + (s & 1); }
#pragma unroll 1
        for (int k = 0; k < 4; ++k) {
            const int qt = k == 0 ? 255 - j : (k == 1 ? 128 + j : (k == 2 ? 127 - j : j));
#ifndef IDX_SLOW
            if (qt * 32 >= 256) { if (indexer_item_fast(lds, QB, IDX, b, qt)) { indexer_item(lds, QB, IDX, b, qt); __syncthreads(); } }
            else
#endif
            { indexer_item(lds, QB, IDX, b, qt); __syncthreads(); }
        }
    }
}

__device__ __forceinline__ s16x4 tr_read(ldsp p) { typedef short v4i16_t __attribute__((ext_vector_type(4))); return __builtin_bit_cast(s16x4, __builtin_amdgcn_ds_read_tr16_b64_v4i16((LAS v4i16_t*)p)); }
constexpr int XS = 528, CS = 544;
__device__ __forceinline__ void sattn_step(ldsp lds, const Params& p, int b, int si) {
    const int tid = otid(), lane = tid & 63, wid = tid >> 6, fr = lane & 15, g = lane >> 4;
    const bf16_t* QB = (const bf16_t*)(p.ws + WS_TMP + T_QB); const bf16_t* CKVN = (const bf16_t*)(p.ws + WS_TMP + T_CKVN);
    const unsigned short* IDX = (const unsigned short*)(p.ws + WS_TMP + T_IDX); bf16_t* O = (bf16_t*)(p.ws + WS_TMP + T_O);
    const bf16_t* WUK = (const bf16_t*)(p.ws + WS_WL + WL_MIX + WM_UK); const bf16_t* WUV = (const bf16_t*)(p.ws + WS_WL + WL_MIX + WM_UV);
    const size_t tb = (size_t)b * SEQ; const int p0 = si * 16; const size_t t0 = tb + p0;
    ldsp X = lds; ldsp Cw = lds + wid * (32 * CS); ldsp IL = lds + 8 * 32 * CS + wid * 1024;
#pragma unroll 1
    for (int hh = 0; hh < 2; ++hh) { const int h = wid * 2 + hh;
        bf16x8 bq[2]; { const bf16_t* qp = QB + (t0 + fr) * QBLD + h * 64 + g * 8; bq[0] = *(const bf16x8*)qp; bq[1] = *(const bf16x8*)(qp + 32); }
#pragma unroll 16
        for (int rt = 0; rt < 16; ++rt) {
            const bf16_t* wp = WUK + ((size_t)(h * 256 + rt * 16 + fr)) * 64 + g * 8;
            f32x4 acc = {0.f, 0.f, 0.f, 0.f};
            acc = mfma16(*(const bf16x8*)wp, bq[0], acc); acc = mfma16(*(const bf16x8*)(wp + 32), bq[1], acc);
            u32x2 w; w.x = pk2(acc[0], acc[1]); w.y = pk2(acc[2], acc[3]); *(LAS u32x2*)(X + (fr * 16 + h) * XS + (rt * 16 + 4 * g) * 2) = w; } }
    { const u32x2 iv0 = *(const u32x2*)(IDX + (t0 + wid) * 256 + lane * 4), iv1 = *(const u32x2*)(IDX + (t0 + wid + 8) * 256 + lane * 4);
      *(LAS u32x2*)(IL + lane * 8) = iv0; *(LAS u32x2*)(IL + 512 + lane * 8) = iv1; }
    __syncthreads();
    bf16x8 qa[8], qb[8];
#pragma unroll
    for (int ks = 0; ks < 8; ++ks) { qa[ks] = ld_lds128(X + (wid * 16 + fr) * XS + ks * 64 + g * 16); qb[ks] = ld_lds128(X + ((wid + 8) * 16 + fr) * XS + ks * 64 + g * 16); }
    __syncthreads();
    u32x2 olat[2][16];
#pragma unroll 1
    for (int tk = 0; tk < 2; ++tk) {
        const int pos = p0 + wid + 8 * tk; ldsp ILt = IL + tk * 512;
        f32x4 o[16];
#pragma unroll
        for (int i = 0; i < 16; ++i) o[i] = (f32x4){0.f, 0.f, 0.f, 0.f};
        float mrun = -INFINITY, lsum = 0.f;
#pragma unroll 1
        for (int kt = 0; kt < 8; ++kt) {
#pragma unroll
            for (int hf = 0; hf < 2; ++hf) { u32x4 gv[8];
#pragma unroll
              for (int i = 0; i < 8; ++i) { const int row = (hf * 8 + i) * 2 + (lane >> 5); const int key = *(LAS const unsigned short*)(ILt + (kt * 32 + row) * 2);
                  const int kc = key <= pos ? key : 0; gv[i] = *(const u32x4*)(CKVN + (tb + kc) * 256 + (lane & 31) * 8); }
#pragma unroll
              for (int i = 0; i < 8; ++i) { const int row = (hf * 8 + i) * 2 + (lane >> 5); *(LAS u32x4*)(Cw + row * CS + (lane & 31) * 16) = gv[i]; }
              __builtin_amdgcn_sched_barrier(0); }
            f32x4 s0 = {0.f, 0.f, 0.f, 0.f}, s1 = {0.f, 0.f, 0.f, 0.f};
#pragma unroll
            for (int ks = 0; ks < 8; ++ks) { s0 = mfma16(ld_lds128(Cw + fr * CS + ks * 64 + g * 16), qa[ks], s0); s1 = mfma16(ld_lds128(Cw + (16 + fr) * CS + ks * 64 + g * 16), qa[ks], s1); }
            const u32x2 k0 = *(LAS const u32x2*)(ILt + (kt * 32 + 4 * g) * 2), k1 = *(LAS const u32x2*)(ILt + (kt * 32 + 16 + 4 * g) * 2);
            float sv[8];
            sv[0] = (int)(k0.x & 0xFFFFu) <= pos ? s0[0] * 0.125f : -INFINITY; sv[1] = (int)(k0.x >> 16) <= pos ? s0[1] * 0.125f : -INFINITY;
            sv[2] = (int)(k0.y & 0xFFFFu) <= pos ? s0[2] * 0.125f : -INFINITY; sv[3] = (int)(k0.y >> 16) <= pos ? s0[3] * 0.125f : -INFINITY;
            sv[4] = (int)(k1.x & 0xFFFFu) <= pos ? s1[0] * 0.125f : -INFINITY; sv[5] = (int)(k1.x >> 16) <= pos ? s1[1] * 0.125f : -INFINITY;
            sv[6] = (int)(k1.y & 0xFFFFu) <= pos ? s1[2] * 0.125f : -INFINITY; sv[7] = (int)(k1.y >> 16) <= pos ? s1[3] * 0.125f : -INFINITY;
            float tm = fmaxf(fmaxf(fmaxf(sv[0], sv[1]), fmaxf(sv[2], sv[3])), fmaxf(fmaxf(sv[4], sv[5]), fmaxf(sv[6], sv[7])));
            tm = fmaxf(tm, __shfl_xor(tm, 16)); tm = fmaxf(tm, __shfl_xor(tm, 32));
            const float mnew = fmaxf(mrun, tm); const float sc = __expf(mrun - mnew); mrun = mnew;
            float ps = 0.f;
#pragma unroll
            for (int i = 0; i < 8; ++i) { sv[i] = __expf(sv[i] - mnew); ps += sv[i]; }
            lsum = lsum * sc + ps;
#pragma unroll
            for (int i = 0; i < 16; ++i) o[i] = o[i] * sc;
            union { bf16x8 v; unsigned u[4]; } pb; pb.u[0] = pk2(sv[0], sv[1]); pb.u[1] = pk2(sv[2], sv[3]); pb.u[2] = pk2(sv[4], sv[5]); pb.u[3] = pk2(sv[6], sv[7]);
            ldsp tra = Cw + (4 * g + (fr >> 2)) * CS + (fr & 3) * 8;
#pragma unroll
            for (int rt = 0; rt < 16; ++rt) {
                const s16x4 lo = tr_read(tra + rt * 32), hi4 = tr_read(tra + 16 * CS + rt * 32);
                bf16x8 a; a[0] = lo[0]; a[1] = lo[1]; a[2] = lo[2]; a[3] = lo[3]; a[4] = hi4[0]; a[5] = hi4[1]; a[6] = hi4[2]; a[7] = hi4[3];
                o[rt] = mfma16(a, pb.v, o[rt]); if ((rt & 3) == 3) __builtin_amdgcn_sched_barrier(0); }
        }
        lsum += __shfl_xor(lsum, 16); lsum += __shfl_xor(lsum, 32);
        const float inv = 1.0f / lsum;
        if (tk == 0) {
#pragma unroll
            for (int rt = 0; rt < 16; ++rt) { olat[0][rt].x = pk2(o[rt][0] * inv, o[rt][1] * inv); olat[0][rt].y = pk2(o[rt][2] * inv, o[rt][3] * inv); }
#pragma unroll
            for (int ks = 0; ks < 8; ++ks) qa[ks] = qb[ks];
        } else {
#pragma unroll
            for (int rt = 0; rt < 16; ++rt) { olat[1][rt].x = pk2(o[rt][0] * inv, o[rt][1] * inv); olat[1][rt].y = pk2(o[rt][2] * inv, o[rt][3] * inv); }
        }
    }
    __syncthreads();
#pragma unroll
    for (int rt = 0; rt < 16; ++rt) { *(LAS u32x2*)(X + (wid * 16 + fr) * XS + (rt * 16 + 4 * g) * 2) = olat[0][rt]; *(LAS u32x2*)(X + ((wid + 8) * 16 + fr) * XS + (rt * 16 + 4 * g) * 2) = olat[1][rt]; }
    __syncthreads();
#pragma unroll 1
    for (int hh = 0; hh < 2; ++hh) { const int h = wid * 2 + hh;
        bf16x8 ao[8];
#pragma unroll
        for (int ks = 0; ks < 8; ++ks) ao[ks] = ld_lds128(X + (fr * 16 + h) * XS + ks * 64 + g * 16);
#pragma unroll 4
        for (int dt = 0; dt < 4; ++dt) {
            const bf16_t* wp = WUV + ((size_t)(h * 64 + dt * 16 + fr)) * 256 + g * 8;
            f32x4 acc = {0.f, 0.f, 0.f, 0.f};
#pragma unroll
            for (int ks = 0; ks < 8; ++ks) acc = mfma16(ao[ks], *(const bf16x8*)(wp + ks * 32), acc);
#pragma unroll
            for (int j = 0; j < 4; ++j) O[(t0 + 4 * g + j) * 1024 + h * 64 + dt * 16 + fr] = (bf16_t)(pk2(acc[j], 0.f) & 0xFFFFu); } }
    __syncthreads();
}
__device__ __forceinline__ void sattn_phase(ldsp lds, const Params& p) {
    const int G = ogd(), bx = obx();
    if ((G & 7) == 0) {
        const int b = (bx & 7) >> 1, wb = (bx >> 3) * 2 + (bx & 1), nwb = G >> 2;
        for (int si = wb; si < 512; si += nwb) sattn_step(lds, p, b, si);
    } else {
        for (int s = bx; s < 2048; s += G) sattn_step(lds, p, s >> 9, s & 511);
    }
}

constexpr int RS = 272;
__device__ __forceinline__ void conv8(const u32x4 (&raw)[7], const float* cw, const float* cb, int c0, float (&out)[4][8]) {
    float w[4][8], bias[8];
#pragma unroll
    for (int k = 0; k < 4; ++k) { const f32x4 a = *(const f32x4*)(cw + k * 3072 + c0), b = *(const f32x4*)(cw + k * 3072 + c0 + 4);
        w[k][0] = a[0]; w[k][1] = a[1]; w[k][2] = a[2]; w[k][3] = a[3]; w[k][4] = b[0]; w[k][5] = b[1]; w[k][6] = b[2]; w[k][7] = b[3]; }
    { const f32x4 a = *(const f32x4*)(cb + c0), b = *(const f32x4*)(cb + c0 + 4); bias[0] = a[0]; bias[1] = a[1]; bias[2] = a[2]; bias[3] = a[3]; bias[4] = b[0]; bias[5] = b[1]; bias[6] = b[2]; bias[7] = b[3]; }
#pragma unroll
    for (int li = 0; li < 4; ++li)
#pragma unroll
        for (int i = 0; i < 8; ++i) { float v = bias[i];
#pragma unroll
            for (int k = 0; k < 4; ++k) { const unsigned wv = raw[li + k][i >> 1]; v = fmaf(w[k][i], (i & 1) ? bfhi(wv) : bflo(wv), v); }
            out[li][i] = pg8::silu_f(v); }
}
__device__ __forceinline__ float softplus_f(float x) {
    const float u = __expf(-fabsf(x));
    const float l = u < 0.03f ? u * (1.0f - u * (0.5f - u * (0.33333334f - 0.25f * u))) : __logf(1.0f + u);
    return fmaxf(x, 0.f) + l;
}
__device__ __forceinline__ void conv8l(const u32x4 (&raw)[7], LAS const float* wl, int stride, float (&out)[4][8]) {
    { const f32x4 a = *(LAS const f32x4*)(wl + 4 * stride), b = *(LAS const f32x4*)(wl + 4 * stride + 4);
#pragma unroll
      for (int li = 0; li < 4; ++li) { out[li][0] = a[0]; out[li][1] = a[1]; out[li][2] = a[2]; out[li][3] = a[3]; out[li][4] = b[0]; out[li][5] = b[1]; out[li][6] = b[2]; out[li][7] = b[3]; } }
#pragma unroll
    for (int k = 0; k < 4; ++k) { const f32x4 a = *(LAS const f32x4*)(wl + k * stride), b = *(LAS const f32x4*)(wl + k * stride + 4); const float w8[8] = {a[0], a[1], a[2], a[3], b[0], b[1], b[2], b[3]};
#pragma unroll
        for (int li = 0; li < 4; ++li)
#pragma unroll
            for (int i = 0; i < 8; ++i) { const unsigned wv = raw[li + k][i >> 1]; out[li][i] = fmaf(w8[i], (i & 1) ? bfhi(wv) : bflo(wv), out[li][i]); } }
#pragma unroll
    for (int li = 0; li < 4; ++li)
#pragma unroll
        for (int i = 0; i < 8; ++i) out[li][i] = pg8::silu_f(out[li][i]);
}
__device__ __forceinline__ void conv1l(const u32x4 (&raw)[4], LAS const float* wl, int stride, float (&out)[8]) {
#pragma unroll
    for (int i = 0; i < 8; ++i) out[i] = wl[4 * stride + i];
#pragma unroll
    for (int k = 0; k < 4; ++k) { const f32x4 a = *(LAS const f32x4*)(wl + k * stride), b = *(LAS const f32x4*)(wl + k * stride + 4); const float w8[8] = {a[0], a[1], a[2], a[3], b[0], b[1], b[2], b[3]};
#pragma unroll
        for (int i = 0; i < 8; ++i) { const unsigned wv = raw[k][i >> 1]; out[i] = fmaf(w8[i], (i & 1) ? bfhi(wv) : bflo(wv), out[i]); } }
#pragma unroll
    for (int i = 0; i < 8; ++i) out[i] = pg8::silu_f(out[i]);
}
__device__ __forceinline__ void load4(const bf16_t* ZX, size_t tb, int posl, int col, u32x4 (&raw)[4]) {
#pragma unroll
    for (int r = 0; r < 4; ++r) { const int pos = posl - 3 + r; raw[r] = pos >= 0 ? *(const u32x4*)(ZX + (tb + pos) * ZXLD + col) : (u32x4){0u, 0u, 0u, 0u}; }
}
__device__ __forceinline__ void load7(const bf16_t* ZX, size_t tb, int posl0, int col, u32x4 (&raw)[7]) {
#pragma unroll
    for (int r = 0; r < 7; ++r) { const int pos = posl0 - 3 + r; raw[r] = pos >= 0 ? *(const u32x4*)(ZX + (tb + pos) * ZXLD + col) : (u32x4){0u, 0u, 0u, 0u}; }
}
__device__ __forceinline__ void bc_conv_phase(const Params& p, int sl) {
    const bf16_t* ZX = (const bf16_t*)(p.ws + WS_TMP + T_ZX); bf16_t* BCC = (bf16_t*)(p.ws + WS_BCC);
    const float* cw = p.in[13] + (size_t)sl * 4 * 3072 + 2048; const float* cb = p.in[14] + (size_t)sl * 3072 + 2048;
    const int gt = obx() * NTHR + otid(), nthr = ogd() * NTHR;
    const int cg = gt & 127;
    float w[4][8], bias[8];
#pragma unroll
    for (int k = 0; k < 4; ++k) { const f32x4 a = *(const f32x4*)(cw + k * 3072 + cg * 8), b = *(const f32x4*)(cw + k * 3072 + cg * 8 + 4);
        w[k][0] = a[0]; w[k][1] = a[1]; w[k][2] = a[2]; w[k][3] = a[3]; w[k][4] = b[0]; w[k][5] = b[1]; w[k][6] = b[2]; w[k][7] = b[3]; }
    { const f32x4 a = *(const f32x4*)(cb + cg * 8), b = *(const f32x4*)(cb + cg * 8 + 4); bias[0] = a[0]; bias[1] = a[1]; bias[2] = a[2]; bias[3] = a[3]; bias[4] = b[0]; bias[5] = b[1]; bias[6] = b[2]; bias[7] = b[3]; }
    for (int item = gt; item < (MT / 4) * 128; item += nthr) {
        const int t0 = (item >> 7) * 4, pos0 = t0 & (SEQ - 1);
        u32x4 raw[7];
#pragma unroll
        for (int r = 0; r < 7; ++r) raw[r] = (pos0 - 3 + r) >= 0 ? *(const u32x4*)(ZX + (size_t)(t0 - 3 + r) * ZXLD + 4096 + cg * 8) : (u32x4){0u, 0u, 0u, 0u};
#pragma unroll
        for (int li = 0; li < 4; ++li) { float o[8];
#pragma unroll
            for (int i = 0; i < 8; ++i) { float v = bias[i];
#pragma unroll
                for (int k = 0; k < 4; ++k) { const unsigned wv = raw[li + k][i >> 1]; v = fmaf(w[k][i], (i & 1) ? bfhi(wv) : bflo(wv), v); }
                o[i] = pg8::silu_f(v); }
            u32x4 q; q.x = pk2(o[0], o[1]); q.y = pk2(o[2], o[3]); q.z = pk2(o[4], o[5]); q.w = pk2(o[6], o[7]);
            *(u32x4*)(BCC + (size_t)(t0 + li) * 1024 + cg * 8) = q; }
    }
}
template <bool DRY>
__device__ __forceinline__ void ssd_item(ldsp lds, const Params& p, int sl, int item) {
    const int tid = otid(), lane = tid & 63, wid = tid >> 6, fr = lane & 15, g = lane >> 4;
    const int b = item >> 6, h = (item >> 1) & 31, ph = item & 1, grp = h >> 3;
    bf16_t* ZX = (bf16_t*)(p.ws + WS_TMP + T_ZX); const float* DT = (const float*)(p.ws + WS_TMP + T_DT); float* SSQ = (float*)(p.ws + WS_TMP + T_SSQ);
    const float* cw_ = p.in[13] + (size_t)sl * 4 * 3072; const float* cb_ = p.in[14] + (size_t)sl * 3072;
    const float dtb = p.in[15][sl * 32 + h], av = -__expf(p.in[16][sl * 32 + h]), dsk = p.in[17][sl * 32 + h];
    const size_t tb = (size_t)b * SEQ;
    ldsp Cc = lds, Bc = lds + 34816, BcT = lds + 69632, XdT = lds + 104448, XwT = lds + 113152, Hb = lds + 121856, Xs = lds + 130560;
    LAS float* dtv = (LAS float*)(lds + 140800); LAS float* acs = (LAS float*)(lds + 141312);
    f32x4 hst[2] = {{0.f, 0.f, 0.f, 0.f}, {0.f, 0.f, 0.f, 0.f}};
    for (int i = tid; i < 32 * RS / 4; i += NTHR) ((LAS unsigned*)Hb)[i] = 0u;
    LAS float* cwl = (LAS float*)(lds + 141824);
    for (int i = tid; i < 1440; i += NTHR) { int which, k, ch, chan;
        if (i < 640) { which = 0; k = i >> 7; ch = i & 127; chan = 2048 + grp * 128 + ch; } else if (i < 1280) { which = 1; k = (i - 640) >> 7; ch = (i - 640) & 127; chan = 2560 + grp * 128 + ch; }
        else { which = 2; k = (i - 1280) >> 5; ch = (i - 1280) & 31; chan = h * 64 + ph * 32 + ch; }
        (void)which; cwl[i] = k < 4 ? cw_[k * 3072 + chan] : cb_[chan]; }
    __syncthreads();
    const int cgi = tid & 15, l0s = (tid >> 4) * 4, c0B = 2048 + grp * 128 + cgi * 8, c0C = c0B + 512;
    const int cgx = tid & 3, lx = tid >> 2, c0X = h * 64 + ph * 32 + cgx * 8;
    const bf16_t* BCC = (const bf16_t*)(p.ws + WS_BCC) + grp * 128;
    u32x4 rawB[4], rawC[4], rawX[4]; float dtr0 = 0.f, dtr1 = 0.f;
#define LOAD_BC(dst, tok0, off) do { _Pragma("unroll") for (int r_ = 0; r_ < 4; ++r_) dst[r_] = *(const u32x4*)(BCC + (size_t)((tok0) + r_) * 1024 + (off) + cgi * 8); } while (0)
    LOAD_BC(rawC, tb + l0s, 512); load4(ZX, tb, lx, 2048 + c0X, rawX);
    LOAD_BC(rawB, tb + l0s, 0);
    if (wid == 7) { dtr0 = DT[(tb + 2 * lane) * 32 + h]; dtr1 = DT[(tb + 2 * lane + 1) * 32 + h]; }
#pragma unroll 1
    for (int c = 0; c < 64; ++c) {
        const int cp = c * 128;
        int tidc = tid; asm volatile("" : "+v"(tidc));
        const int lane = tidc & 63, wid = tidc >> 6, fr = lane & 15, g = lane >> 4;
        const int cgi = tidc & 15, l0s = (tidc >> 4) * 4, c0B = 2048 + grp * 128 + cgi * 8, c0C = c0B + 512;
        const int cgx = tidc & 3, lx = tidc >> 2, c0X = h * 64 + ph * 32 + cgx * 8;
        u32x2 zpre[2];
        { bf16_t* zp = ZX + (tb + cp + 16 * wid + fr) * ZXLD + h * 64 + ph * 32 + 4 * g; zpre[0] = *(const u32x2*)zp; zpre[1] = *(const u32x2*)(zp + 16); }
        if (wid == 7) {
            const float r0 = dtr0 + dtb, r1 = dtr1 + dtb;
            if (c + 1 < 64) { dtr0 = DT[(tb + cp + 128 + 2 * lane) * 32 + h]; dtr1 = DT[(tb + cp + 128 + 2 * lane + 1) * 32 + h]; }
            const float d0 = softplus_f(r0), d1 = softplus_f(r1);
            const float a0 = d0 * av, a1 = d1 * av; float sc = a0 + a1;
#pragma unroll
            for (int d = 1; d < 64; d <<= 1) { const float t = __shfl_up(sc, d); if (lane >= d) sc += t; }
            dtv[2 * lane] = d0; dtv[2 * lane + 1] = d1; acs[2 * lane] = sc - a1; acs[2 * lane + 1] = sc;
        }
        { const int l0 = l0s;
#pragma unroll
          for (int li = 0; li < 4; ++li) { *(LAS u32x4*)(Bc + (l0 + li) * RS + cgi * 16) = rawB[li]; *(LAS u32x4*)(Cc + (l0 + li) * RS + cgi * 16) = rawC[li]; }
#pragma unroll
          for (int i = 0; i < 8; ++i) { u32x2 w;
              if (i & 1) { w.x = (rawB[0][i >> 1] >> 16) | (rawB[1][i >> 1] & 0xFFFF0000u); w.y = (rawB[2][i >> 1] >> 16) | (rawB[3][i >> 1] & 0xFFFF0000u); }
              else { w.x = (rawB[0][i >> 1] & 0xFFFFu) | (rawB[1][i >> 1] << 16); w.y = (rawB[2][i >> 1] & 0xFFFFu) | (rawB[3][i >> 1] << 16); }
              *(LAS u32x2*)(BcT + (cgi * 8 + i) * RS + l0 * 2) = w; }
          if (c + 1 < 64) LOAD_BC(rawB, tb + cp + 128 + l0, 0); }
        __syncthreads();
        const float aend = acs[127];
        { float o8[8]; conv1l(rawX, cwl + 1280 + cgx * 8, 32, o8);
          const float dl = dtv[lx], wl = dl * __expf(aend - acs[lx]);
          u32x4 w; w.x = pk2(o8[0], o8[1]); w.y = pk2(o8[2], o8[3]); w.z = pk2(o8[4], o8[5]); w.w = pk2(o8[6], o8[7]);
          *(LAS u32x4*)(Xs + lx * 80 + cgx * 16) = w;
#pragma unroll
          for (int i = 0; i < 8; i += 2) { const int pp = cgx * 8 + i; const unsigned a2 = pk2(o8[i] * dl, o8[i + 1] * dl), b2 = pk2(o8[i] * wl, o8[i + 1] * wl);
              *(LAS unsigned short*)(XdT + pp * RS + lx * 2) = (unsigned short)(a2 & 0xFFFFu); *(LAS unsigned short*)(XdT + (pp + 1) * RS + lx * 2) = (unsigned short)(a2 >> 16);
              *(LAS unsigned short*)(XwT + pp * RS + lx * 2) = (unsigned short)(b2 & 0xFFFFu); *(LAS unsigned short*)(XwT + (pp + 1) * RS + lx * 2) = (unsigned short)(b2 >> 16); } }
        u32x2 mm[8];
        { bf16x8 a[4];
#pragma unroll
          for (int ks = 0; ks < 4; ++ks) a[ks] = ld_lds128(Bc + (16 * wid + fr) * RS + ks * 64 + g * 16);
          float as4[4];
#pragma unroll
          for (int j = 0; j < 4; ++j) as4[j] = acs[16 * wid + 4 * g + j];
#pragma unroll
          for (int lt = 0; lt < 8; ++lt) {
              mm[lt] = (u32x2){0u, 0u};
              if (lt >= wid) {
                  f32x4 acc = {0.f, 0.f, 0.f, 0.f};
#pragma unroll
                  for (int ks = 0; ks < 4; ++ks) acc = mfma16(a[ks], ld_lds128(Cc + (lt * 16 + fr) * RS + ks * 64 + g * 16), acc);
                  const int l = lt * 16 + fr; const float al = acs[l]; float v[4];
#pragma unroll
                  for (int j = 0; j < 4; ++j) { const int s = 16 * wid + 4 * g + j; v[j] = (s <= l) ? acc[j] * __expf(al - as4[j]) : 0.f; }
                  mm[lt].x = pk2(v[0], v[1]); mm[lt].y = pk2(v[2], v[3]); } } }
        __syncthreads();
#pragma unroll
        for (int lt = 0; lt < 8; ++lt) *(LAS u32x2*)(Bc + (lt * 16 + fr) * RS + (16 * wid + 4 * g) * 2) = mm[lt];
        __syncthreads();
        if (c + 1 < 64) { LOAD_BC(rawC, tb + cp + 128 + l0s, 512); load4(ZX, tb, cp + 128 + lx, 2048 + c0X, rawX); }
        { f32x4 y1[2] = {{0.f, 0.f, 0.f, 0.f}, {0.f, 0.f, 0.f, 0.f}}, y2[2] = {{0.f, 0.f, 0.f, 0.f}, {0.f, 0.f, 0.f, 0.f}};
          const int l = 16 * wid + fr;
#pragma unroll
          for (int ks = 0; ks < 4; ++ks) {
              const bf16x8 bm = ld_lds128(Bc + l * RS + ks * 64 + g * 16), bc = ld_lds128(Cc + l * RS + ks * 64 + g * 16);
#pragma unroll
              for (int pt = 0; pt < 2; ++pt) { y1[pt] = mfma16(ld_lds128(XdT + (pt * 16 + fr) * RS + ks * 64 + g * 16), bm, y1[pt]); y2[pt] = mfma16(ld_lds128(Hb + (pt * 16 + fr) * RS + ks * 64 + g * 16), bc, y2[pt]); } }
          const float el = __expf(acs[l]); const size_t tg = tb + cp + l; float sq = 0.f;
#pragma unroll
          for (int pt = 0; pt < 2; ++pt) { const int pp = pt * 16 + 4 * g;
              const u32x2 xs2 = *(LAS const u32x2*)(Xs + l * 80 + pp * 2); bf16_t* zp = ZX + tg * ZXLD + h * 64 + ph * 32 + pp; const u32x2 z2 = zpre[pt];
              float yv[4], xv[4] = {bflo(xs2.x), bfhi(xs2.x), bflo(xs2.y), bfhi(xs2.y)}, zv[4] = {bflo(z2.x), bfhi(z2.x), bflo(z2.y), bfhi(z2.y)};
#pragma unroll
              for (int j = 0; j < 4; ++j) { yv[j] = (y1[pt][j] + el * y2[pt][j] + xv[j] * dsk) * pg8::silu_f(zv[j]); sq += yv[j] * yv[j]; }
              u32x2 w; w.x = pk2(yv[0], yv[1]); w.y = pk2(yv[2], yv[3]);
              if (DRY) *(u32x2*)((bf16_t*)(p.ws + WS_END + 65536) + (((size_t)(zp - ZX)) & 0xFFFFFCull)) = w; else *(u32x2*)zp = w; }
          sq += __shfl_xor(sq, 16); sq += __shfl_xor(sq, 32);
          if (g == 0) { if (DRY) ((float*)(p.ws + WS_END + 65536 + 40000000))[(tg * 64 + h * 2 + ph) & 0xFFFFF] = sq; else SSQ[tg * 64 + h * 2 + ph] = sq; } }
        { const float dec = __expf(aend);
          hst[0] = hst[0] * dec; hst[1] = hst[1] * dec;
#pragma unroll
          for (int ks = 0; ks < 4; ++ks) { const bf16x8 ab = ld_lds128(BcT + (16 * wid + fr) * RS + ks * 64 + g * 16);
#pragma unroll
              for (int pt = 0; pt < 2; ++pt) hst[pt] = mfma16(ab, ld_lds128(XwT + (pt * 16 + fr) * RS + ks * 64 + g * 16), hst[pt]); } }
        __syncthreads();
#pragma unroll
        for (int pt = 0; pt < 2; ++pt) { u32x2 w; w.x = pk2(hst[pt][0], hst[pt][1]); w.y = pk2(hst[pt][2], hst[pt][3]); *(LAS u32x2*)(Hb + (pt * 16 + fr) * RS + (16 * wid + 4 * g) * 2) = w; }
    }
    __syncthreads();
#undef LOAD_BC
}
__device__ __forceinline__ void ssd_norm_phase(const Params& p) {
    bf16_t* ZX = (bf16_t*)(p.ws + WS_TMP + T_ZX); const float* SSQ = (const float*)(p.ws + WS_TMP + T_SSQ);
    const int tid_ = otid(); const int lane = tid_ & 63, gw = obx() * 8 + (tid_ >> 6), nw = ogd() * 8;
    for (int row0 = gw; row0 < MT; row0 += 2 * nw) {
        float part[2]; u32x4 v[2][4];
#pragma unroll
        for (int r = 0; r < 2; ++r) { const int row = row0 + r * nw; const size_t rr = (size_t)(row < MT ? row : row0);
            part[r] = SSQ[rr * 64 + lane];
#pragma unroll
            for (int i = 0; i < 4; ++i) v[r][i] = *(const u32x4*)(ZX + rr * ZXLD + i * 512 + lane * 8); }
#pragma unroll
        for (int r = 0; r < 2; ++r) { const int row = row0 + r * nw;
            float pt = part[r]; pt += __shfl_xor(pt, 1); pt += __shfl_xor(pt, 2); pt += __shfl_xor(pt, 4); pt += __shfl_xor(pt, 8);
#pragma unroll
            for (int i = 0; i < 4; ++i) { const float rs = rsqrtf(__shfl(pt, i * 16) * (1.0f / 512.0f) + RMS_EPS); u32x4 w;
#pragma unroll
                for (int k = 0; k < 4; ++k) w[k] = pk2(bflo(v[r][i][k]) * rs, bfhi(v[r][i][k]) * rs);
                if (row < MT) *(u32x4*)(ZX + (size_t)row * ZXLD + i * 512 + lane * 8) = w; } }
    }
}

#define XB_TMO      128
#define XB_XCNT(j)  (256  + 64 * (j))
#define XB_XSUB(j)  (1280 + 64 * (j))
#define XB_XGEN(j)  (2304 + 64 * (j))
#define XB_TOP      3328
#define XB_TOPGEN   3392
#define XCD_BAR_WORDS 3456
#define XB_SPIN_CAP (1u << 20)
__device__ __forceinline__ unsigned xb_ld(unsigned* p)              { return __hip_atomic_load(p, __ATOMIC_RELAXED, __HIP_MEMORY_SCOPE_AGENT); }
__device__ __forceinline__ unsigned xb_add(unsigned* p, unsigned v) { return __hip_atomic_fetch_add(p, v, __ATOMIC_RELAXED, __HIP_MEMORY_SCOPE_AGENT); }
__device__ __forceinline__ unsigned xb_xcc_id() { return (unsigned)__builtin_amdgcn_s_getreg((3 << 11) | 20) & 0xFu; }
#define XB_SPIN(cond, bar) do { unsigned _sp = 0; while (cond) { __builtin_amdgcn_s_sleep(1); \
    if ((++_sp & 255u) == 0u) { if (xb_ld(&(bar)[XB_TMO])) break; if (_sp > XB_SPIN_CAP) { atomicAdd(&(bar)[XB_TMO], 1u); break; } } } } while (0)
struct XcdBarrier { unsigned* bar; unsigned x; volatile LAS unsigned* st; };
__device__ __forceinline__ void xcd_barrier_complete(unsigned* bar, unsigned x, unsigned& nloc, unsigned& nx) {
    const unsigned G = gridDim.x * gridDim.y * gridDim.z;
    unsigned sum, cnt, mine, sp = 0u;
    for (;;) {
        sum = 0u; cnt = 0u; mine = 0u;
#pragma unroll
        for (unsigned j = 0; j < 16; ++j) { const unsigned c = xb_ld(&bar[XB_XCNT(j)]); sum += c; cnt += (c > 0u) ? 1u : 0u; mine = (j == x) ? c : mine; }
        if (sum == G) break;
        __builtin_amdgcn_s_sleep(1);
        if ((++sp & 255u) == 0u) { if (xb_ld(&bar[XB_TMO])) break; if (sp > XB_SPIN_CAP) { atomicAdd(&bar[XB_TMO], 1u); break; } }
    }
    nloc = mine > 0u ? mine : 1u; nx = cnt > 0u ? cnt : 1u;
}
__device__ __forceinline__ void xcd_barrier(const XcdBarrier& b) {
    asm volatile("s_waitcnt vmcnt(0)" ::: "memory");
    __syncthreads();
    if (otid() == 0) {
        unsigned* bar = b.bar;
        __builtin_amdgcn_s_waitcnt(0);
        unsigned nloc = b.st[0], nx = b.st[1];
        if (nloc == 0u) { xcd_barrier_complete(bar, b.x, nloc, nx); b.st[0] = nloc; b.st[1] = nx; }
        const unsigned old = xb_add(&bar[XB_XSUB(b.x)], 1u);
        const unsigned gen = old / nloc;
        if (old + 1u == (gen + 1u) * nloc) {
            __builtin_amdgcn_fence(__ATOMIC_RELEASE, "agent");
            asm volatile("s_waitcnt vmcnt(0)" ::: "memory");
            const unsigned og = xb_add(&bar[XB_TOP], 1u);
            const unsigned tg = og / nx;
            if (og + 1u == (tg + 1u) * nx) xb_add(&bar[XB_TOPGEN], 1u);
            else XB_SPIN(xb_ld(&bar[XB_TOPGEN]) == tg, bar);
            __builtin_amdgcn_fence(__ATOMIC_ACQUIRE, "agent");
            xb_add(&bar[XB_XGEN(b.x)], 1u);
            asm volatile("s_waitcnt vmcnt(0)" ::: "memory");
        } else {
            XB_SPIN(xb_ld(&bar[XB_XGEN(b.x)]) == gen, bar);
            __builtin_amdgcn_fence(__ATOMIC_ACQUIRE, "agent");
            asm volatile("s_waitcnt vmcnt(0)" ::: "memory");
        }
    }
    __syncthreads();
}
constexpr size_t WS_BAR = WS_END;
constexpr int LDS_BARST = LDS_BYTES - 16;
#define GRID_BAR() do { XcdBarrier _b; { const Params _q = load_params(); _b.bar = (unsigned*)(_q.ws + WS_BAR); } _b.x = xb_xcc_id(); _b.st = (volatile LAS unsigned*)(lds + LDS_BARST); xcd_barrier(_b); } while (0)

__global__ void __launch_bounds__(NTHR, 2) fwd_megakernel(Params p) {
    extern __shared__ __attribute__((aligned(16))) unsigned char smem[];
    ldsp lds = (ldsp)smem;
    cg::grid_group grid = cg::this_grid();
    if (otid() == 0) { ((volatile LAS unsigned*)(lds + LDS_BARST))[0] = 0u; ((volatile LAS unsigned*)(lds + LDS_BARST))[1] = 0u; }
    __syncthreads();
    { const Params q = load_params(); if (otid() == 0) (void)xb_add(&((unsigned*)(q.ws + WS_BAR))[XB_XCNT(xb_xcc_id())], 1u); }
    { const Params q = load_params(); cvt_x_phase(q.in[0], (bf16_t*)(q.ws + WS_XB)); }
#ifndef NO_CONV
    { const Params q = load_params(); convert_layer(lds, q, 0); }
#endif
    if (ogd() == 0x7FFFFFF) grid.sync();
    GRID_BAR();
#pragma unroll 1
    for (int sub = 0; sub < 12; ++sub) {
        const int L = sub / 3, kind = sub % 3, sl = L >> 1; const bool attn = (L & 1) == 0;
#if defined(SKIP_ATTN) || defined(SKIP_SSM)
        {
#if defined(SKIP_ATTN) && defined(SKIP_SSM)
            const bool skip = kind == 1;
#elif defined(SKIP_ATTN)
            const bool skip = kind == 1 && attn;
#else
            const bool skip = kind == 1 && !attn;
#endif
            if (skip) { const Params q = load_params(); ln_phase<false>(q.out, (bf16_t*)(q.ws + WS_XB), q.in[1] + (size_t)(L * 3 + kind) * DM, q.in[2] + (size_t)(L * 3 + kind) * DM, nullptr, sub == 11); GRID_BAR(); continue; }
        }
#endif
        if (kind != 1) {
            const Params q = load_params(); const int G = ogd(), bx = obx();
            pg8::Gemm gm{(const bf16_t*)(q.ws + WS_XB), (const bf16_t*)(q.ws + WS_WL + (kind == 0 ? WL_F1IN : WL_F2IN)), MT, 5632, 1024, 1024}; pg8::StaticOrder S; S.init(MT, 5632, G, bx);
            pg8::EpiSwiglu E{(bf16_t*)(q.ws + WS_TMP + T_H)};
            pg8::gemm_phase<pg8::EpiSwiglu, pg8::StaticOrder>((PG8_LAS unsigned char*)lds, gm, S, E, nullptr);
        } else {
            const Params q = load_params(); const int G = ogd(), bx = obx(); unsigned char* tmp = q.ws + WS_TMP;
            const int N = attn ? 2048 : 5376;
            pg8::Gemm gm{(const bf16_t*)(q.ws + WS_XB), (const bf16_t*)(q.ws + WS_WL + WL_MIX), MT, N, 1024, 1024}; pg8::StaticOrder S; S.init(MT, N, G, bx);
            pg8::EpiSplit E{(bf16_t*)tmp, attn ? QBLD : ZXLD, attn ? 7 : 20, (float*)(tmp + (attn ? T_CKV : T_DT)), attn ? 256 : 32, attn ? 256 : 32, (bf16_t*)(tmp + T_KW), attn ? 6 : -1};
            pg8::gemm_phase<pg8::EpiSplit, pg8::StaticOrder>((PG8_LAS unsigned char*)lds, gm, S, E, nullptr);
        }
        GRID_BAR();
        if (kind == 1) {
            if (attn) {
                { const Params q = load_params(); ckv_norm_phase((const float*)(q.ws + WS_TMP + T_CKV), (bf16_t*)(q.ws + WS_TMP + T_CKVN), q.in[8] + (size_t)sl * 256); }
#ifndef NO_IDX
                { const Params q = load_params(); indexer_phase(lds, q); }
#ifdef DBL_IDX
                { const Params q = load_params(); indexer_phase(lds, q); }
#endif
#endif
                GRID_BAR();
#ifndef NO_SATTN
                { const Params q = load_params(); sattn_phase(lds, q); }
#ifdef DBL_SATTN
                { const Params q = load_params(); sattn_phase(lds, q); }
#endif
#else
                { const Params q = load_params(); u32x4* Oz = (u32x4*)(q.ws + WS_TMP + T_O); for (size_t i = (size_t)obx() * NTHR + otid(); i < (size_t)MT * 1024 / 8; i += (size_t)ogd() * NTHR) Oz[i] = (u32x4){0u, 0u, 0u, 0u}; }
#endif
                GRID_BAR();
            } else {
                { const Params q = load_params(); bc_conv_phase(q, sl); }
                GRID_BAR();
#ifndef NO_SSD
#ifdef DBL_SSD
                { const Params q = load_params(); const int G = ogd(); for (int it = obx(); it < 256; it += G) ssd_item<true>(lds, q, sl, it); }
#endif
                { const Params q = load_params(); const int G = ogd();
                  for (int it = obx(); it < 256; it += G) { int item = it;
                      if (G == 256) { const int xcd = it & 7, slot = it >> 3, bg = xcd * 2 + (slot >> 4), wi = slot & 15; item = ((bg >> 2) << 6) | ((((bg & 3) * 8) + (wi >> 1)) << 1) | (wi & 1); }
                      ssd_item<false>(lds, q, sl, item); } }
#endif
                GRID_BAR();
                { const Params q = load_params(); ssd_norm_phase(q); }
                GRID_BAR();
            }
        }
        {
            const Params q = load_params(); const int G = ogd(), bx = obx(); unsigned char* tmp = q.ws + WS_TMP; unsigned char* wl = q.ws + WS_WL;
            const bf16_t* A2 = (const bf16_t*)(tmp + T_H); int K2 = DFF, lda2 = DFF; const bf16_t* B2 = (const bf16_t*)(wl + (kind == 0 ? WL_F1OUT : WL_F2OUT)); float sc2 = 0.5f;
            if (kind == 1) { sc2 = 1.0f;
                if (attn) { A2 = (const bf16_t*)(tmp + T_O); K2 = 1024; lda2 = 1024; B2 = (const bf16_t*)(wl + WL_MIX + WM_AOUT); }
                else { A2 = (const bf16_t*)(tmp + T_ZX); K2 = 2048; lda2 = ZXLD; B2 = (const bf16_t*)(wl + WL_MIX + WM_SOUT); } }
            pg8::Gemm gm{A2, B2, MT, 1024, K2, lda2}; pg8::StaticOrder S; S.init(MT, 1024, G, bx);
            pg8::EpiResid E{(bf16_t*)(q.ws + WS_XB), ALPHA, sc2};
            pg8::gemm_phase<pg8::EpiResid, pg8::StaticOrder>((PG8_LAS unsigned char*)lds, gm, S, E, nullptr);
        }
        GRID_BAR();
#ifdef DBL_LN
        { const Params q = load_params(); ln_phase<true>(q.out, (bf16_t*)(q.ws + WS_XB), q.in[1] + (size_t)(L * 3 + kind) * DM, q.in[2] + (size_t)(L * 3 + kind) * DM, q.ws + WS_END + 65536, sub == 11); }
#endif
        { const Params q = load_params(); ln_phase<false>(q.out, (bf16_t*)(q.ws + WS_XB), q.in[1] + (size_t)(L * 3 + kind) * DM, q.in[2] + (size_t)(L * 3 + kind) * DM, nullptr, sub == 11); }
#ifndef NO_CONV
        if (kind == 2 && L < 3) { const Params q = load_params(); convert_layer(lds, q, L + 1); }
#endif
        GRID_BAR();
    }
}

extern "C" void kernel_launch(void* const* d_in, const int* in_sizes, int n_in, void* d_out, int out_size, void* d_ws, size_t ws_size, hipStream_t stream) {
    static int grid_blocks = 0;
    if (grid_blocks == 0) {
        if (n_in != 20 || ws_size < WS_BCC + (size_t)MT * 1024 * 2) { fprintf(stderr, "kernel_launch: unexpected inputs (n_in %d, ws %zu < %zu)\n", n_in, ws_size, (size_t)WS_END); grid_blocks = -1; return; }
        int dev = 0, cus = 0, per_cu = 0;
        hipGetDevice(&dev); hipDeviceGetAttribute(&cus, hipDeviceAttributeMultiprocessorCount, dev);
        if (hipFuncSetAttribute((const void*)fwd_megakernel, hipFuncAttributeMaxDynamicSharedMemorySize, LDS_BYTES) != hipSuccess) { fprintf(stderr, "kernel_launch: hipFuncSetAttribute failed\n"); grid_blocks = -1; return; }
        hipOccupancyMaxActiveBlocksPerMultiprocessor(&per_cu, (const void*)fwd_megakernel, NTHR, LDS_BYTES);
        if (per_cu < 1) { fprintf(stderr, "kernel_launch: occupancy query says %d blocks per CU\n", per_cu); per_cu = 1; }
        (void)hipGetLastError();
        grid_blocks = cus * per_cu;
    }
    if (grid_blocks < 0) return;
    if (hipMemsetAsync((char*)d_ws + WS_BAR, 0, XCD_BAR_WORDS * 4, stream) != hipSuccess) { fprintf(stderr, "kernel_launch: memset of the barrier words failed\n"); return; }
    Params p{};
    for (int i = 0; i < 20; ++i) p.in[i] = (const float*)d_in[i];
    p.out = (float*)d_out; p.ws = (unsigned char*)d_ws;
    void* args[] = {&p};
    hipError_t e = hipLaunchCooperativeKernel((const void*)fwd_megakernel, dim3(grid_blocks), dim3(NTHR), args, LDS_BYTES, stream);
    if (e != hipSuccess) fprintf(stderr, "cooperative launch failed: %s (grid %d)\n", hipGetErrorString(e), grid_blocks);
}
```

```cpp
#include <hip/hip_runtime.h>
#include <hip/hip_cooperative_groups.h>
#include <cstdio>
namespace cg = cooperative_groups;
namespace pg8 {
#define PG8_LAS __attribute__((address_space(3)))
typedef unsigned short bf16_t;
typedef short bf16x8 __attribute__((ext_vector_type(8)));
typedef float f32x4 __attribute__((ext_vector_type(4)));
typedef unsigned u32x4 __attribute__((ext_vector_type(4)));
constexpr int BM = 256, BK = 64, HALF = 128, HTB = HALF * BK * 2  , STAGE_BYTES = 8 * HTB, NXCD = 8, WGM = 8;

__host__ __device__ __forceinline__ int lds_byte(int r, int c) { const int st = (r >> 4) * 2 + (c >> 5), rr = r & 15, cc = c & 31, ob = rr * 64 + cc * 2; return st * 1024 + (ob ^ (((ob >> 9) & 1) << 5)); }
__host__ __device__ __forceinline__ void stage_rc(int b, int& R, int& C) { const int st = b / 1024, sb = b % 1024, swz = sb ^ (((sb >> 9) & 1) << 5); R = (st >> 1) * 16 + swz / 64; C = (st & 1) * 32 + (swz % 64) / 2; }
__host__ __device__ __forceinline__ int perm32(int rho) { const int n = rho >> 4, i = rho & 15; return 8 * (i >> 2) + 4 * n + (i & 3); }

struct Unit { int pm, pn; };
struct Gemm { const bf16_t* A; const bf16_t* Bt; int M, N, K, lda; };

struct StaticOrder {
    int nM, nN, nwg, G, c;
    __host__ __device__ void init(int M, int N, int G_, int c_) { nM = M / BM; nN = N / BM; nwg = nM * nN; G = G_; c = c_; }
    __host__ __device__ bool next(int i, Unit& u) const {
        const long L = (long)i * G + c; if (L >= nwg) return false;
        int wgid = (int)L; { const int q = nwg / NXCD, r = nwg % NXCD, xcd = wgid % NXCD, off = wgid / NXCD; wgid = (xcd < r ? xcd * (q + 1) : r * (q + 1) + (xcd - r) * q) + off; }
        const int nig = WGM * nN, gid = wgid / nig, fm = gid * WGM, gsz = (nM - fm) < WGM ? (nM - fm) : WGM;
        u.pm = fm + ((wgid % nig) % gsz); u.pn = (wgid % nig) / gsz; return true;
    }
    __device__ __forceinline__ void a_ready(const Unit&) const {}
    __device__ __forceinline__ void done(const Unit&) const {}
};
typedef __bf16 bf16x2_t __attribute__((ext_vector_type(2)));
typedef float f32x2_t __attribute__((ext_vector_type(2)));
__device__ __forceinline__ unsigned cvt_pk_bf16(float lo, float hi) { const f32x2_t f = {lo, hi}; const bf16x2_t v = __builtin_convertvector(f, bf16x2_t); return __builtin_bit_cast(unsigned, v); }
__device__ __forceinline__ float silu_f(float x) { return x * __builtin_amdgcn_rcpf(1.0f + __expf(-x)); }
struct EpiSwiglu {
    static constexpr bool PERM = true, AFTER_DRAIN = false;
    bf16_t* H;
    __device__ __forceinline__ void operator()(const f32x4 (&acc)[2][2][4][2], const Unit& u, int wr, int wc, int fr, int fq) const {
        const int row0 = u.pm * BM + wr * 64 + fr, col0 = u.pn * 128 + wc * 32 + 8 * fq;
#pragma unroll
        for (int ai = 0; ai < 2; ++ai)
#pragma unroll
            for (int m = 0; m < 4; ++m) {
                bf16_t* rowp = H + (size_t)(row0 + ai * HALF + m * 16) * 2816 + col0;
                const f32x4 g0 = acc[ai][0][m][0], g1 = acc[ai][0][m][1], u0 = acc[ai][1][m][0], u1 = acc[ai][1][m][1];
                u32x4 w;
                w.x = cvt_pk_bf16(silu_f(g0[0]) * u0[0], silu_f(g0[1]) * u0[1]); w.y = cvt_pk_bf16(silu_f(g0[2]) * u0[2], silu_f(g0[3]) * u0[3]);
                w.z = cvt_pk_bf16(silu_f(g1[0]) * u1[0], silu_f(g1[1]) * u1[1]); w.w = cvt_pk_bf16(silu_f(g1[2]) * u1[2], silu_f(g1[3]) * u1[3]);
                *(u32x4*)rowp = w; }
    }
};
struct EpiResid {
    static constexpr bool PERM = false, AFTER_DRAIN = false;
    bf16_t* X; float alpha, scale;
    __device__ __forceinline__ void operator()(const f32x4 (&acc)[2][2][4][2], const Unit& u, int wr, int wc, int fr, int fq) const {
        const int row0 = u.pm * BM + wr * 64 + fr, col0 = u.pn * BM + wc * 32 + 4 * fq;
        typedef unsigned u32x2_t __attribute__((ext_vector_type(2)));
#pragma unroll
        for (int ai = 0; ai < 2; ++ai)
#pragma unroll
            for (int m = 0; m < 4; ++m) { const size_t ro = (size_t)(row0 + ai * HALF + m * 16) * 1024 + col0;
#pragma unroll
                for (int bj = 0; bj < 2; ++bj)
#pragma unroll
                    for (int n = 0; n < 2; ++n) { const size_t o = ro + bj * HALF + n * 16; const u32x2_t rb = *(const u32x2_t*)(X + o);
                        f32x4 r; r[0] = __uint_as_float(rb.x << 16); r[1] = __uint_as_float(rb.x & 0xFFFF0000u); r[2] = __uint_as_float(rb.y << 16); r[3] = __uint_as_float(rb.y & 0xFFFF0000u);
                        const f32x4 y = r * alpha + acc[ai][bj][m][n] * scale; u32x2_t w; w.x = cvt_pk_bf16(y[0], y[1]); w.y = cvt_pk_bf16(y[2], y[3]); *(u32x2_t*)(X + o) = w; } }
    }
};
struct EpiSplit {
    static constexpr bool PERM = true, AFTER_DRAIN = false;
    bf16_t* O; int ldo; int nb16; float* F; int ldf; int fcols; bf16_t* O2; int pn2;
    __device__ __forceinline__ void operator()(const f32x4 (&acc)[2][2][4][2], const Unit& u, int wr, int wc, int fr, int fq) const {
        const int row0 = u.pm * BM + wr * 64 + fr;
        if (u.pn < nb16) {
            const int col0 = u.pn * BM + wc * 32 + 8 * fq;
#pragma unroll
            for (int ai = 0; ai < 2; ++ai)
#pragma unroll
                for (int m = 0; m < 4; ++m) { bf16_t* rowp = O + (size_t)(row0 + ai * HALF + m * 16) * ldo + col0;
#pragma unroll
                    for (int bj = 0; bj < 2; ++bj) { const f32x4 v0 = acc[ai][bj][m][0], v1 = acc[ai][bj][m][1]; u32x4 w;
                        w.x = cvt_pk_bf16(v0[0], v0[1]); w.y = cvt_pk_bf16(v0[2], v0[3]); w.z = cvt_pk_bf16(v1[0], v1[1]); w.w = cvt_pk_bf16(v1[2], v1[3]);
                        *(u32x4*)(rowp + bj * HALF) = w;
                        if (u.pn == pn2 && bj == 0) *(u32x4*)(O2 + (size_t)(row0 + ai * HALF + m * 16) * 128 + wc * 32 + 8 * fq) = w; } }
        } else {
            const int col0 = (u.pn - nb16) * BM + wc * 32 + 8 * fq;
#pragma unroll
            for (int ai = 0; ai < 2; ++ai)
#pragma unroll
                for (int m = 0; m < 4; ++m) { float* rowp = F + (size_t)(row0 + ai * HALF + m * 16) * ldf;
#pragma unroll
                    for (int bj = 0; bj < 2; ++bj) { const int c = col0 + bj * HALF;
                        if (c < fcols) { *(f32x4*)(rowp + c) = acc[ai][bj][m][0]; *(f32x4*)(rowp + c + 4) = acc[ai][bj][m][1]; } } }
        }
    }
};
template <class Epi, class Sched, bool STAMP = false>
__device__ __forceinline__ void gemm_phase(PG8_LAS unsigned char* lds, const Gemm g, const Sched& S, const Epi& E, unsigned long long* stamps) {
    int tid = threadIdx.x; asm volatile("" : "+v"(tid)); const int wid = __builtin_amdgcn_readfirstlane(tid >> 6), lane = tid & 63, wr = wid >> 2, wc = wid & 3, fr = lane & 15, fq = lane >> 4;
    const int K = g.K, nt = K / BK;
    int ts_lo = 0, ts_hi = 0, nts = 0; const unsigned long long rt_entry = STAMP ? (unsigned long long)wall_clock64() : 0ull;
#define PG8_STAMP() do { if (STAMP && wid == 0 && nts < 64) { const unsigned long long _c = (unsigned long long)clock64(); \
        ts_lo = (lane == nts) ? (int)(unsigned)_c : ts_lo; ts_hi = (lane == nts) ? (int)(unsigned)(_c >> 32) : ts_hi; ++nts; } } while (0)
    PG8_STAMP();
    unsigned voffA[2], voffB[2];
#pragma unroll
    for (int i = 0; i < 2; ++i) { int R, C; stage_rc(tid * 16 + i * 8192, R, C); const int Rb = Epi::PERM ? ((R & ~31) + perm32(R & 31)) : R;
        voffA[i] = (unsigned)(R * g.lda + C) * 2u; voffB[i] = (unsigned)(Rb * K + C) * 2u; }
    const size_t kstep = (size_t)(BK * 2);
    const size_t hstep = (size_t)HALF * K * 2;
    const size_t tstep = 2 * hstep; const size_t hstepA = (size_t)HALF * g.lda * 2; const size_t tstepA = 2 * hstepA;
    const unsigned ldsw = (unsigned)wid * 1024u;
    const int aoff = lds_byte(wr * 64 + fr, fq * 8), boff = lds_byte(wc * 32 + fr, fq * 8);
#define PG8_SA(b, h) (((b) * 2 + (h)) * HTB)
#define PG8_SB(b, h) ((4 + (b) * 2 + (h)) * HTB)
#define PG8_STAGE(bufoff, gbase, voff) do { _Pragma("unroll") for (int _i = 0; _i < 2; ++_i) \
        __builtin_amdgcn_global_load_lds((const unsigned*)((const char*)(gbase) + (voff)[_i]), (PG8_LAS unsigned*)(lds + (bufoff) + ldsw + _i * 8192), 16, 0, 0); } while (0)
#define PG8_LDA(dst, b, h) do { _Pragma("unroll") for (int m = 0; m < 4; ++m) _Pragma("unroll") for (int k = 0; k < 2; ++k) dst[m][k] = *(const PG8_LAS bf16x8*)(lds + PG8_SA(b, h) + aoff + m * 2048 + k * 1024); } while (0)
#define PG8_LDB(dst, b, h) do { _Pragma("unroll") for (int n = 0; n < 2; ++n) _Pragma("unroll") for (int k = 0; k < 2; ++k) dst[n][k] = *(const PG8_LAS bf16x8*)(lds + PG8_SB(b, h) + boff + n * 2048 + k * 1024); } while (0)
#define PG8_MMA(ai, bj, At, Bt) do { __builtin_amdgcn_s_setprio(1); _Pragma("unroll") for (int m = 0; m < 4; ++m) _Pragma("unroll") for (int n = 0; n < 2; ++n) _Pragma("unroll") for (int k = 0; k < 2; ++k) \
        acc[ai][bj][m][n] = __builtin_amdgcn_mfma_f32_16x16x32_bf16(Bt[n][k], At[m][k], acc[ai][bj][m][n], 0, 0, 0); __builtin_amdgcn_s_setprio(0); } while (0)
#define PG8_WAIT_V(n) asm volatile("s_waitcnt vmcnt(" #n ")" ::: "memory")
#define PG8_WAIT_L(n) asm volatile("s_waitcnt lgkmcnt(" #n ")" ::: "memory")
#define PG8_BAR __builtin_amdgcn_s_barrier()
#define PG8_SCHED __builtin_amdgcn_sched_barrier(0)
    Unit cur, nxt; int ui = 0;
    if (!S.next(0, cur)) return;
    f32x4 acc[2][2][4][2];
#pragma unroll
    for (int a = 0; a < 2; ++a)
#pragma unroll
        for (int b = 0; b < 2; ++b)
#pragma unroll
            for (int m = 0; m < 4; ++m)
#pragma unroll
                for (int n = 0; n < 2; ++n) acc[a][b][m][n] = (f32x4){0.f, 0.f, 0.f, 0.f};
    bf16x8 At[4][2], B0[2][2], B1[2][2];
    const char* cA = (const char*)g.A + (size_t)cur.pm * tstepA; const char* cB = (const char*)g.Bt + (size_t)cur.pn * tstep;
    S.a_ready(cur);
    PG8_STAGE(PG8_SB(0, 0), cB, voffB); PG8_STAGE(PG8_SA(0, 0), cA, voffA); PG8_STAGE(PG8_SB(0, 1), cB + hstep, voffB); PG8_STAGE(PG8_SA(0, 1), cA + hstepA, voffA);
    if (wr == 1) PG8_BAR;
    PG8_WAIT_V(4); PG8_BAR;
    PG8_STAGE(PG8_SB(1, 0), cB + kstep, voffB); PG8_STAGE(PG8_SA(1, 0), cA + kstep, voffA); PG8_STAGE(PG8_SB(1, 1), cB + hstep + kstep, voffB);
    PG8_WAIT_V(6); PG8_BAR;
    PG8_STAMP();
    for (;;) {
        const bool has_next = S.next(ui + 1, nxt);
        const char* nA = has_next ? (const char*)g.A + (size_t)nxt.pm * tstepA : cA; const char* nB = has_next ? (const char*)g.Bt + (size_t)nxt.pn * tstep : cB;
        for (int t = 0; t < nt; t += 2) {
            const bool last = (t == nt - 2);
            const char* a1 = cA + (size_t)(t + 1) * kstep;
            const char* a2 = last ? nA : cA + (size_t)(t + 2) * kstep; const char* b2 = last ? nB : cB + (size_t)(t + 2) * kstep;
            const char* a3 = a2 + kstep; const char* b3 = b2 + kstep;
            if (last && has_next) S.a_ready(nxt);
            PG8_LDB(B0, 0, 0); PG8_SCHED; PG8_LDA(At, 0, 0); PG8_STAGE(PG8_SA(1, 1), a1 + hstepA, voffA);
            PG8_WAIT_L(8); PG8_BAR; PG8_WAIT_L(0); PG8_MMA(0, 0, At, B0); PG8_BAR; PG8_SCHED;
            PG8_LDB(B1, 0, 1); PG8_STAGE(PG8_SB(0, 0), b2, voffB);
            PG8_BAR; PG8_WAIT_L(0); PG8_MMA(0, 1, At, B1); PG8_BAR;
            PG8_LDA(At, 0, 1); PG8_STAGE(PG8_SA(0, 0), a2, voffA);
            PG8_BAR; PG8_WAIT_L(0); PG8_MMA(1, 0, At, B0); PG8_BAR; PG8_SCHED;
            PG8_STAGE(PG8_SB(0, 1), b2 + hstep, voffB);
            PG8_WAIT_V(6); PG8_BAR; PG8_MMA(1, 1, At, B1); PG8_BAR;
            PG8_LDB(B0, 1, 0); PG8_SCHED; PG8_LDA(At, 1, 0); PG8_STAGE(PG8_SA(0, 1), a2 + hstepA, voffA);
            PG8_WAIT_L(8); PG8_BAR; PG8_WAIT_L(0); PG8_MMA(0, 0, At, B0); PG8_BAR; PG8_SCHED;
            PG8_LDB(B1, 1, 1); PG8_STAGE(PG8_SB(1, 0), b3, voffB);
            PG8_BAR; PG8_WAIT_L(0); PG8_MMA(0, 1, At, B1); PG8_BAR;
            PG8_LDA(At, 1, 1); PG8_STAGE(PG8_SA(1, 0), a3, voffA);
            PG8_BAR; PG8_WAIT_L(0); PG8_MMA(1, 0, At, B0); PG8_BAR; PG8_SCHED;
            PG8_STAGE(PG8_SB(1, 1), b3 + hstep, voffB);
            PG8_WAIT_V(6); PG8_BAR; PG8_MMA(1, 1, At, B1); PG8_BAR;
        }
        PG8_STAMP();
        if constexpr (!Epi::AFTER_DRAIN) { E(acc, cur, wr, wc, fr, fq); S.done(cur); }
        PG8_STAMP();
        if (!has_next) break;
#pragma unroll
        for (int a = 0; a < 2; ++a)
#pragma unroll
            for (int b = 0; b < 2; ++b)
#pragma unroll
                for (int m = 0; m < 4; ++m)
#pragma unroll
                    for (int n = 0; n < 2; ++n) acc[a][b][m][n] = (f32x4){0.f, 0.f, 0.f, 0.f};
        cur = nxt; cA = nA; cB = nB; ++ui;
    }
    PG8_WAIT_V(0);
    if (wr == 0) PG8_BAR;
    PG8_BAR;
    if constexpr (Epi::AFTER_DRAIN) { E.fused(acc, cur, wr, wc, fr, fq, lds, wid, lane); S.done(cur); }
    PG8_STAMP();
    if (STAMP && wid == 0) { stamps[lane] = lane < nts ? (((unsigned long long)(unsigned)ts_hi << 32) | (unsigned)ts_lo) : 0ull;
        if (lane == 62) stamps[62] = rt_entry; if (lane == 63) stamps[63] = (unsigned long long)wall_clock64(); }
#undef PG8_STAMP
#undef PG8_SA
#undef PG8_SB
#undef PG8_STAGE
#undef PG8_LDA
#undef PG8_LDB
#undef PG8_MMA
#undef PG8_WAIT_V
#undef PG8_WAIT_L
#undef PG8_BAR
#undef PG8_SCHED
}
}
using pg8::bf16_t; using pg8::bf16x8; using pg8::f32x4; using pg8::u32x4;
#define LAS __attribute__((address_space(3)))
typedef short s16x4 __attribute__((ext_vector_type(4)));
typedef float f32x16 __attribute__((ext_vector_type(16)));
typedef unsigned u32x2 __attribute__((ext_vector_type(2)));
typedef LAS unsigned char* ldsp;

constexpr int MT = 32768, DM = 1024, SEQ = 8192, DFF = 2816, NTHR = 512;
constexpr int LDS_BYTES = 155648;
constexpr float ALPHA = 1.6817928305074290f;
constexpr float LN_EPS = 1e-5f, RMS_EPS = 1e-6f;
constexpr size_t WL_F1IN = 0, WL_F1OUT = 11534336, WL_F2IN = 17301504, WL_F2OUT = 28835840, WL_MIX = 34603008, WL_SIZE = 49807360;
constexpr size_t WM_AIN = 0, WM_UK = 4194304, WM_UV = 4718592, WM_AOUT = 5242880;
constexpr size_t WM_SIN = 0, WM_SOUT = 11010048;
constexpr size_t WS_WL = 4096, WS_XB = WS_WL + WL_SIZE, WS_TMP = WS_XB + 67108864;
constexpr size_t T_H = 0;
constexpr size_t T_KW = 251658240;
constexpr size_t T_QB = 0, T_CKV = 117440512, T_CKVN = 150994944, T_IDX = 167772160, T_O = 184549376;
constexpr size_t T_ZX = 0, T_DT = 335544320, T_SSQ = 339738624;
constexpr size_t WS_END = WS_TMP + 348127232;
constexpr size_t WS_BCC = WS_END + 65536;
constexpr int QBLD = 1792, ZXLD = 5120;

struct Params {
    const float* in[20]; float* out; unsigned char* ws;
};

__device__ __forceinline__ int obx() { int b = blockIdx.x; asm volatile("" : "+s"(b)); return b; }
__device__ __forceinline__ int ogd() { int b = gridDim.x; asm volatile("" : "+s"(b)); return b; }
#define AS4 __attribute__((address_space(4)))
__device__ __forceinline__ Params load_params() {
    Params q; const AS4 unsigned long long* kp = (const AS4 unsigned long long*)__builtin_amdgcn_kernarg_segment_ptr(); asm volatile("" : "+s"(kp));
#pragma unroll
    for (int i = 0; i < 20; ++i) q.in[i] = (const float*)(const __attribute__((address_space(1))) float*)kp[i];
    q.out = (float*)(__attribute__((address_space(1))) float*)kp[20]; q.ws = (unsigned char*)(__attribute__((address_space(1))) unsigned char*)kp[21]; return q; }
__device__ __forceinline__ int otid() { int t = threadIdx.x; asm volatile("" : "+v"(t)); return t; }
__device__ __forceinline__ float bf2f(unsigned v) { return __uint_as_float(v << 16); }
__device__ __forceinline__ float bflo(unsigned v) { return __uint_as_float(v << 16); }
__device__ __forceinline__ float bfhi(unsigned v) { return __uint_as_float(v & 0xFFFF0000u); }
__device__ __forceinline__ unsigned pk2(float a, float b) { return pg8::cvt_pk_bf16(a, b); }
__device__ __forceinline__ float wave_sum(float v) {
#pragma unroll
    for (int d = 32; d >= 1; d >>= 1) v += __shfl_xor(v, d);
    return v;
}
__device__ __forceinline__ f32x4 mfma16(bf16x8 a, bf16x8 b, f32x4 c) { return __builtin_amdgcn_mfma_f32_16x16x32_bf16(a, b, c, 0, 0, 0); }
__device__ __forceinline__ bf16x8 ld_lds128(ldsp p) { return *(LAS const bf16x8*)p; }

__device__ __forceinline__ int map_col(int kind, int j, int nsrc) {
    if (kind == 0) return j < nsrc ? j : -1;
    if (kind == 1) { const int pn = j >> 8, bj = (j >> 7) & 1, i = j & 127; return bj * DFF + pn * 128 + i; }
    if (j < 1024) return j;
    if (j < 1536) return j - 1024 + 1280;
    if (j < 1600) return j - 1536 + 1792;
    if (j < 1608) return j - 1600 + 1856;
    if (j < 1792) return -1;
    return j - 1792 + 1024;
}
__device__ __forceinline__ void conv_job(ldsp lds, const float* src0, bf16_t* dst0, int K, int nsrc, int ndst, int kind, const float* kscale, int nb = 1) {
    LAS float* tile = (LAS float*)lds;
    const int tid = otid(), ntk = K >> 6, ntm = (ndst >> 6) * ntk, ntiles = ntm * nb, G = ogd();
    for (int t0 = obx(); t0 < ntiles; t0 += 4 * G) {
        float v[4][8];
#pragma unroll
        for (int s = 0; s < 4; ++s) { const int t = t0 + s * G; const bool on = t < ntiles; const int tt = on ? t : t0; const int mb = tt / ntm, tm = tt - mb * ntm; const int j0 = (tm / ntk) << 6, k0 = (tm % ntk) << 6; const float* src = src0 + (size_t)mb * K * nsrc;
#pragma unroll
            for (int e = 0; e < 8; ++e) { const int idx = tid + e * NTHR, kk = idx >> 6, jj = idx & 63; const int c = map_col(kind, j0 + jj, nsrc);
                float x = (on && c >= 0) ? src[(size_t)(k0 + kk) * nsrc + c] : 0.f; if (kscale) x *= kscale[k0 + kk]; v[s][e] = x; } }
#pragma unroll
        for (int s = 0; s < 4; ++s)
#pragma unroll
            for (int e = 0; e < 8; ++e) { const int idx = tid + e * NTHR, kk = idx >> 6, jj = idx & 63; tile[s * 4160 + kk * 65 + jj] = v[s][e]; }
        __syncthreads();
#pragma unroll
        for (int s = 0; s < 4; ++s) { const int t = t0 + s * G;
            if (t < ntiles) { const int mb = t / ntm, tm = t - mb * ntm; const int j0 = (tm / ntk) << 6, k0 = (tm % ntk) << 6; bf16_t* dst = dst0 + (size_t)mb * ndst * K; const int jj = tid >> 3, kc = tid & 7; LAS const float* tl = tile + s * 4160; u32x4 w;
                w.x = pk2(tl[(kc * 8 + 0) * 65 + jj], tl[(kc * 8 + 1) * 65 + jj]); w.y = pk2(tl[(kc * 8 + 2) * 65 + jj], tl[(kc * 8 + 3) * 65 + jj]);
                w.z = pk2(tl[(kc * 8 + 4) * 65 + jj], tl[(kc * 8 + 5) * 65 + jj]); w.w = pk2(tl[(kc * 8 + 6) * 65 + jj], tl[(kc * 8 + 7) * 65 + jj]);
                *(u32x4*)(dst + (size_t)(j0 + jj) * K + k0 + kc * 8) = w; } }
        __syncthreads();
    }
}
__device__ __forceinline__ void convert_layer(ldsp lds, const Params& p, int L) {
    unsigned char* wl = p.ws + WS_WL;
    conv_job(lds, p.in[3] + (size_t)L * 1024 * 5632, (bf16_t*)(wl + WL_F1IN), 1024, 5632, 5632, 1, nullptr);
    conv_job(lds, p.in[4] + (size_t)L * 2816 * 1024, (bf16_t*)(wl + WL_F1OUT), 2816, 1024, 1024, 0, nullptr);
    conv_job(lds, p.in[5] + (size_t)L * 1024 * 5632, (bf16_t*)(wl + WL_F2IN), 1024, 5632, 5632, 1, nullptr);
    conv_job(lds, p.in[6] + (size_t)L * 2816 * 1024, (bf16_t*)(wl + WL_F2OUT), 2816, 1024, 1024, 0, nullptr);
    const int j = L >> 1;
    if ((L & 1) == 0) {
        conv_job(lds, p.in[7] + (size_t)j * 1024 * 1864, (bf16_t*)(wl + WL_MIX + WM_AIN), 1024, 1864, 2048, 2, nullptr);
        conv_job(lds, p.in[9] + (size_t)j * 16 * 64 * 256, (bf16_t*)(wl + WL_MIX + WM_UK), 64, 256, 256, 0, nullptr, 16);
        conv_job(lds, p.in[10] + (size_t)j * 16 * 256 * 64, (bf16_t*)(wl + WL_MIX + WM_UV), 256, 64, 64, 0, nullptr, 16);
        conv_job(lds, p.in[11] + (size_t)j * 1024 * 1024, (bf16_t*)(wl + WL_MIX + WM_AOUT), 1024, 1024, 1024, 0, nullptr);
    } else {
        conv_job(lds, p.in[12] + (size_t)j * 1024 * 5152, (bf16_t*)(wl + WL_MIX + WM_SIN), 1024, 5152, 5376, 0, nullptr);
        conv_job(lds, p.in[19] + (size_t)j * 2048 * 1024, (bf16_t*)(wl + WL_MIX + WM_SOUT), 2048, 1024, 1024, 0, p.in[18] + (size_t)j * 2048);
    }
}

template <bool DRY>
__device__ __forceinline__ void ln_phase(float* x, bf16_t* xb, const float* g, const float* b, unsigned char* dummy, bool write_f32) {
    const int tid_ = otid(); const int lane = tid_ & 63, gw = obx() * 8 + (tid_ >> 6), nw = ogd() * 8;
    for (int row0 = gw; row0 < MT; row0 += 4 * nw) {
        f32x4 v[4][4]; float s[4];
#pragma unroll
        for (int r = 0; r < 4; ++r) { const int row = row0 + r * nw; const bf16_t* xr = xb + (size_t)(row < MT ? row : row0) * DM; s[r] = 0.f;
#pragma unroll
            for (int i = 0; i < 4; ++i) { const u32x2 w = *(const u32x2*)(xr + i * 256 + lane * 4); v[r][i][0] = bflo(w.x); v[r][i][1] = bfhi(w.x); v[r][i][2] = bflo(w.y); v[r][i][3] = bfhi(w.y); } }
#pragma unroll
        for (int r = 0; r < 4; ++r) {
#pragma unroll
            for (int i = 0; i < 4; ++i) s[r] += v[r][i][0] + v[r][i][1] + v[r][i][2] + v[r][i][3];
            s[r] = wave_sum(s[r]) * (1.0f / DM); }
        float q[4];
#pragma unroll
        for (int r = 0; r < 4; ++r) { q[r] = 0.f;
#pragma unroll
            for (int i = 0; i < 4; ++i) { v[r][i] = v[r][i] - s[r]; q[r] += v[r][i][0] * v[r][i][0] + v[r][i][1] * v[r][i][1] + v[r][i][2] * v[r][i][2] + v[r][i][3] * v[r][i][3]; }
            q[r] = rsqrtf(wave_sum(q[r]) * (1.0f / DM) + LN_EPS); }
#pragma unroll
        for (int i = 0; i < 4; ++i) { const int c = i * 256 + lane * 4; const f32x4 gg = *(const f32x4*)(g + c), bb = *(const f32x4*)(b + c);
#pragma unroll
            for (int r = 0; r < 4; ++r) { const int row = row0 + r * nw;
                if (row < MT) { const f32x4 o = v[r][i] * q[r] * gg + bb; u32x2 w; w.x = pk2(o[0], o[1]); w.y = pk2(o[2], o[3]);
                    if (write_f32) *(f32x4*)(x + (size_t)row * DM + c) = o;
                    *(u32x2*)(xb + (size_t)row * DM + c) = w; } } }
    }
}
__device__ __forceinline__ void cvt_x_phase(const float* x, bf16_t* xb) {
    const size_t n8 = (size_t)MT * DM / 8, stride = (size_t)ogd() * NTHR;
    for (size_t i0 = (size_t)obx() * NTHR + otid(); i0 < n8; i0 += 4 * stride) {
        f32x4 a[4], b[4];
#pragma unroll
        for (int s = 0; s < 4; ++s) { const size_t i = i0 + s * stride; const size_t ii = i < n8 ? i : i0; a[s] = *(const f32x4*)(x + ii * 8); b[s] = *(const f32x4*)(x + ii * 8 + 4); }
#pragma unroll
        for (int s = 0; s < 4; ++s) { const size_t i = i0 + s * stride;
            if (i < n8) { u32x4 w; w.x = pk2(a[s][0], a[s][1]); w.y = pk2(a[s][2], a[s][3]); w.z = pk2(b[s][0], b[s][1]); w.w = pk2(b[s][2], b[s][3]); *(u32x4*)(xb + i * 8) = w; } }
    }
}

__device__ __forceinline__ void ckv_norm_phase(const float* ckv, bf16_t* ckvn, const float* g) {
    const int tid_ = otid(); const int lane = tid_ & 63, gw = obx() * 8 + (tid_ >> 6), nw = ogd() * 8;
    const f32x4 gg = *(const f32x4*)(g + lane * 4);
    for (int row0 = gw; row0 < MT; row0 += 4 * nw) {
        f32x4 v[4];
#pragma unroll
        for (int r = 0; r < 4; ++r) { const int row = row0 + r * nw; v[r] = *(const f32x4*)(ckv + (size_t)(row < MT ? row : row0) * 256 + lane * 4); }
#pragma unroll
        for (int r = 0; r < 4; ++r) { const int row = row0 + r * nw;
            const float ms = wave_sum(v[r][0] * v[r][0] + v[r][1] * v[r][1] + v[r][2] * v[r][2] + v[r][3] * v[r][3]) * (1.0f / 256.0f);
            const float rs = rsqrtf(ms + RMS_EPS); const f32x4 o = v[r] * rs * gg; u32x2 w; w.x = pk2(o[0], o[1]); w.y = pk2(o[2], o[3]);
            if (row < MT) *(u32x2*)(ckvn + (size_t)row * 256 + lane * 4) = w; }
    }
}

__device__ __forceinline__ unsigned f2key(float s) { const unsigned u = __float_as_uint(s); return (u & 0x80000000u) ? ~u : (u | 0x80000000u); }
__device__ __forceinline__ void find_bin(ldsp hq, unsigned need, unsigned& bin, unsigned& newneed) {
    const int lane = otid() & 63;
    u32x4 w[4];
#pragma unroll
    for (int i = 0; i < 4; ++i) w[i] = *(LAS const u32x4*)(hq + lane * 64 + i * 16);
    unsigned sum = 0;
#pragma unroll
    for (int i = 0; i < 4; ++i)
#pragma unroll
        for (int k = 0; k < 4; ++k) sum += (w[i][k] & 0xFFFFu) + (w[i][k] >> 16);
    unsigned suf = sum;
#pragma unroll
    for (int d = 1; d < 64; d <<= 1) { const unsigned t = __shfl_down(suf, d); if (lane + d < 64) suf += t; }
    const unsigned above = suf - sum;
    const bool mine = (above < need) && (need <= suf);
    unsigned cum = above, fb = 0, fn = 0; bool found = false;
#pragma unroll
    for (int i = 3; i >= 0; --i)
#pragma unroll
        for (int k = 3; k >= 0; --k) {
            const unsigned hi16 = w[i][k] >> 16, lo16 = w[i][k] & 0xFFFFu; const int wi = i * 4 + k;
            if (!found && cum + hi16 >= need) { fb = lane * 32 + wi * 2 + 1; fn = need - cum; found = true; } cum += hi16;
            if (!found && cum + lo16 >= need) { fb = lane * 32 + wi * 2; fn = need - cum; found = true; } cum += lo16; }
    const unsigned long long bal = __ballot(mine);
    const int src = bal ? (int)__builtin_ctzll(bal) : 0;
    bin = __shfl(fb, src); newneed = __shfl(fn, src);
}

__device__ __forceinline__ void indexer_item(ldsp lds, const bf16_t* QB, unsigned short* IDX, int b, int qt) {
    const int tid = otid(), lane = tid & 63, wid = tid >> 6, c = lane & 31, hi = lane >> 5;
    const int q0 = qt * 32; const size_t tb = (size_t)b * SEQ;
    const int posb = q0 + 4 * wid + 2 * hi;
#ifdef IDX_SIMPLE
    if (true) {
#else
    if (q0 < 256) {
#endif
        for (int tq = 0; tq < 4; ++tq) { const int pos = q0 + 4 * wid + tq; unsigned short* o = IDX + (tb + pos) * 256;
#pragma unroll
            for (int k = 0; k < 4; ++k) { const int j = lane * 4 + k; o[j] = (unsigned short)(j <= pos ? j : 0xFFFF); } }
        return;
    }
    ldsp hist = lds + wid * 16384;
    ldsp kbuf = lds + 131072;
    bf16x8 af[4];
    { const int r = c, tk = ((r >> 2) & 1) * 2 + (r & 1), hd = (r >> 3) * 2 + ((r >> 1) & 1);
      const bf16_t* qp = QB + (tb + q0 + 4 * wid + tk) * QBLD + 1024 + hd * 64 + hi * 8;
#pragma unroll
      for (int ks = 0; ks < 4; ++ks) af[ks] = *(const bf16x8*)(qp + ks * 16); }
    float wq[2][8];
#pragma unroll
    for (int e = 0; e < 2; ++e) { const u32x4 wv = *(const u32x4*)(QB + T_KW / 2 + (tb + posb + e) * 128 + 64);
#pragma unroll
        for (int k = 0; k < 4; ++k) { wq[e][2 * k] = bflo(wv[k]) * 0.04419417382415922f; wq[e][2 * k + 1] = bfhi(wv[k]) * 0.04419417382415922f; } }
    const int nch = (q0 + 32 + 63) >> 6;
    const bf16_t* KW = QB + T_KW / 2;
    const bf16_t* kg = KW + (tb + (tid >> 3)) * 128 + (tid & 7) * 8;
    const int kst = (tid >> 3) * 144 + (tid & 7) * 16;
    unsigned pre[2] = {0u, 0u}, need[2] = {256u, 256u};
    unsigned cnt[2] = {0u, 0u}, tie[2] = {0u, 0u};
    for (int pass = 0; pass < 4; ++pass) {
        if (pass < 3) {
#pragma unroll
            for (int i = 0; i < 16; ++i) *(LAS u32x4*)(hist + i * 1024 + lane * 16) = (u32x4){0u, 0u, 0u, 0u};
        }
        __syncthreads();
        u32x4 kr = *(const u32x4*)kg;
        *(LAS u32x4*)(kbuf + kst) = kr;
        __syncthreads();
        for (int ch = 0; ch < nch; ++ch) {
            if (ch + 1 < nch) kr = *(const u32x4*)(kg + (size_t)(ch + 1) * 64 * 128);
            ldsp kb = kbuf + (ch & 1) * 9216;
#pragma unroll
            for (int ts = 0; ts < 2; ++ts) {
                f32x16 acc;
#pragma unroll
                for (int i = 0; i < 16; ++i) acc[i] = 0.f;
#pragma unroll
                for (int ks = 0; ks < 4; ++ks) { const bf16x8 bf = ld_lds128(kb + (ts * 32 + c) * 144 + ks * 32 + hi * 16); acc = __builtin_amdgcn_mfma_f32_32x32x16_bf16(af[ks], bf, acc, 0, 0, 0); }
                const int key = ch * 64 + ts * 32 + c;
#pragma unroll
                for (int e = 0; e < 2; ++e) {
                    float s = 0.f;
#pragma unroll
                    for (int h = 0; h < 8; ++h) s = fmaf(wq[e][h], fmaxf(acc[2 * h + e], 0.f), s);
                    s += 0.0f;
                    const unsigned u = f2key(s); const bool valid = key <= posb + e;
                    if (pass == 0) { if (valid) { const unsigned bin = u >> 21; __hip_atomic_fetch_add((LAS unsigned*)(hist + (2 * hi + e) * 4096 + (bin >> 1) * 4), 1u << ((bin & 1) * 16), __ATOMIC_RELAXED, __HIP_MEMORY_SCOPE_WORKGROUP); } }
                    else if (pass == 1) { if (valid && (u >> 21) == pre[e]) { const unsigned bin = (u >> 10) & 0x7FFu; __hip_atomic_fetch_add((LAS unsigned*)(hist + (2 * hi + e) * 4096 + (bin >> 1) * 4), 1u << ((bin & 1) * 16), __ATOMIC_RELAXED, __HIP_MEMORY_SCOPE_WORKGROUP); } }
                    else if (pass == 2) { if (valid && (u >> 10) == pre[e]) { const unsigned bin = u & 0x3FFu; __hip_atomic_fetch_add((LAS unsigned*)(hist + (2 * hi + e) * 4096 + (bin >> 1) * 4), 1u << ((bin & 1) * 16), __ATOMIC_RELAXED, __HIP_MEMORY_SCOPE_WORKGROUP); } }
                    else {
                        const bool gt = valid && (u > pre[e]), eq = valid && (u == pre[e]);
                        const unsigned long long beq = __ballot(eq); const unsigned meq = hi ? (unsigned)(beq >> 32) : (unsigned)beq;
                        const unsigned below = (1u << c) - 1u;
                        const bool emit = gt || (eq && (tie[e] + __popc(meq & below) < need[e]));
                        tie[e] += __popc(meq);
                        const unsigned long long bem = __ballot(emit); const unsigned mem = hi ? (unsigned)(bem >> 32) : (unsigned)bem;
                        const unsigned slot = cnt[e] + __popc(mem & below);
                        if (emit && slot < 256u) IDX[(tb + posb + e) * 256 + slot] = (unsigned short)key;
                        cnt[e] += __popc(mem);
                    }
                }
            }
            if (ch + 1 < nch) *(LAS u32x4*)(kbuf + ((ch + 1) & 1) * 9216 + kst) = kr;
            __syncthreads();
        }
        if (pass < 3) {
            unsigned nb[4], nn[4];
#pragma unroll
            for (int tq = 0; tq < 4; ++tq) {
                const unsigned nd = __shfl(need[tq & 1], (tq >> 1) * 32);
                find_bin(hist + tq * 4096, nd, nb[tq], nn[tq]); }
#pragma unroll
            for (int e = 0; e < 2; ++e) { const unsigned bsel = hi ? nb[2 + e] : nb[e], nsel = hi ? nn[2 + e] : nn[e];
                pre[e] = (pass == 0) ? bsel : (pass == 1 ? ((pre[e] << 11) | bsel) : ((pre[e] << 10) | bsel)); need[e] = nsel; }
        }
    }
}
__device__ __forceinline__ void find_bin1k(ldsp hq, unsigned need, unsigned& bin, unsigned& newneed) {
    const int lane = otid() & 63;
    u32x4 w[2];
#pragma unroll
    for (int i = 0; i < 2; ++i) w[i] = *(LAS const u32x4*)(hq + lane * 32 + i * 16);
    unsigned sum = 0;
#pragma unroll
    for (int i = 0; i < 2; ++i)
#pragma unroll
        for (int k = 0; k < 4; ++k) sum += (w[i][k] & 0xFFFFu) + (w[i][k] >> 16);
    unsigned suf = sum;
#pragma unroll
    for (int d = 1; d < 64; d <<= 1) { const unsigned t = __shfl_down(suf, d); if (lane + d < 64) suf += t; }
    const unsigned above = suf - sum;
    const bool mine = (above < need) && (need <= suf);
    unsigned cum = above, fb = 0, fn = 0; bool found = false;
#pragma unroll
    for (int i = 1; i >= 0; --i)
#pragma unroll
        for (int k = 3; k >= 0; --k) {
            const unsigned hi16 = w[i][k] >> 16, lo16 = w[i][k] & 0xFFFFu; const int wi = i * 4 + k;
            if (!found && cum + hi16 >= need) { fb = lane * 16 + wi * 2 + 1; fn = need - cum; found = true; } cum += hi16;
            if (!found && cum + lo16 >= need) { fb = lane * 16 + wi * 2; fn = need - cum; found = true; } cum += lo16; }
    const unsigned long long bal = __ballot(mine);
    const int src = bal ? (int)__builtin_ctzll(bal) : 0;
    bin = __shfl(fb, src); newneed = __shfl(fn, src);
}
struct IdxState { bf16x8 af[4]; float wq[2][8], bsc[2], bof[2]; unsigned tbin[2], cnt[2], ccnt[2]; };
template <int PASS>
__device__ __forceinline__ void idx_update(float sv, unsigned bin, int e, int key, IdxState& st, ldsp hist, ldsp cand, ldsp ctrs, unsigned short* IDX, size_t tb, int posb, int hi) {
    const bool valid = key <= posb + e;
    if (PASS == 2) { if (valid && sv == 123456.789f) IDX[(tb + posb + e) * 256] = (unsigned short)bin; }
    else if (PASS == 0) { __hip_atomic_fetch_add((LAS unsigned*)(hist + (2 * hi + e) * 2048 + (bin >> 1) * 4), valid ? (1u << ((bin & 1) * 16)) : 0u, __ATOMIC_RELAXED, __HIP_MEMORY_SCOPE_WORKGROUP); }
    else if (valid && bin >= st.tbin[e]) {
        LAS unsigned* ctr = (LAS unsigned*)(ctrs + (2 * hi + e) * 8);
        if (bin > st.tbin[e]) { const unsigned slot = __hip_atomic_fetch_add(ctr, 1u, __ATOMIC_RELAXED, __HIP_MEMORY_SCOPE_WORKGROUP);
            if (slot < 256u) IDX[(tb + posb + e) * 256 + slot] = (unsigned short)key; }
        else { const unsigned cp = __hip_atomic_fetch_add(ctr + 1, 1u, __ATOMIC_RELAXED, __HIP_MEMORY_SCOPE_WORKGROUP);
            if (cp < 256u) { u32x2 cv; cv.x = f2key(sv); cv.y = (unsigned)key; *(LAS u32x2*)(cand + ((2 * hi + e) * 256 + cp) * 8) = cv; } }
    }
}
__device__ __forceinline__ void idx_mfma(ldsp kb, const IdxState& st, f32x16 (&acc)[4]) {
#pragma unroll
    for (int tl = 0; tl < 4; ++tl)
#pragma unroll
        for (int i = 0; i < 16; ++i) acc[tl][i] = 0.f;
#pragma unroll
    for (int tp = 0; tp < 2; ++tp) { bf16x8 b0[4], b1[4];
#pragma unroll
        for (int ks = 0; ks < 4; ++ks) { b0[ks] = ld_lds128(kb + (2 * tp) * 32 * 144 + ks * 32); b1[ks] = ld_lds128(kb + (2 * tp + 1) * 32 * 144 + ks * 32); }
#pragma unroll
        for (int ks = 0; ks < 4; ++ks) { acc[2 * tp] = __builtin_amdgcn_mfma_f32_32x32x16_bf16(st.af[ks], b0[ks], acc[2 * tp], 0, 0, 0); acc[2 * tp + 1] = __builtin_amdgcn_mfma_f32_32x32x16_bf16(st.af[ks], b1[ks], acc[2 * tp + 1], 0, 0, 0); } }
}
template <int PASS>
__device__ __forceinline__ void idx_pass(ldsp lds, IdxState& st, const bf16_t* kg, unsigned short* IDX, size_t tb, int q0, int posb, int wid, int c, int hi, int kst, int nch) {
    ldsp hist = lds + wid * 8192; ldsp cand = hist; ldsp ctrs = lds + 65536 + wid * 32; ldsp kbuf = lds + 81920; const int lo = c * 144 + hi * 16;
    __syncthreads();
    u32x4 kr0 = *(const u32x4*)kg, kr1 = *(const u32x4*)(kg + (size_t)64 * 128);
    *(LAS u32x4*)(kbuf + kst) = kr0; *(LAS u32x4*)(kbuf + 9216 + kst) = kr1;
    if (1 < nch) { kr0 = *(const u32x4*)(kg + (size_t)128 * 128); kr1 = *(const u32x4*)(kg + (size_t)(128 + 64) * 128); *(LAS u32x4*)(kbuf + 18432 + kst) = kr0; *(LAS u32x4*)(kbuf + 18432 + 9216 + kst) = kr1; }
    u32x4 kn0 = kr0, kn1 = kr1;
    if (2 < nch) { kr0 = *(const u32x4*)(kg + (size_t)256 * 128); kr1 = *(const u32x4*)(kg + (size_t)(256 + 64) * 128); }
    if (3 < nch) { kn0 = *(const u32x4*)(kg + (size_t)384 * 128); kn1 = *(const u32x4*)(kg + (size_t)(384 + 64) * 128); }
    __syncthreads();
    f32x16 accA[4], accB[4];
    idx_mfma(kbuf + lo, st, accA);
    int bcur = 0;
#define IDX_STEP(CH, CUR, NXT) do { const int ch_ = (CH); const int bn = bcur == 2 ? 0 : bcur + 1, bw = bn == 2 ? 0 : bn + 1; \
        ldsp kb_ = kbuf + bn * 18432 + lo; float sv_[4][2]; unsigned bin_[4][2]; \
          \
        _Pragma("unroll") for (int tl = 0; tl < 4; ++tl) _Pragma("unroll") for (int i = 0; i < 16; ++i) NXT[tl][i] = 0.f; \
        _Pragma("unroll") for (int ks = 0; ks < 4; ++ks) { \
            bf16x8 f0 = ld_lds128(kb_ + ks * 32), f1 = ld_lds128(kb_ + 4608 + ks * 32), f2 = ld_lds128(kb_ + 9216 + ks * 32), f3 = ld_lds128(kb_ + 13824 + ks * 32); \
            NXT[0] = __builtin_amdgcn_mfma_f32_32x32x16_bf16(st.af[ks], f0, NXT[0], 0, 0, 0); NXT[1] = __builtin_amdgcn_mfma_f32_32x32x16_bf16(st.af[ks], f1, NXT[1], 0, 0, 0); \
            NXT[2] = __builtin_amdgcn_mfma_f32_32x32x16_bf16(st.af[ks], f2, NXT[2], 0, 0, 0); NXT[3] = __builtin_amdgcn_mfma_f32_32x32x16_bf16(st.af[ks], f3, NXT[3], 0, 0, 0); \
            { const int tl = ks;                                     \
              _Pragma("unroll") for (int e = 0; e < 2; ++e) { float s = 0.f; \
                  _Pragma("unroll") for (int h = 0; h < 8; ++h) s = fmaf(st.wq[e][h], __builtin_amdgcn_fmed3f(CUR[tl][2 * h + e], 0.f, 3.0e38f), s); \
                  sv_[tl][e] = s + 0.0f; bin_[tl][e] = (unsigned)__builtin_amdgcn_fmed3f(fmaf(sv_[tl][e], st.bsc[e], st.bof[e]), 0.f, 1023.f); } } } \
        _Pragma("unroll") for (int i = 0; i < 16; ++i) { __builtin_amdgcn_sched_group_barrier(0x008, 1, 0); __builtin_amdgcn_sched_group_barrier(0x002, 9, 0); } \
          \
        _Pragma("unroll") for (int tl = 0; tl < 4; ++tl) { \
            _Pragma("unroll") for (int e = 0; e < 2; ++e) idx_update<PASS>(sv_[tl][e], bin_[tl][e], e, ch_ * 128 + tl * 32 + c, st, hist, cand, ctrs, IDX, tb, posb, hi); } \
        if (ch_ + 2 < nch) { *(LAS u32x4*)(kbuf + bw * 18432 + kst) = kr0; *(LAS u32x4*)(kbuf + bw * 18432 + 9216 + kst) = kr1; } \
        kr0 = kn0; kr1 = kn1; \
        if (ch_ + 4 < nch) { kn0 = *(const u32x4*)(kg + (size_t)(ch_ + 4) * 128 * 128); kn1 = *(const u32x4*)(kg + (size_t)((ch_ + 4) * 128 + 64) * 128); } \
        bcur = bn; __syncthreads(); } while (0)
#pragma unroll 1
    for (int ch = 0; ch < nch; ch += 2) {
        IDX_STEP(ch, accA, accB);
        if (ch + 1 < nch) IDX_STEP(ch + 1, accB, accA);
    }
#undef IDX_STEP
}
__device__ __forceinline__ int indexer_item_fast(ldsp lds, const bf16_t* QB, unsigned short* IDX, int b, int qt) {
    const int tid = otid(), lane = tid & 63, wid = tid >> 6, c = lane & 31, hi = lane >> 5;
    const int q0 = qt * 32; const size_t tb = (size_t)b * SEQ;
    const int posb = q0 + 4 * wid + 2 * hi;
    ldsp hist = lds + wid * 8192;
    ldsp cand = hist;
    ldsp ctrs = lds + 65536 + wid * 32;
    IdxState st;
    { const int r = c, tk = ((r >> 2) & 1) * 2 + (r & 1), hd = (r >> 3) * 2 + ((r >> 1) & 1);
      const bf16_t* qp = QB + (tb + q0 + 4 * wid + tk) * QBLD + 1024 + hd * 64 + hi * 8;
#pragma unroll
      for (int ks = 0; ks < 4; ++ks) st.af[ks] = *(const bf16x8*)(qp + ks * 16); }
#pragma unroll
    for (int e = 0; e < 2; ++e) { const u32x4 wv = *(const u32x4*)(QB + T_KW / 2 + (tb + posb + e) * 128 + 64); float sw = 0.f, sw2 = 0.f;
#pragma unroll
        for (int k = 0; k < 4; ++k) { st.wq[e][2 * k] = bflo(wv[k]) * 0.04419417382415922f; st.wq[e][2 * k + 1] = bfhi(wv[k]) * 0.04419417382415922f; }
#pragma unroll
        for (int h = 0; h < 8; ++h) { sw += st.wq[e][h]; sw2 += st.wq[e][h] * st.wq[e][h]; }
        const float mu = sw * 3.1915382f, sg = sqrtf(sw2 * 21.81f) + 1e-20f;
        st.bsc[e] = 128.0f / sg; st.bof[e] = 256.0f - mu * st.bsc[e];
        st.tbin[e] = 0u; st.cnt[e] = 0u; st.ccnt[e] = 0u; }
    const int nch = (q0 + 32 + 127) >> 7;
    const bf16_t* kg = QB + T_KW / 2 + (tb + (tid >> 3)) * 128 + (tid & 7) * 8;
    const int kst = (tid >> 3) * 144 + (tid & 7) * 16;
#pragma unroll
    for (int i = 0; i < 8; ++i) *(LAS u32x4*)(hist + i * 1024 + lane * 16) = (u32x4){0u, 0u, 0u, 0u};
#ifdef DUMMY_PASS
    idx_pass<2>(lds, st, kg, IDX, tb, q0, posb, wid, c, hi, kst, nch);
#endif
    idx_pass<0>(lds, st, kg, IDX, tb, q0, posb, wid, c, hi, kst, nch);
    unsigned need[2];
    { unsigned nb[4], nn[4];
#pragma unroll
      for (int tq = 0; tq < 4; ++tq) find_bin1k(hist + tq * 2048, 256u, nb[tq], nn[tq]);
#pragma unroll
      for (int e = 0; e < 2; ++e) { st.tbin[e] = hi ? nb[2 + e] : nb[e]; need[e] = hi ? nn[2 + e] : nn[e]; } }
    if (lane < 8) *(LAS unsigned*)(ctrs + lane * 4) = 0u;
    idx_pass<1>(lds, st, kg, IDX, tb, q0, posb, wid, c, hi, kst, nch);
    int ovf = 0;
#pragma unroll 1
    for (int tq = 0; tq < 4; ++tq) {
        const unsigned base = *(LAS const unsigned*)(ctrs + tq * 8), n = *(LAS const unsigned*)(ctrs + tq * 8 + 4);
        const unsigned nd = __shfl(need[tq & 1], (tq >> 1) * 32);
        if (n > 256u) { ovf = 1; }
        else {
#pragma unroll 1
            for (unsigned g0 = 0; g0 < n; g0 += 64) {
                const unsigned ci = g0 + lane;
                const u32x2 mine = ci < n ? *(LAS const u32x2*)(cand + (tq * 256 + ci) * 8) : (u32x2){0u, 0u};
                unsigned rank = 0;
                for (unsigned j = 0; j < n; ++j) { const u32x2 o = *(LAS const u32x2*)(cand + (tq * 256 + j) * 8); rank += (o.x > mine.x || (o.x == mine.x && o.y < mine.y)) ? 1u : 0u; }
                if (ci < n && rank < nd && base + rank < 256u) IDX[(tb + q0 + 4 * wid + tq) * 256 + base + rank] = (unsigned short)mine.y;
            }
        }
    }
    return __syncthreads_or(ovf);
}
__device__ __forceinline__ void indexer_phase(ldsp lds, const Params& p) {
    const bf16_t* QB = (const bf16_t*)(p.ws + WS_TMP + T_QB); unsigned short* IDX = (unsigned short*)(p.ws + WS_TMP + T_IDX);
    for (int s = obx(); s < 256; s += ogd()) {
        int b = s >> 6, j = s & 63;
        if (ogd() == 256) { b = (s & 7) >> 1; j = (s >> 3) * 2 + (s & 1); }
#pragma unroll 1
        for (int k = 0; k < 4; ++k) {
            const int qt = k == 0 ? 255 - j : (k == 1 ? 128 + j : (k == 2 ? 127 - j : j));
#ifndef IDX_SLOW
            if (qt * 32 >= 256) { if (indexer_item_fast(lds, QB, IDX, b, qt)) { indexer_item(lds, QB, IDX, b, qt); __syncthreads(); } }
            else
#endif
            { indexer_item(lds, QB, IDX, b, qt); __syncthreads(); }
        }
    }
}

__device__ __forceinline__ s16x4 tr_read(ldsp p) { typedef short v4i16_t __attribute__((ext_vector_type(4))); return __builtin_bit_cast(s16x4, __builtin_amdgcn_ds_read_tr16_b64_v4i16((LAS v4i16_t*)p)); }
constexpr int XS = 528, CS = 544;
__device__ __forceinline__ void sattn_step(ldsp lds, const Params& p, int b, int si) {
    const int tid = otid(), lane = tid & 63, wid = tid >> 6, fr = lane & 15, g = lane >> 4;
    const bf16_t* QB = (const bf16_t*)(p.ws + WS_TMP + T_QB); const bf16_t* CKVN = (const bf16_t*)(p.ws + WS_TMP + T_CKVN);
    const unsigned short* IDX = (const unsigned short*)(p.ws + WS_TMP + T_IDX); bf16_t* O = (bf16_t*)(p.ws + WS_TMP + T_O);
    const bf16_t* WUK = (const bf16_t*)(p.ws + WS_WL + WL_MIX + WM_UK); const bf16_t* WUV = (const bf16_t*)(p.ws + WS_WL + WL_MIX + WM_UV);
    const size_t tb = (size_t)b * SEQ; const int p0 = si * 16; const size_t t0 = tb + p0;
    ldsp X = lds; ldsp Cw = lds + wid * (32 * CS); ldsp IL = lds + 8 * 32 * CS + wid * 1024;
#pragma unroll 1
    for (int hh = 0; hh < 2; ++hh) { const int h = wid * 2 + hh;
        bf16x8 bq[2]; { const bf16_t* qp = QB + (t0 + fr) * QBLD + h * 64 + g * 8; bq[0] = *(const bf16x8*)qp; bq[1] = *(const bf16x8*)(qp + 32); }
#pragma unroll 16
        for (int rt = 0; rt < 16; ++rt) {
            const bf16_t* wp = WUK + ((size_t)(h * 256 + rt * 16 + fr)) * 64 + g * 8;
            f32x4 acc = {0.f, 0.f, 0.f, 0.f};
            acc = mfma16(*(const bf16x8*)wp, bq[0], acc); acc = mfma16(*(const bf16x8*)(wp + 32), bq[1], acc);
            u32x2 w; w.x = pk2(acc[0], acc[1]); w.y = pk2(acc[2], acc[3]); *(LAS u32x2*)(X + (fr * 16 + h) * XS + (rt * 16 + 4 * g) * 2) = w; } }
    { const u32x2 iv0 = *(const u32x2*)(IDX + (t0 + wid) * 256 + lane * 4), iv1 = *(const u32x2*)(IDX + (t0 + wid + 8) * 256 + lane * 4);
      *(LAS u32x2*)(IL + lane * 8) = iv0; *(LAS u32x2*)(IL + 512 + lane * 8) = iv1; }
    __syncthreads();
    bf16x8 qa[8], qb[8];
#pragma unroll
    for (int ks = 0; ks < 8; ++ks) { qa[ks] = ld_lds128(X + (wid * 16 + fr) * XS + ks * 64 + g * 16); qb[ks] = ld_lds128(X + ((wid + 8) * 16 + fr) * XS + ks * 64 + g * 16); }
    __syncthreads();
    u32x2 olat[2][16];
#pragma unroll 1
    for (int tk = 0; tk < 2; ++tk) {
        const int pos = p0 + wid + 8 * tk; ldsp ILt = IL + tk * 512;
        f32x4 o[16];
#pragma unroll
        for (int i = 0; i < 16; ++i) o[i] = (f32x4){0.f, 0.f, 0.f, 0.f};
        float mrun = -INFINITY, lsum = 0.f;
#pragma unroll 1
        for (int kt = 0; kt < 8; ++kt) {
#pragma unroll
            for (int hf = 0; hf < 2; ++hf) { u32x4 gv[8];
#pragma unroll
              for (int i = 0; i < 8; ++i) { const int row = (hf * 8 + i) * 2 + (lane >> 5); const int key = *(LAS const unsigned short*)(ILt + (kt * 32 + row) * 2);
                  const int kc = key <= pos ? key : 0; gv[i] = *(const u32x4*)(CKVN + (tb + kc) * 256 + (lane & 31) * 8); }
#pragma unroll
              for (int i = 0; i < 8; ++i) { const int row = (hf * 8 + i) * 2 + (lane >> 5); *(LAS u32x4*)(Cw + row * CS + (lane & 31) * 16) = gv[i]; }
              __builtin_amdgcn_sched_barrier(0); }
            f32x4 s0 = {0.f, 0.f, 0.f, 0.f}, s1 = {0.f, 0.f, 0.f, 0.f};
#pragma unroll
            for (int ks = 0; ks < 8; ++ks) { s0 = mfma16(ld_lds128(Cw + fr * CS + ks * 64 + g * 16), qa[ks], s0); s1 = mfma16(ld_lds128(Cw + (16 + fr) * CS + ks * 64 + g * 16), qa[ks], s1); }
            const u32x2 k0 = *(LAS const u32x2*)(ILt + (kt * 32 + 4 * g) * 2), k1 = *(LAS const u32x2*)(ILt + (kt * 32 + 16 + 4 * g) * 2);
            float sv[8];
            sv[0] = (int)(k0.x & 0xFFFFu) <= pos ? s0[0] * 0.125f : -INFINITY; sv[1] = (int)(k0.x >> 16) <= pos ? s0[1] * 0.125f : -INFINITY;
            sv[2] = (int)(k0.y & 0xFFFFu) <= pos ? s0[2] * 0.125f : -INFINITY; sv[3] = (int)(k0.y >> 16) <= pos ? s0[3] * 0.125f : -INFINITY;
            sv[4] = (int)(k1.x & 0xFFFFu) <= pos ? s1[0] * 0.125f : -INFINITY; sv[5] = (int)(k1.x >> 16) <= pos ? s1[1] * 0.125f : -INFINITY;
            sv[6] = (int)(k1.y & 0xFFFFu) <= pos ? s1[2] * 0.125f : -INFINITY; sv[7] = (int)(k1.y >> 16) <= pos ? s1[3] * 0.125f : -INFINITY;
            float tm = fmaxf(fmaxf(fmaxf(sv[0], sv[1]), fmaxf(sv[2], sv[3])), fmaxf(fmaxf(sv[4], sv[5]), fmaxf(sv[6], sv[7])));
            tm = fmaxf(tm, __shfl_xor(tm, 16)); tm = fmaxf(tm, __shfl_xor(tm, 32));
            const float mnew = fmaxf(mrun, tm); const float sc = __expf(mrun - mnew); mrun = mnew;
            float ps = 0.f;
#pragma unroll
            for (int i = 0; i < 8; ++i) { sv[i] = __expf(sv[i] - mnew); ps += sv[i]; }
            lsum = lsum * sc + ps;
#pragma unroll
            for (int i = 0; i < 16; ++i) o[i] = o[i] * sc;
            union { bf16x8 v; unsigned u[4]; } pb; pb.u[0] = pk2(sv[0], sv[1]); pb.u[1] = pk2(sv[2], sv[3]); pb.u[2] = pk2(sv[4], sv[5]); pb.u[3] = pk2(sv[6], sv[7]);
            ldsp tra = Cw + (4 * g + (fr >> 2)) * CS + (fr & 3) * 8;
#pragma unroll
            for (int rt = 0; rt < 16; ++rt) {
                const s16x4 lo = tr_read(tra + rt * 32), hi4 = tr_read(tra + 16 * CS + rt * 32);
                bf16x8 a; a[0] = lo[0]; a[1] = lo[1]; a[2] = lo[2]; a[3] = lo[3]; a[4] = hi4[0]; a[5] = hi4[1]; a[6] = hi4[2]; a[7] = hi4[3];
                o[rt] = mfma16(a, pb.v, o[rt]); if ((rt & 3) == 3) __builtin_amdgcn_sched_barrier(0); }
        }
        lsum += __shfl_xor(lsum, 16); lsum += __shfl_xor(lsum, 32);
        const float inv = 1.0f / lsum;
        if (tk == 0) {
#pragma unroll
            for (int rt = 0; rt < 16; ++rt) { olat[0][rt].x = pk2(o[rt][0] * inv, o[rt][1] * inv); olat[0][rt].y = pk2(o[rt][2] * inv, o[rt][3] * inv); }
#pragma unroll
            for (int ks = 0; ks < 8; ++ks) qa[ks] = qb[ks];
        } else {
#pragma unroll
            for (int rt = 0; rt < 16; ++rt) { olat[1][rt].x = pk2(o[rt][0] * inv, o[rt][1] * inv); olat[1][rt].y = pk2(o[rt][2] * inv, o[rt][3] * inv); }
        }
    }
    __syncthreads();
#pragma unroll
    for (int rt = 0; rt < 16; ++rt) { *(LAS u32x2*)(X + (wid * 16 + fr) * XS + (rt * 16 + 4 * g) * 2) = olat[0][rt]; *(LAS u32x2*)(X + ((wid + 8) * 16 + fr) * XS + (rt * 16 + 4 * g) * 2) = olat[1][rt]; }
    __syncthreads();
#pragma unroll 1
    for (int hh = 0; hh < 2; ++hh) { const int h = wid * 2 + hh;
        bf16x8 ao[8];
#pragma unroll
        for (int ks = 0; ks < 8; ++ks) ao[ks] = ld_lds128(X + (fr * 16 + h) * XS + ks * 64 + g * 16);
#pragma unroll 4
        for (int dt = 0; dt < 4; ++dt) {
            const bf16_t* wp = WUV + ((size_t)(h * 64 + dt * 16 + fr)) * 256 + g * 8;
            f32x4 acc = {0.f, 0.f, 0.f, 0.f};
#pragma unroll
            for (int ks = 0; ks < 8; ++ks) acc = mfma16(ao[ks], *(const bf16x8*)(wp + ks * 32), acc);
#pragma unroll
            for (int j = 0; j < 4; ++j) O[(t0 + 4 * g + j) * 1024 + h * 64 + dt * 16 + fr] = (bf16_t)(pk2(acc[j], 0.f) & 0xFFFFu); } }
    __syncthreads();
}
__device__ __forceinline__ void sattn_phase(ldsp lds, const Params& p) {
    const int G = ogd(), bx = obx();
    if ((G & 7) == 0) {
        const int b = (bx & 7) >> 1, wb = (bx >> 3) * 2 + (bx & 1), nwb = G >> 2;
        for (int si = wb; si < 512; si += nwb) sattn_step(lds, p, b, si);
    } else {
        for (int s = bx; s < 2048; s += G) sattn_step(lds, p, s >> 9, s & 511);
    }
}

constexpr int RS = 272;
__device__ __forceinline__ void conv8(const u32x4 (&raw)[7], const float* cw, const float* cb, int c0, float (&out)[4][8]) {
    float w[4][8], bias[8];
#pragma unroll
    for (int k = 0; k < 4; ++k) { const f32x4 a = *(const f32x4*)(cw + k * 3072 + c0), b = *(const f32x4*)(cw + k * 3072 + c0 + 4);
        w[k][0] = a[0]; w[k][1] = a[1]; w[k][2] = a[2]; w[k][3] = a[3]; w[k][4] = b[0]; w[k][5] = b[1]; w[k][6] = b[2]; w[k][7] = b[3]; }
    { const f32x4 a = *(const f32x4*)(cb + c0), b = *(const f32x4*)(cb + c0 + 4); bias[0] = a[0]; bias[1] = a[1]; bias[2] = a[2]; bias[3] = a[3]; bias[4] = b[0]; bias[5] = b[1]; bias[6] = b[2]; bias[7] = b[3]; }
#pragma unroll
    for (int li = 0; li < 4; ++li)
#pragma unroll
        for (int i = 0; i < 8; ++i) { float v = bias[i];
#pragma unroll
            for (int k = 0; k < 4; ++k) { const unsigned wv = raw[li + k][i >> 1]; v = fmaf(w[k][i], (i & 1) ? bfhi(wv) : bflo(wv), v); }
            out[li][i] = pg8::silu_f(v); }
}
__device__ __forceinline__ float softplus_f(float x) {
    const float u = __expf(-fabsf(x));
    const float l = u < 0.03f ? u * (1.0f - u * (0.5f - u * (0.33333334f - 0.25f * u))) : __logf(1.0f + u);
    return fmaxf(x, 0.f) + l;
}
__device__ __forceinline__ void conv8l(const u32x4 (&raw)[7], LAS const float* wl, int stride, float (&out)[4][8]) {
    { const f32x4 a = *(LAS const f32x4*)(wl + 4 * stride), b = *(LAS const f32x4*)(wl + 4 * stride + 4);
#pragma unroll
      for (int li = 0; li < 4; ++li) { out[li][0] = a[0]; out[li][1] = a[1]; out[li][2] = a[2]; out[li][3] = a[3]; out[li][4] = b[0]; out[li][5] = b[1]; out[li][6] = b[2]; out[li][7] = b[3]; } }
#pragma unroll
    for (int k = 0; k < 4; ++k) { const f32x4 a = *(LAS const f32x4*)(wl + k * stride), b = *(LAS const f32x4*)(wl + k * stride + 4); const float w8[8] = {a[0], a[1], a[2], a[3], b[0], b[1], b[2], b[3]};
#pragma unroll
        for (int li = 0; li < 4; ++li)
#pragma unroll
            for (int i = 0; i < 8; ++i) { const unsigned wv = raw[li + k][i >> 1]; out[li][i] = fmaf(w8[i], (i & 1) ? bfhi(wv) : bflo(wv), out[li][i]); } }
#pragma unroll
    for (int li = 0; li < 4; ++li)
#pragma unroll
        for (int i = 0; i < 8; ++i) out[li][i] = pg8::silu_f(out[li][i]);
}
__device__ __forceinline__ void conv1l(const u32x4 (&raw)[4], LAS const float* wl, int stride, float (&out)[8]) {
#pragma unroll
    for (int i = 0; i < 8; ++i) out[i] = wl[4 * stride + i];
#pragma unroll
    for (int k = 0; k < 4; ++k) { const f32x4 a = *(LAS const f32x4*)(wl + k * stride), b = *(LAS const f32x4*)(wl + k * stride + 4); const float w8[8] = {a[0], a[1], a[2], a[3], b[0], b[1], b[2], b[3]};
#pragma unroll
        for (int i = 0; i < 8; ++i) { const unsigned wv = raw[k][i >> 1]; out[i] = fmaf(w8[i], (i & 1) ? bfhi(wv) : bflo(wv), out[i]); } }
#pragma unroll
    for (int i = 0; i < 8; ++i) out[i] = pg8::silu_f(out[i]);
}
__device__ __forceinline__ void load4(const bf16_t* ZX, size_t tb, int posl, int col, u32x4 (&raw)[4]) {
#pragma unroll
    for (int r = 0; r < 4; ++r) { const int pos = posl - 3 + r; raw[r] = pos >= 0 ? *(const u32x4*)(ZX + (tb + pos) * ZXLD + col) : (u32x4){0u, 0u, 0u, 0u}; }
}
__device__ __forceinline__ void load7(const bf16_t* ZX, size_t tb, int posl0, int col, u32x4 (&raw)[7]) {
#pragma unroll
    for (int r = 0; r < 7; ++r) { const int pos = posl0 - 3 + r; raw[r] = pos >= 0 ? *(const u32x4*)(ZX + (tb + pos) * ZXLD + col) : (u32x4){0u, 0u, 0u, 0u}; }
}
__device__ __forceinline__ void bc_conv_phase(const Params& p, int sl) {
    const bf16_t* ZX = (const bf16_t*)(p.ws + WS_TMP + T_ZX); bf16_t* BCC = (bf16_t*)(p.ws + WS_BCC);
    const float* cw = p.in[13] + (size_t)sl * 4 * 3072 + 2048; const float* cb = p.in[14] + (size_t)sl * 3072 + 2048;
    const int gt = obx() * NTHR + otid(), nthr = ogd() * NTHR;
    const int cg = gt & 127;
    float w[4][8], bias[8];
#pragma unroll
    for (int k = 0; k < 4; ++k) { const f32x4 a = *(const f32x4*)(cw + k * 3072 + cg * 8), b = *(const f32x4*)(cw + k * 3072 + cg * 8 + 4);
        w[k][0] = a[0]; w[k][1] = a[1]; w[k][2] = a[2]; w[k][3] = a[3]; w[k][4] = b[0]; w[k][5] = b[1]; w[k][6] = b[2]; w[k][7] = b[3]; }
    { const f32x4 a = *(const f32x4*)(cb + cg * 8), b = *(const f32x4*)(cb + cg * 8 + 4); bias[0] = a[0]; bias[1] = a[1]; bias[2] = a[2]; bias[3] = a[3]; bias[4] = b[0]; bias[5] = b[1]; bias[6] = b[2]; bias[7] = b[3]; }
    for (int item = gt; item < (MT / 8) * 128; item += nthr) {
        const int t0 = (item >> 7) * 8, pos0 = t0 & (SEQ - 1);
        u32x4 raw[11];
#pragma unroll
        for (int r = 0; r < 11; ++r) raw[r] = (pos0 - 3 + r) >= 0 ? *(const u32x4*)(ZX + (size_t)(t0 - 3 + r) * ZXLD + 4096 + cg * 8) : (u32x4){0u, 0u, 0u, 0u};
#pragma unroll
        for (int li = 0; li < 8; ++li) { float o[8];
#pragma unroll
            for (int i = 0; i < 8; ++i) { float v = bias[i];
#pragma unroll
                for (int k = 0; k < 4; ++k) { const unsigned wv = raw[li + k][i >> 1]; v = fmaf(w[k][i], (i & 1) ? bfhi(wv) : bflo(wv), v); }
                o[i] = pg8::silu_f(v); }
            u32x4 q; q.x = pk2(o[0], o[1]); q.y = pk2(o[2], o[3]); q.z = pk2(o[4], o[5]); q.w = pk2(o[6], o[7]);
            *(u32x4*)(BCC + (size_t)(t0 + li) * 1024 + cg * 8) = q; }
    }
}
template <bool DRY>
__device__ __forceinline__ void ssd_item(ldsp lds, const Params& p, int sl, int item) {
    const int tid = otid(), lane = tid & 63, wid = tid >> 6, fr = lane & 15, g = lane >> 4;
    const int b = item >> 6, h = (item >> 1) & 31, ph = item & 1, grp = h >> 3;
    bf16_t* ZX = (bf16_t*)(p.ws + WS_TMP + T_ZX); const float* DT = (const float*)(p.ws + WS_TMP + T_DT); float* SSQ = (float*)(p.ws + WS_TMP + T_SSQ);
    const float* cw_ = p.in[13] + (size_t)sl * 4 * 3072; const float* cb_ = p.in[14] + (size_t)sl * 3072;
    const float dtb = p.in[15][sl * 32 + h], av = -__expf(p.in[16][sl * 32 + h]), dsk = p.in[17][sl * 32 + h];
    const size_t tb = (size_t)b * SEQ;
    ldsp Cc = lds, Bc = lds + 34816, BcT = lds + 69632, XdT = lds + 104448, XwT = lds + 113152, Hb = lds + 121856, Xs = lds + 130560;
    LAS float* dtv = (LAS float*)(lds + 140800); LAS float* acs = (LAS float*)(lds + 141312);
    f32x4 hst[2] = {{0.f, 0.f, 0.f, 0.f}, {0.f, 0.f, 0.f, 0.f}};
    for (int i = tid; i < 32 * RS / 4; i += NTHR) ((LAS unsigned*)Hb)[i] = 0u;
    LAS float* cwl = (LAS float*)(lds + 141824);
    for (int i = tid; i < 1440; i += NTHR) { int which, k, ch, chan;
        if (i < 640) { which = 0; k = i >> 7; ch = i & 127; chan = 2048 + grp * 128 + ch; } else if (i < 1280) { which = 1; k = (i - 640) >> 7; ch = (i - 640) & 127; chan = 2560 + grp * 128 + ch; }
        else { which = 2; k = (i - 1280) >> 5; ch = (i - 1280) & 31; chan = h * 64 + ph * 32 + ch; }
        (void)which; cwl[i] = k < 4 ? cw_[k * 3072 + chan] : cb_[chan]; }
    __syncthreads();
    const int cgi = tid & 15, l0s = (tid >> 4) * 4, c0B = 2048 + grp * 128 + cgi * 8, c0C = c0B + 512;
    const int cgx = tid & 3, lx = tid >> 2, c0X = h * 64 + ph * 32 + cgx * 8;
    const bf16_t* BCC = (const bf16_t*)(p.ws + WS_BCC) + grp * 128;
    u32x4 rawB[4], rawC[4], rawX[4]; float dtr0 = 0.f, dtr1 = 0.f;
#define LOAD_BC(dst, tok0, off) do { _Pragma("unroll") for (int r_ = 0; r_ < 4; ++r_) dst[r_] = *(const u32x4*)(BCC + (size_t)((tok0) + r_) * 1024 + (off) + cgi * 8); } while (0)
    LOAD_BC(rawC, tb + l0s, 512); load4(ZX, tb, lx, 2048 + c0X, rawX);
    LOAD_BC(rawB, tb + l0s, 0);
    if (wid == 7) { dtr0 = DT[(tb + 2 * lane) * 32 + h]; dtr1 = DT[(tb + 2 * lane + 1) * 32 + h]; }
#pragma unroll 1
    for (int c = 0; c < 64; ++c) {
        const int cp = c * 128;
        int tidc = tid; asm volatile("" : "+v"(tidc));
        const int lane = tidc & 63, wid = tidc >> 6, fr = lane & 15, g = lane >> 4;
        const int cgi = tidc & 15, l0s = (tidc >> 4) * 4, c0B = 2048 + grp * 128 + cgi * 8, c0C = c0B + 512;
        const int cgx = tidc & 3, lx = tidc >> 2, c0X = h * 64 + ph * 32 + cgx * 8;
        u32x2 zpre[2];
        { bf16_t* zp = ZX + (tb + cp + 16 * wid + fr) * ZXLD + h * 64 + ph * 32 + 4 * g; zpre[0] = *(const u32x2*)zp; zpre[1] = *(const u32x2*)(zp + 16); }
        if (wid == 7) {
            const float r0 = dtr0 + dtb, r1 = dtr1 + dtb;
            if (c + 1 < 64) { dtr0 = DT[(tb + cp + 128 + 2 * lane) * 32 + h]; dtr1 = DT[(tb + cp + 128 + 2 * lane + 1) * 32 + h]; }
            const float d0 = softplus_f(r0), d1 = softplus_f(r1);
            const float a0 = d0 * av, a1 = d1 * av; float sc = a0 + a1;
#pragma unroll
            for (int d = 1; d < 64; d <<= 1) { const float t = __shfl_up(sc, d); if (lane >= d) sc += t; }
            dtv[2 * lane] = d0; dtv[2 * lane + 1] = d1; acs[2 * lane] = sc - a1; acs[2 * lane + 1] = sc;
        }
        { const int l0 = l0s;
#pragma unroll
          for (int li = 0; li < 4; ++li) { *(LAS u32x4*)(Bc + (l0 + li) * RS + cgi * 16) = rawB[li]; *(LAS u32x4*)(Cc + (l0 + li) * RS + cgi * 16) = rawC[li]; }
#pragma unroll
          for (int i = 0; i < 8; ++i) { u32x2 w;
              if (i & 1) { w.x = (rawB[0][i >> 1] >> 16) | (rawB[1][i >> 1] & 0xFFFF0000u); w.y = (rawB[2][i >> 1] >> 16) | (rawB[3][i >> 1] & 0xFFFF0000u); }
              else { w.x = (rawB[0][i >> 1] & 0xFFFFu) | (rawB[1][i >> 1] << 16); w.y = (rawB[2][i >> 1] & 0xFFFFu) | (rawB[3][i >> 1] << 16); }
              *(LAS u32x2*)(BcT + (cgi * 8 + i) * RS + l0 * 2) = w; }
          if (c + 1 < 64) LOAD_BC(rawB, tb + cp + 128 + l0, 0); }
        __syncthreads();
        const float aend = acs[127];
        { float o8[8]; conv1l(rawX, cwl + 1280 + cgx * 8, 32, o8);
          const float dl = dtv[lx], wl = dl * __expf(aend - acs[lx]);
          u32x4 w; w.x = pk2(o8[0], o8[1]); w.y = pk2(o8[2], o8[3]); w.z = pk2(o8[4], o8[5]); w.w = pk2(o8[6], o8[7]);
          *(LAS u32x4*)(Xs + lx * 80 + cgx * 16) = w;
#pragma unroll
          for (int i = 0; i < 8; i += 2) { const int pp = cgx * 8 + i; const unsigned a2 = pk2(o8[i] * dl, o8[i + 1] * dl), b2 = pk2(o8[i] * wl, o8[i + 1] * wl);
              *(LAS unsigned short*)(XdT + pp * RS + lx * 2) = (unsigned short)(a2 & 0xFFFFu); *(LAS unsigned short*)(XdT + (pp + 1) * RS + lx * 2) = (unsigned short)(a2 >> 16);
              *(LAS unsigned short*)(XwT + pp * RS + lx * 2) = (unsigned short)(b2 & 0xFFFFu); *(LAS unsigned short*)(XwT + (pp + 1) * RS + lx * 2) = (unsigned short)(b2 >> 16); } }
        u32x2 mm[8];
        { bf16x8 a[4];
#pragma unroll
          for (int ks = 0; ks < 4; ++ks) a[ks] = ld_lds128(Bc + (16 * wid + fr) * RS + ks * 64 + g * 16);
          float as4[4];
#pragma unroll
          for (int j = 0; j < 4; ++j) as4[j] = acs[16 * wid + 4 * g + j];
#pragma unroll
          for (int lt = 0; lt < 8; ++lt) {
              mm[lt] = (u32x2){0u, 0u};
              if (lt >= wid) {
                  f32x4 acc = {0.f, 0.f, 0.f, 0.f};
#pragma unroll
                  for (int ks = 0; ks < 4; ++ks) acc = mfma16(a[ks], ld_lds128(Cc + (lt * 16 + fr) * RS + ks * 64 + g * 16), acc);
                  const int l = lt * 16 + fr; const float al = acs[l]; float v[4];
#pragma unroll
                  for (int j = 0; j < 4; ++j) { const int s = 16 * wid + 4 * g + j; v[j] = (s <= l) ? acc[j] * __expf(al - as4[j]) : 0.f; }
                  mm[lt].x = pk2(v[0], v[1]); mm[lt].y = pk2(v[2], v[3]); } } }
        __syncthreads();
#pragma unroll
        for (int lt = 0; lt < 8; ++lt) *(LAS u32x2*)(Bc + (lt * 16 + fr) * RS + (16 * wid + 4 * g) * 2) = mm[lt];
        __syncthreads();
        if (c + 1 < 64) { LOAD_BC(rawC, tb + cp + 128 + l0s, 512); load4(ZX, tb, cp + 128 + lx, 2048 + c0X, rawX); }
        { f32x4 y1[2] = {{0.f, 0.f, 0.f, 0.f}, {0.f, 0.f, 0.f, 0.f}}, y2[2] = {{0.f, 0.f, 0.f, 0.f}, {0.f, 0.f, 0.f, 0.f}};
          const int l = 16 * wid + fr;
#pragma unroll
          for (int ks = 0; ks < 4; ++ks) {
              const bf16x8 bm = ld_lds128(Bc + l * RS + ks * 64 + g * 16), bc = ld_lds128(Cc + l * RS + ks * 64 + g * 16);
#pragma unroll
              for (int pt = 0; pt < 2; ++pt) { y1[pt] = mfma16(ld_lds128(XdT + (pt * 16 + fr) * RS + ks * 64 + g * 16), bm, y1[pt]); y2[pt] = mfma16(ld_lds128(Hb + (pt * 16 + fr) * RS + ks * 64 + g * 16), bc, y2[pt]); } }
          const float el = __expf(acs[l]); const size_t tg = tb + cp + l; float sq = 0.f;
#pragma unroll
          for (int pt = 0; pt < 2; ++pt) { const int pp = pt * 16 + 4 * g;
              const u32x2 xs2 = *(LAS const u32x2*)(Xs + l * 80 + pp * 2); bf16_t* zp = ZX + tg * ZXLD + h * 64 + ph * 32 + pp; const u32x2 z2 = zpre[pt];
              float yv[4], xv[4] = {bflo(xs2.x), bfhi(xs2.x), bflo(xs2.y), bfhi(xs2.y)}, zv[4] = {bflo(z2.x), bfhi(z2.x), bflo(z2.y), bfhi(z2.y)};
#pragma unroll
              for (int j = 0; j < 4; ++j) { yv[j] = (y1[pt][j] + el * y2[pt][j] + xv[j] * dsk) * pg8::silu_f(zv[j]); sq += yv[j] * yv[j]; }
              u32x2 w; w.x = pk2(yv[0], yv[1]); w.y = pk2(yv[2], yv[3]);
              if (DRY) *(u32x2*)((bf16_t*)(p.ws + WS_END + 65536) + (((size_t)(zp - ZX)) & 0xFFFFFCull)) = w; else *(u32x2*)zp = w; }
          sq += __shfl_xor(sq, 16); sq += __shfl_xor(sq, 32);
          if (g == 0) { if (DRY) ((float*)(p.ws + WS_END + 65536 + 40000000))[(tg * 64 + h * 2 + ph) & 0xFFFFF] = sq; else SSQ[tg * 64 + h * 2 + ph] = sq; } }
        { const float dec = __expf(aend);
          hst[0] = hst[0] * dec; hst[1] = hst[1] * dec;
#pragma unroll
          for (int ks = 0; ks < 4; ++ks) { const bf16x8 ab = ld_lds128(BcT + (16 * wid + fr) * RS + ks * 64 + g * 16);
#pragma unroll
              for (int pt = 0; pt < 2; ++pt) hst[pt] = mfma16(ab, ld_lds128(XwT + (pt * 16 + fr) * RS + ks * 64 + g * 16), hst[pt]); } }
        __syncthreads();
#pragma unroll
        for (int pt = 0; pt < 2; ++pt) { u32x2 w; w.x = pk2(hst[pt][0], hst[pt][1]); w.y = pk2(hst[pt][2], hst[pt][3]); *(LAS u32x2*)(Hb + (pt * 16 + fr) * RS + (16 * wid + 4 * g) * 2) = w; }
    }
    __syncthreads();
#undef LOAD_BC
}
__device__ __forceinline__ void ssd_norm_phase(const Params& p) {
    bf16_t* ZX = (bf16_t*)(p.ws + WS_TMP + T_ZX); const float* SSQ = (const float*)(p.ws + WS_TMP + T_SSQ);
    const int tid_ = otid(); const int lane = tid_ & 63, gw = obx() * 8 + (tid_ >> 6), nw = ogd() * 8;
    for (int row0 = gw; row0 < MT; row0 += 2 * nw) {
        float part[2]; u32x4 v[2][4];
#pragma unroll
        for (int r = 0; r < 2; ++r) { const int row = row0 + r * nw; const size_t rr = (size_t)(row < MT ? row : row0);
            part[r] = SSQ[rr * 64 + lane];
#pragma unroll
            for (int i = 0; i < 4; ++i) v[r][i] = *(const u32x4*)(ZX + rr * ZXLD + i * 512 + lane * 8); }
#pragma unroll
        for (int r = 0; r < 2; ++r) { const int row = row0 + r * nw;
            float pt = part[r]; pt += __shfl_xor(pt, 1); pt += __shfl_xor(pt, 2); pt += __shfl_xor(pt, 4); pt += __shfl_xor(pt, 8);
#pragma unroll
            for (int i = 0; i < 4; ++i) { const float rs = rsqrtf(__shfl(pt, i * 16) * (1.0f / 512.0f) + RMS_EPS); u32x4 w;
#pragma unroll
                for (int k = 0; k < 4; ++k) w[k] = pk2(bflo(v[r][i][k]) * rs, bfhi(v[r][i][k]) * rs);
                if (row < MT) *(u32x4*)(ZX + (size_t)row * ZXLD + i * 512 + lane * 8) = w; } }
    }
}

#define XB_TMO      128
#define XB_XCNT(j)  (256  + 64 * (j))
#define XB_XSUB(j)  (1280 + 64 * (j))
#define XB_XGEN(j)  (2304 + 64 * (j))
#define XB_TOP      3328
#define XB_TOPGEN   3392
#define XCD_BAR_WORDS 3456
#define XB_SPIN_CAP (1u << 20)
__device__ __forceinline__ unsigned xb_ld(unsigned* p)              { return __hip_atomic_load(p, __ATOMIC_RELAXED, __HIP_MEMORY_SCOPE_AGENT); }
__device__ __forceinline__ unsigned xb_add(unsigned* p, unsigned v) { return __hip_atomic_fetch_add(p, v, __ATOMIC_RELAXED, __HIP_MEMORY_SCOPE_AGENT); }
__device__ __forceinline__ unsigned xb_xcc_id() { return (unsigned)__builtin_amdgcn_s_getreg((3 << 11) | 20) & 0xFu; }
#define XB_SPIN(cond, bar) do { unsigned _sp = 0; while (cond) { __builtin_amdgcn_s_sleep(1); \
    if ((++_sp & 255u) == 0u) { if (xb_ld(&(bar)[XB_TMO])) break; if (_sp > XB_SPIN_CAP) { atomicAdd(&(bar)[XB_TMO], 1u); break; } } } } while (0)
struct XcdBarrier { unsigned* bar; unsigned x; volatile LAS unsigned* st; };
__device__ __forceinline__ void xcd_barrier_complete(unsigned* bar, unsigned x, unsigned& nloc, unsigned& nx) {
    const unsigned G = gridDim.x * gridDim.y * gridDim.z;
    unsigned sum, cnt, mine, sp = 0u;
    for (;;) {
        sum = 0u; cnt = 0u; mine = 0u;
#pragma unroll
        for (unsigned j = 0; j < 16; ++j) { const unsigned c = xb_ld(&bar[XB_XCNT(j)]); sum += c; cnt += (c > 0u) ? 1u : 0u; mine = (j == x) ? c : mine; }
        if (sum == G) break;
        __builtin_amdgcn_s_sleep(1);
        if ((++sp & 255u) == 0u) { if (xb_ld(&bar[XB_TMO])) break; if (sp > XB_SPIN_CAP) { atomicAdd(&bar[XB_TMO], 1u); break; } }
    }
    nloc = mine > 0u ? mine : 1u; nx = cnt > 0u ? cnt : 1u;
}
__device__ __forceinline__ void xcd_barrier(const XcdBarrier& b) {
    asm volatile("s_waitcnt vmcnt(0)" ::: "memory");
    __syncthreads();
    if (otid() == 0) {
        unsigned* bar = b.bar;
        __builtin_amdgcn_s_waitcnt(0);
        unsigned nloc = b.st[0], nx = b.st[1];
        if (nloc == 0u) { xcd_barrier_complete(bar, b.x, nloc, nx); b.st[0] = nloc; b.st[1] = nx; }
        const unsigned old = xb_add(&bar[XB_XSUB(b.x)], 1u);
        const unsigned gen = old / nloc;
        if (old + 1u == (gen + 1u) * nloc) {
            __builtin_amdgcn_fence(__ATOMIC_RELEASE, "agent");
            asm volatile("s_waitcnt vmcnt(0)" ::: "memory");
            const unsigned og = xb_add(&bar[XB_TOP], 1u);
            const unsigned tg = og / nx;
            if (og + 1u == (tg + 1u) * nx) xb_add(&bar[XB_TOPGEN], 1u);
            else XB_SPIN(xb_ld(&bar[XB_TOPGEN]) == tg, bar);
            __builtin_amdgcn_fence(__ATOMIC_ACQUIRE, "agent");
            xb_add(&bar[XB_XGEN(b.x)], 1u);
            asm volatile("s_waitcnt vmcnt(0)" ::: "memory");
        } else {
            XB_SPIN(xb_ld(&bar[XB_XGEN(b.x)]) == gen, bar);
            __builtin_amdgcn_fence(__ATOMIC_ACQUIRE, "agent");
            asm volatile("s_waitcnt vmcnt(0)" ::: "memory");
        }
    }
    __syncthreads();
}
constexpr size_t WS_BAR = WS_END;
constexpr int LDS_BARST = LDS_BYTES - 16;
#define GRID_BAR() do { XcdBarrier _b; { const Params _q = load_params(); _b.bar = (unsigned*)(_q.ws + WS_BAR); } _b.x = xb_xcc_id(); _b.st = (volatile LAS unsigned*)(lds + LDS_BARST); xcd_barrier(_b); } while (0)

__global__ void __launch_bounds__(NTHR, 2) fwd_megakernel(Params p) {
    extern __shared__ __attribute__((aligned(16))) unsigned char smem[];
    ldsp lds = (ldsp)smem;
    cg::grid_group grid = cg::this_grid();
    if (otid() == 0) { ((volatile LAS unsigned*)(lds + LDS_BARST))[0] = 0u; ((volatile LAS unsigned*)(lds + LDS_BARST))[1] = 0u; }
    __syncthreads();
    { const Params q = load_params(); if (otid() == 0) (void)xb_add(&((unsigned*)(q.ws + WS_BAR))[XB_XCNT(xb_xcc_id())], 1u); }
    { const Params q = load_params(); cvt_x_phase(q.in[0], (bf16_t*)(q.ws + WS_XB)); }
#ifndef NO_CONV
    { const Params q = load_params(); convert_layer(lds, q, 0); }
#endif
    if (ogd() == 0x7FFFFFF) grid.sync();
    GRID_BAR();
#pragma unroll 1
    for (int sub = 0; sub < 12; ++sub) {
        const int L = sub / 3, kind = sub % 3, sl = L >> 1; const bool attn = (L & 1) == 0;
#if defined(SKIP_ATTN) || defined(SKIP_SSM)
        {
#if defined(SKIP_ATTN) && defined(SKIP_SSM)
            const bool skip = kind == 1;
#elif defined(SKIP_ATTN)
            const bool skip = kind == 1 && attn;
#else
            const bool skip = kind == 1 && !attn;
#endif
            if (skip) { const Params q = load_params(); ln_phase<false>(q.out, (bf16_t*)(q.ws + WS_XB), q.in[1] + (size_t)(L * 3 + kind) * DM, q.in[2] + (size_t)(L * 3 + kind) * DM, nullptr, sub == 11); GRID_BAR(); continue; }
        }
#endif
        if (kind != 1) {
            const Params q = load_params(); const int G = ogd(), bx = obx();
            pg8::Gemm gm{(const bf16_t*)(q.ws + WS_XB), (const bf16_t*)(q.ws + WS_WL + (kind == 0 ? WL_F1IN : WL_F2IN)), MT, 5632, 1024, 1024}; pg8::StaticOrder S; S.init(MT, 5632, G, bx);
            pg8::EpiSwiglu E{(bf16_t*)(q.ws + WS_TMP + T_H)};
            pg8::gemm_phase<pg8::EpiSwiglu, pg8::StaticOrder>((PG8_LAS unsigned char*)lds, gm, S, E, nullptr);
        } else {
            const Params q = load_params(); const int G = ogd(), bx = obx(); unsigned char* tmp = q.ws + WS_TMP;
            const int N = attn ? 2048 : 5376;
            pg8::Gemm gm{(const bf16_t*)(q.ws + WS_XB), (const bf16_t*)(q.ws + WS_WL + WL_MIX), MT, N, 1024, 1024}; pg8::StaticOrder S; S.init(MT, N, G, bx);
            pg8::EpiSplit E{(bf16_t*)tmp, attn ? QBLD : ZXLD, attn ? 7 : 20, (float*)(tmp + (attn ? T_CKV : T_DT)), attn ? 256 : 32, attn ? 256 : 32, (bf16_t*)(tmp + T_KW), attn ? 6 : -1};
            pg8::gemm_phase<pg8::EpiSplit, pg8::StaticOrder>((PG8_LAS unsigned char*)lds, gm, S, E, nullptr);
        }
        GRID_BAR();
        if (kind == 1) {
            if (attn) {
                { const Params q = load_params(); ckv_norm_phase((const float*)(q.ws + WS_TMP + T_CKV), (bf16_t*)(q.ws + WS_TMP + T_CKVN), q.in[8] + (size_t)sl * 256); }
#ifndef NO_IDX
                { const Params q = load_params(); indexer_phase(lds, q); }
#ifdef DBL_IDX
                { const Params q = load_params(); indexer_phase(lds, q); }
#endif
#endif
                GRID_BAR();
#ifndef NO_SATTN
                { const Params q = load_params(); sattn_phase(lds, q); }
#ifdef DBL_SATTN
                { const Params q = load_params(); sattn_phase(lds, q); }
#endif
#else
                { const Params q = load_params(); u32x4* Oz = (u32x4*)(q.ws + WS_TMP + T_O); for (size_t i = (size_t)obx() * NTHR + otid(); i < (size_t)MT * 1024 / 8; i += (size_t)ogd() * NTHR) Oz[i] = (u32x4){0u, 0u, 0u, 0u}; }
#endif
                GRID_BAR();
            } else {
                { const Params q = load_params(); bc_conv_phase(q, sl); }
                GRID_BAR();
#ifndef NO_SSD
#ifdef DBL_SSD
                { const Params q = load_params(); const int G = ogd(); for (int it = obx(); it < 256; it += G) ssd_item<true>(lds, q, sl, it); }
#endif
                { const Params q = load_params(); const int G = ogd();
                  for (int it = obx(); it < 256; it += G) { int item = it;
                      if (G == 256) { const int xcd = it & 7, slot = it >> 3, bg = xcd * 2 + (slot >> 4), wi = slot & 15; item = ((bg >> 2) << 6) | ((((bg & 3) * 8) + (wi >> 1)) << 1) | (wi & 1); }
                      ssd_item<false>(lds, q, sl, item); } }
#endif
                GRID_BAR();
                { const Params q = load_params(); ssd_norm_phase(q); }
                GRID_BAR();
            }
        }
        {
            const Params q = load_params(); const int G = ogd(), bx = obx(); unsigned char* tmp = q.ws + WS_TMP; unsigned char* wl = q.ws + WS_WL;
            const bf16_t* A2 = (const bf16_t*)(tmp + T_H); int K2 = DFF, lda2 = DFF; const bf16_t* B2 = (const bf16_t*)(wl + (kind == 0 ? WL_F1OUT : WL_F2OUT)); float sc2 = 0.5f;
            if (kind == 1) { sc2 = 1.0f;
                if (attn) { A2 = (const bf16_t*)(tmp + T_O); K2 = 1024; lda2 = 1024; B2 = (const bf16_t*)(wl + WL_MIX + WM_AOUT); }
                else { A2 = (const bf16_t*)(tmp + T_ZX); K2 = 2048; lda2 = ZXLD; B2 = (const bf16_t*)(wl + WL_MIX + WM_SOUT); } }
            pg8::Gemm gm{A2, B2, MT, 1024, K2, lda2}; pg8::StaticOrder S; S.init(MT, 1024, G, bx);
            pg8::EpiResid E{(bf16_t*)(q.ws + WS_XB), ALPHA, sc2};
            pg8::gemm_phase<pg8::EpiResid, pg8::StaticOrder>((PG8_LAS unsigned char*)lds, gm, S, E, nullptr);
        }
        GRID_BAR();
#ifdef DBL_LN
        { const Params q = load_params(); ln_phase<true>(q.out, (bf16_t*)(q.ws + WS_XB), q.in[1] + (size_t)(L * 3 + kind) * DM, q.in[2] + (size_t)(L * 3 + kind) * DM, q.ws + WS_END + 65536, sub == 11); }
#endif
        { const Params q = load_params(); ln_phase<false>(q.out, (bf16_t*)(q.ws + WS_XB), q.in[1] + (size_t)(L * 3 + kind) * DM, q.in[2] + (size_t)(L * 3 + kind) * DM, nullptr, sub == 11); }
#ifndef NO_CONV
        if (kind == 2 && L < 3) { const Params q = load_params(); convert_layer(lds, q, L + 1); }
#endif
        GRID_BAR();
    }
}

extern "C" void kernel_launch(void* const* d_in, const int* in_sizes, int n_in, void* d_out, int out_size, void* d_ws, size_t ws_size, hipStream_t stream) {
    static int grid_blocks = 0;
    if (grid_blocks == 0) {
        if (n_in != 20 || ws_size < WS_BCC + (size_t)MT * 1024 * 2) { fprintf(stderr, "kernel_launch: unexpected inputs (n_in %d, ws %zu < %zu)\n", n_in, ws_size, (size_t)WS_END); grid_blocks = -1; return; }
        int dev = 0, cus = 0, per_cu = 0;
        hipGetDevice(&dev); hipDeviceGetAttribute(&cus, hipDeviceAttributeMultiprocessorCount, dev);
        if (hipFuncSetAttribute((const void*)fwd_megakernel, hipFuncAttributeMaxDynamicSharedMemorySize, LDS_BYTES) != hipSuccess) { fprintf(stderr, "kernel_launch: hipFuncSetAttribute failed\n"); grid_blocks = -1; return; }
        hipOccupancyMaxActiveBlocksPerMultiprocessor(&per_cu, (const void*)fwd_megakernel, NTHR, LDS_BYTES);
        if (per_cu < 1) { fprintf(stderr, "kernel_launch: occupancy query says %d blocks per CU\n", per_cu); per_cu = 1; }
        (void)hipGetLastError();
        grid_blocks = cus * per_cu;
    }
    if (grid_blocks < 0) return;
    if (hipMemsetAsync((char*)d_ws + WS_BAR, 0, XCD_BAR_WORDS * 4, stream) != hipSuccess) { fprintf(stderr, "kernel_launch: memset of the barrier words failed\n"); return; }
    Params p{};
    for (int i = 0; i < 20; ++i) p.in[i] = (const float*)d_in[i];
    p.out = (float*)d_out; p.ws = (unsigned char*)d_ws;
    void* args[] = {&p};
    hipError_t e = hipLaunchCooperativeKernel((const void*)fwd_megakernel, dim3(grid_blocks), dim3(NTHR), args, LDS_BYTES, stream);
    if (e != hipSuccess) fprintf(stderr, "cooperative launch failed: %s (grid %d)\n", hipGetErrorString(e), grid_blocks);
}
```

```cpp
#include <hip/hip_runtime.h>
#include <hip/hip_cooperative_groups.h>
#include <cstdio>
namespace cg = cooperative_groups;
namespace pg8 {
#define PG8_LAS __attribute__((address_space(3)))
typedef unsigned short bf16_t;
typedef short bf16x8 __attribute__((ext_vector_type(8)));
typedef float f32x4 __attribute__((ext_vector_type(4)));
typedef unsigned u32x4 __attribute__((ext_vector_type(4)));
constexpr int BM = 256, BK = 64, HALF = 128, HTB = HALF * BK * 2  , STAGE_BYTES = 8 * HTB, NXCD = 8, WGM = 8;

__host__ __device__ __forceinline__ int lds_byte(int r, int c) { const int st = (r >> 4) * 2 + (c >> 5), rr = r & 15, cc = c & 31, ob = rr * 64 + cc * 2; return st * 1024 + (ob ^ (((ob >> 9) & 1) << 5)); }
__host__ __device__ __forceinline__ void stage_rc(int b, int& R, int& C) { const int st = b / 1024, sb = b % 1024, swz = sb ^ (((sb >> 9) & 1) << 5); R = (st >> 1) * 16 + swz / 64; C = (st & 1) * 32 + (swz % 64) / 2; }
__host__ __device__ __forceinline__ int perm32(int rho) { const int n = rho >> 4, i = rho & 15; return 8 * (i >> 2) + 4 * n + (i & 3); }

struct Unit { int pm, pn; };
struct Gemm { const bf16_t* A; const bf16_t* Bt; int M, N, K, lda; };

struct StaticOrder {
    int nM, nN, nwg, G, c;
    __host__ __device__ void init(int M, int N, int G_, int c_) { nM = M / BM; nN = N / BM; nwg = nM * nN; G = G_; c = c_; }
    __host__ __device__ bool next(int i, Unit& u) const {
        const long L = (long)i * G + c; if (L >= nwg) return false;
        int wgid = (int)L; { const int q = nwg / NXCD, r = nwg % NXCD, xcd = wgid % NXCD, off = wgid / NXCD; wgid = (xcd < r ? xcd * (q + 1) : r * (q + 1) + (xcd - r) * q) + off; }
        const int nig = WGM * nN, gid = wgid / nig, fm = gid * WGM, gsz = (nM - fm) < WGM ? (nM - fm) : WGM;
        u.pm = fm + ((wgid % nig) % gsz); u.pn = (wgid % nig) / gsz; return true;
    }
    __device__ __forceinline__ void a_ready(const Unit&) const {}
    __device__ __forceinline__ void done(const Unit&) const {}
};
typedef __bf16 bf16x2_t __attribute__((ext_vector_type(2)));
typedef float f32x2_t __attribute__((ext_vector_type(2)));
__device__ __forceinline__ unsigned cvt_pk_bf16(float lo, float hi) { const f32x2_t f = {lo, hi}; const bf16x2_t v = __builtin_convertvector(f, bf16x2_t); return __builtin_bit_cast(unsigned, v); }
__device__ __forceinline__ float silu_f(float x) { return x * __builtin_amdgcn_rcpf(1.0f + __expf(-x)); }
struct EpiSwiglu {
    static constexpr bool PERM = true, AFTER_DRAIN = false;
    bf16_t* H;
    __device__ __forceinline__ void operator()(const f32x4 (&acc)[2][2][4][2], const Unit& u, int wr, int wc, int fr, int fq) const {
        const int row0 = u.pm * BM + wr * 64 + fr, col0 = u.pn * 128 + wc * 32 + 8 * fq;
#pragma unroll
        for (int ai = 0; ai < 2; ++ai)
#pragma unroll
            for (int m = 0; m < 4; ++m) {
                bf16_t* rowp = H + (size_t)(row0 + ai * HALF + m * 16) * 2816 + col0;
                const f32x4 g0 = acc[ai][0][m][0], g1 = acc[ai][0][m][1], u0 = acc[ai][1][m][0], u1 = acc[ai][1][m][1];
                u32x4 w;
                w.x = cvt_pk_bf16(silu_f(g0[0]) * u0[0], silu_f(g0[1]) * u0[1]); w.y = cvt_pk_bf16(silu_f(g0[2]) * u0[2], silu_f(g0[3]) * u0[3]);
                w.z = cvt_pk_bf16(silu_f(g1[0]) * u1[0], silu_f(g1[1]) * u1[1]); w.w = cvt_pk_bf16(silu_f(g1[2]) * u1[2], silu_f(g1[3]) * u1[3]);
                *(u32x4*)rowp = w; }
    }
};
struct EpiResid {
    static constexpr bool PERM = false, AFTER_DRAIN = false;
    bf16_t* X; float alpha, scale;
    __device__ __forceinline__ void operator()(const f32x4 (&acc)[2][2][4][2], const Unit& u, int wr, int wc, int fr, int fq) const {
        const int row0 = u.pm * BM + wr * 64 + fr, col0 = u.pn * BM + wc * 32 + 4 * fq;
        typedef unsigned u32x2_t __attribute__((ext_vector_type(2)));
#pragma unroll
        for (int ai = 0; ai < 2; ++ai)
#pragma unroll
            for (int m = 0; m < 4; ++m) { const size_t ro = (size_t)(row0 + ai * HALF + m * 16) * 1024 + col0;
#pragma unroll
                for (int bj = 0; bj < 2; ++bj)
#pragma unroll
                    for (int n = 0; n < 2; ++n) { const size_t o = ro + bj * HALF + n * 16; const u32x2_t rb = *(const u32x2_t*)(X + o);
                        f32x4 r; r[0] = __uint_as_float(rb.x << 16); r[1] = __uint_as_float(rb.x & 0xFFFF0000u); r[2] = __uint_as_float(rb.y << 16); r[3] = __uint_as_float(rb.y & 0xFFFF0000u);
                        const f32x4 y = r * alpha + acc[ai][bj][m][n] * scale; u32x2_t w; w.x = cvt_pk_bf16(y[0], y[1]); w.y = cvt_pk_bf16(y[2], y[3]); *(u32x2_t*)(X + o) = w; } }
    }
};
struct EpiSplit {
    static constexpr bool PERM = true, AFTER_DRAIN = false;
    bf16_t* O; int ldo; int nb16; float* F; int ldf; int fcols; bf16_t* O2; int pn2;
    __device__ __forceinline__ void operator()(const f32x4 (&acc)[2][2][4][2], const Unit& u, int wr, int wc, int fr, int fq) const {
        const int row0 = u.pm * BM + wr * 64 + fr;
        if (u.pn < nb16) {
            const int col0 = u.pn * BM + wc * 32 + 8 * fq;
#pragma unroll
            for (int ai = 0; ai < 2; ++ai)
#pragma unroll
                for (int m = 0; m < 4; ++m) { bf16_t* rowp = O + (size_t)(row0 + ai * HALF + m * 16) * ldo + col0;
#pragma unroll
                    for (int bj = 0; bj < 2; ++bj) { const f32x4 v0 = acc[ai][bj][m][0], v1 = acc[ai][bj][m][1]; u32x4 w;
                        w.x = cvt_pk_bf16(v0[0], v0[1]); w.y = cvt_pk_bf16(v0[2], v0[3]); w.z = cvt_pk_bf16(v1[0], v1[1]); w.w = cvt_pk_bf16(v1[2], v1[3]);
                        *(u32x4*)(rowp + bj * HALF) = w;
                        if (u.pn == pn2 && bj == 0) *(u32x4*)(O2 + (size_t)(row0 + ai * HALF + m * 16) * 128 + wc * 32 + 8 * fq) = w; } }
        } else {
            const int col0 = (u.pn - nb16) * BM + wc * 32 + 8 * fq;
#pragma unroll
            for (int ai = 0; ai < 2; ++ai)
#pragma unroll
                for (int m = 0; m < 4; ++m) { float* rowp = F + (size_t)(row0 + ai * HALF + m * 16) * ldf;
#pragma unroll
                    for (int bj = 0; bj < 2; ++bj) { const int c = col0 + bj * HALF;
                        if (c < fcols) { *(f32x4*)(rowp + c) = acc[ai][bj][m][0]; *(f32x4*)(rowp + c + 4) = acc[ai][bj][m][1]; } } }
        }
    }
};
template <class Epi, class Sched, bool STAMP = false>
__device__ __forceinline__ void gemm_phase(PG8_LAS unsigned char* lds, const Gemm g, const Sched& S, const Epi& E, unsigned long long* stamps) {
    int tid = threadIdx.x; asm volatile("" : "+v"(tid)); const int wid = __builtin_amdgcn_readfirstlane(tid >> 6), lane = tid & 63, wr = wid >> 2, wc = wid & 3, fr = lane & 15, fq = lane >> 4;
    const int K = g.K, nt = K / BK;
    int ts_lo = 0, ts_hi = 0, nts = 0; const unsigned long long rt_entry = STAMP ? (unsigned long long)wall_clock64() : 0ull;
#define PG8_STAMP() do { if (STAMP && wid == 0 && nts < 64) { const unsigned long long _c = (unsigned long long)clock64(); \
        ts_lo = (lane == nts) ? (int)(unsigned)_c : ts_lo; ts_hi = (lane == nts) ? (int)(unsigned)(_c >> 32) : ts_hi; ++nts; } } while (0)
    PG8_STAMP();
    unsigned voffA[2], voffB[2];
#pragma unroll
    for (int i = 0; i < 2; ++i) { int R, C; stage_rc(tid * 16 + i * 8192, R, C); const int Rb = Epi::PERM ? ((R & ~31) + perm32(R & 31)) : R;
        voffA[i] = (unsigned)(R * g.lda + C) * 2u; voffB[i] = (unsigned)(Rb * K + C) * 2u; }
    const size_t kstep = (size_t)(BK * 2);
    const size_t hstep = (size_t)HALF * K * 2;
    const size_t tstep = 2 * hstep; const size_t hstepA = (size_t)HALF * g.lda * 2; const size_t tstepA = 2 * hstepA;
    const unsigned ldsw = (unsigned)wid * 1024u;
    const int aoff = lds_byte(wr * 64 + fr, fq * 8), boff = lds_byte(wc * 32 + fr, fq * 8);
#define PG8_SA(b, h) (((b) * 2 + (h)) * HTB)
#define PG8_SB(b, h) ((4 + (b) * 2 + (h)) * HTB)
#define PG8_STAGE(bufoff, gbase, voff) do { _Pragma("unroll") for (int _i = 0; _i < 2; ++_i) \
        __builtin_amdgcn_global_load_lds((const unsigned*)((const char*)(gbase) + (voff)[_i]), (PG8_LAS unsigned*)(lds + (bufoff) + ldsw + _i * 8192), 16, 0, 0); } while (0)
#define PG8_LDA(dst, b, h) do { _Pragma("unroll") for (int m = 0; m < 4; ++m) _Pragma("unroll") for (int k = 0; k < 2; ++k) dst[m][k] = *(const PG8_LAS bf16x8*)(lds + PG8_SA(b, h) + aoff + m * 2048 + k * 1024); } while (0)
#define PG8_LDB(dst, b, h) do { _Pragma("unroll") for (int n = 0; n < 2; ++n) _Pragma("unroll") for (int k = 0; k < 2; ++k) dst[n][k] = *(const PG8_LAS bf16x8*)(lds + PG8_SB(b, h) + boff + n * 2048 + k * 1024); } while (0)
#define PG8_MMA(ai, bj, At, Bt) do { __builtin_amdgcn_s_setprio(1); _Pragma("unroll") for (int m = 0; m < 4; ++m) _Pragma("unroll") for (int n = 0; n < 2; ++n) _Pragma("unroll") for (int k = 0; k < 2; ++k) \
        acc[ai][bj][m][n] = __builtin_amdgcn_mfma_f32_16x16x32_bf16(Bt[n][k], At[m][k], acc[ai][bj][m][n], 0, 0, 0); __builtin_amdgcn_s_setprio(0); } while (0)
#define PG8_WAIT_V(n) asm volatile("s_waitcnt vmcnt(" #n ")" ::: "memory")
#define PG8_WAIT_L(n) asm volatile("s_waitcnt lgkmcnt(" #n ")" ::: "memory")
#define PG8_BAR __builtin_amdgcn_s_barrier()
#define PG8_SCHED __builtin_amdgcn_sched_barrier(0)
    Unit cur, nxt; int ui = 0;
    if (!S.next(0, cur)) return;
    f32x4 acc[2][2][4][2];
#pragma unroll
    for (int a = 0; a < 2; ++a)
#pragma unroll
        for (int b = 0; b < 2; ++b)
#pragma unroll
            for (int m = 0; m < 4; ++m)
#pragma unroll
                for (int n = 0; n < 2; ++n) acc[a][b][m][n] = (f32x4){0.f, 0.f, 0.f, 0.f};
    bf16x8 At[4][2], B0[2][2], B1[2][2];
    const char* cA = (const char*)g.A + (size_t)cur.pm * tstepA; const char* cB = (const char*)g.Bt + (size_t)cur.pn * tstep;
    S.a_ready(cur);
    PG8_STAGE(PG8_SB(0, 0), cB, voffB); PG8_STAGE(PG8_SA(0, 0), cA, voffA); PG8_STAGE(PG8_SB(0, 1), cB + hstep, voffB); PG8_STAGE(PG8_SA(0, 1), cA + hstepA, voffA);
    if (wr == 1) PG8_BAR;
    PG8_WAIT_V(4); PG8_BAR;
    PG8_STAGE(PG8_SB(1, 0), cB + kstep, voffB); PG8_STAGE(PG8_SA(1, 0), cA + kstep, voffA); PG8_STAGE(PG8_SB(1, 1), cB + hstep + kstep, voffB);
    PG8_WAIT_V(6); PG8_BAR;
    PG8_STAMP();
    for (;;) {
        const bool has_next = S.next(ui + 1, nxt);
        const char* nA = has_next ? (const char*)g.A + (size_t)nxt.pm * tstepA : cA; const char* nB = has_next ? (const char*)g.Bt + (size_t)nxt.pn * tstep : cB;
        for (int t = 0; t < nt; t += 2) {
            const bool last = (t == nt - 2);
            const char* a1 = cA + (size_t)(t + 1) * kstep;
            const char* a2 = last ? nA : cA + (size_t)(t + 2) * kstep; const char* b2 = last ? nB : cB + (size_t)(t + 2) * kstep;
            const char* a3 = a2 + kstep; const char* b3 = b2 + kstep;
            if (last && has_next) S.a_ready(nxt);
            PG8_LDB(B0, 0, 0); PG8_SCHED; PG8_LDA(At, 0, 0); PG8_STAGE(PG8_SA(1, 1), a1 + hstepA, voffA);
            PG8_WAIT_L(8); PG8_BAR; PG8_WAIT_L(0); PG8_MMA(0, 0, At, B0); PG8_BAR; PG8_SCHED;
            PG8_LDB(B1, 0, 1); PG8_STAGE(PG8_SB(0, 0), b2, voffB);
            PG8_BAR; PG8_WAIT_L(0); PG8_MMA(0, 1, At, B1); PG8_BAR;
            PG8_LDA(At, 0, 1); PG8_STAGE(PG8_SA(0, 0), a2, voffA);
            PG8_BAR; PG8_WAIT_L(0); PG8_MMA(1, 0, At, B0); PG8_BAR; PG8_SCHED;
            PG8_STAGE(PG8_SB(0, 1), b2 + hstep, voffB);
            PG8_WAIT_V(6); PG8_BAR; PG8_MMA(1, 1, At, B1); PG8_BAR;
            PG8_LDB(B0, 1, 0); PG8_SCHED; PG8_LDA(At, 1, 0); PG8_STAGE(PG8_SA(0, 1), a2 + hstepA, voffA);
            PG8_WAIT_L(8); PG8_BAR; PG8_WAIT_L(0); PG8_MMA(0, 0, At, B0); PG8_BAR; PG8_SCHED;
            PG8_LDB(B1, 1, 1); PG8_STAGE(PG8_SB(1, 0), b3, voffB);
            PG8_BAR; PG8_WAIT_L(0); PG8_MMA(0, 1, At, B1); PG8_BAR;
            PG8_LDA(At, 1, 1); PG8_STAGE(PG8_SA(1, 0), a3, voffA);
            PG8_BAR; PG8_WAIT_L(0); PG8_MMA(1, 0, At, B0); PG8_BAR; PG8_SCHED;
            PG8_STAGE(PG8_SB(1, 1), b3 + hstep, voffB);
            PG8_WAIT_V(6); PG8_BAR; PG8_MMA(1, 1, At, B1); PG8_BAR;
        }
        PG8_STAMP();
        if constexpr (!Epi::AFTER_DRAIN) { E(acc, cur, wr, wc, fr, fq); S.done(cur); }
        PG8_STAMP();
        if (!has_next) break;
#pragma unroll
        for (int a = 0; a < 2; ++a)
#pragma unroll
            for (int b = 0; b < 2; ++b)
#pragma unroll
                for (int m = 0; m < 4; ++m)
#pragma unroll
                    for (int n = 0; n < 2; ++n) acc[a][b][m][n] = (f32x4){0.f, 0.f, 0.f, 0.f};
        cur = nxt; cA = nA; cB = nB; ++ui;
    }
    PG8_WAIT_V(0);
    if (wr == 0) PG8_BAR;
    PG8_BAR;
    if constexpr (Epi::AFTER_DRAIN) { E.fused(acc, cur, wr, wc, fr, fq, lds, wid, lane); S.done(cur); }
    PG8_STAMP();
    if (STAMP && wid == 0) { stamps[lane] = lane < nts ? (((unsigned long long)(unsigned)ts_hi << 32) | (unsigned)ts_lo) : 0ull;
        if (lane == 62) stamps[62] = rt_entry; if (lane == 63) stamps[63] = (unsigned long long)wall_clock64(); }
#undef PG8_STAMP
#undef PG8_SA
#undef PG8_SB
#undef PG8_STAGE
#undef PG8_LDA
#undef PG8_LDB
#undef PG8_MMA
#undef PG8_WAIT_V
#undef PG8_WAIT_L
#undef PG8_BAR
#undef PG8_SCHED
}
}
using pg8::bf16_t; using pg8::bf16x8; using pg8::f32x4; using pg8::u32x4;
#define LAS __attribute__((address_space(3)))
typedef short s16x4 __attribute__((ext_vector_type(4)));
typedef float f32x16 __attribute__((ext_vector_type(16)));
typedef unsigned u32x2 __attribute__((ext_vector_type(2)));
typedef LAS unsigned char* ldsp;

constexpr int MT = 32768, DM = 1024, SEQ = 8192, DFF = 2816, NTHR = 512;
constexpr int LDS_BYTES = 155648;
constexpr float ALPHA = 1.6817928305074290f;
constexpr float LN_EPS = 1e-5f, RMS_EPS = 1e-6f;
constexpr size_t WL_F1IN = 0, WL_F1OUT = 11534336, WL_F2IN = 17301504, WL_F2OUT = 28835840, WL_MIX = 34603008, WL_SIZE = 49807360;
constexpr size_t WM_AIN = 0, WM_UK = 4194304, WM_UV = 4718592, WM_AOUT = 5242880;
constexpr size_t WM_SIN = 0, WM_SOUT = 11010048;
constexpr size_t WS_WL = 4096, WS_XB = WS_WL + WL_SIZE, WS_TMP = WS_XB + 67108864;
constexpr size_t T_H = 0;
constexpr size_t T_KW = 251658240;
constexpr size_t T_QB = 0, T_CKV = 117440512, T_CKVN = 150994944, T_IDX = 167772160, T_O = 184549376;
constexpr size_t T_ZX = 0, T_DT = 335544320, T_SSQ = 339738624;
constexpr size_t WS_END = WS_TMP + 348127232;
constexpr size_t WS_BCC = WS_END + 65536;
constexpr int QBLD = 1792, ZXLD = 5120;

struct Params {
    const float* in[20]; float* out; unsigned char* ws;
};

__device__ __forceinline__ int obx() { int b = blockIdx.x; asm volatile("" : "+s"(b)); return b; }
__device__ __forceinline__ int ogd() { int b = gridDim.x; asm volatile("" : "+s"(b)); return b; }
#define AS4 __attribute__((address_space(4)))
__device__ __forceinline__ Params load_params() {
    Params q; const AS4 unsigned long long* kp = (const AS4 unsigned long long*)__builtin_amdgcn_kernarg_segment_ptr(); asm volatile("" : "+s"(kp));
#pragma unroll
    for (int i = 0; i < 20; ++i) q.in[i] = (const float*)(const __attribute__((address_space(1))) float*)kp[i];
    q.out = (float*)(__attribute__((address_space(1))) float*)kp[20]; q.ws = (unsigned char*)(__attribute__((address_space(1))) unsigned char*)kp[21]; return q; }
__device__ __forceinline__ int otid() { int t = threadIdx.x; asm volatile("" : "+v"(t)); return t; }
__device__ __forceinline__ float bf2f(unsigned v) { return __uint_as_float(v << 16); }
__device__ __forceinline__ float bflo(unsigned v) { return __uint_as_float(v << 16); }
__device__ __forceinline__ float bfhi(unsigned v) { return __uint_as_float(v & 0xFFFF0000u); }
__device__ __forceinline__ unsigned pk2(float a, float b) { return pg8::cvt_pk_bf16(a, b); }
__device__ __forceinline__ float wave_sum(float v) {
#pragma unroll
    for (int d = 32; d >= 1; d >>= 1) v += __shfl_xor(v, d);
    return v;
}
__device__ __forceinline__ f32x4 mfma16(bf16x8 a, bf16x8 b, f32x4 c) { return __builtin_amdgcn_mfma_f32_16x16x32_bf16(a, b, c, 0, 0, 0); }
__device__ __forceinline__ bf16x8 ld_lds128(ldsp p) { return *(LAS const bf16x8*)p; }

__device__ __forceinline__ int map_col(int kind, int j, int nsrc) {
    if (kind == 0) return j < nsrc ? j : -1;
    if (kind == 1) { const int pn = j >> 8, bj = (j >> 7) & 1, i = j & 127; return bj * DFF + pn * 128 + i; }
    if (j < 1024) return j;
    if (j < 1536) return j - 1024 + 1280;
    if (j < 1600) return j - 1536 + 1792;
    if (j < 1608) return j - 1600 + 1856;
    if (j < 1792) return -1;
    return j - 1792 + 1024;
}
__device__ __forceinline__ void conv_job(ldsp lds, const float* src0, bf16_t* dst0, int K, int nsrc, int ndst, int kind, const float* kscale, int nb = 1) {
    LAS float* tile = (LAS float*)lds;
    const int tid = otid(), ntk = K >> 6, ntm = (ndst >> 6) * ntk, ntiles = ntm * nb, G = ogd();
    for (int t0 = obx(); t0 < ntiles; t0 += 4 * G) {
        float v[4][8];
#pragma unroll
        for (int s = 0; s < 4; ++s) { const int t = t0 + s * G; const bool on = t < ntiles; const int tt = on ? t : t0; const int mb = tt / ntm, tm = tt - mb * ntm; const int j0 = (tm / ntk) << 6, k0 = (tm % ntk) << 6; const float* src = src0 + (size_t)mb * K * nsrc;
#pragma unroll
            for (int e = 0; e < 8; ++e) { const int idx = tid + e * NTHR, kk = idx >> 6, jj = idx & 63; const int c = map_col(kind, j0 + jj, nsrc);
                float x = (on && c >= 0) ? src[(size_t)(k0 + kk) * nsrc + c] : 0.f; if (kscale) x *= kscale[k0 + kk]; v[s][e] = x; } }
#pragma unroll
        for (int s = 0; s < 4; ++s)
#pragma unroll
            for (int e = 0; e < 8; ++e) { const int idx = tid + e * NTHR, kk = idx >> 6, jj = idx & 63; tile[s * 4160 + kk * 65 + jj] = v[s][e]; }
        __syncthreads();
#pragma unroll
        for (int s = 0; s < 4; ++s) { const int t = t0 + s * G;
            if (t < ntiles) { const int mb = t / ntm, tm = t - mb * ntm; const int j0 = (tm / ntk) << 6, k0 = (tm % ntk) << 6; bf16_t* dst = dst0 + (size_t)mb * ndst * K; const int jj = tid >> 3, kc = tid & 7; LAS const float* tl = tile + s * 4160; u32x4 w;
                w.x = pk2(tl[(kc * 8 + 0) * 65 + jj], tl[(kc * 8 + 1) * 65 + jj]); w.y = pk2(tl[(kc * 8 + 2) * 65 + jj], tl[(kc * 8 + 3) * 65 + jj]);
                w.z = pk2(tl[(kc * 8 + 4) * 65 + jj], tl[(kc * 8 + 5) * 65 + jj]); w.w = pk2(tl[(kc * 8 + 6) * 65 + jj], tl[(kc * 8 + 7) * 65 + jj]);
                *(u32x4*)(dst + (size_t)(j0 + jj) * K + k0 + kc * 8) = w; } }
        __syncthreads();
    }
}
__device__ __forceinline__ void convert_layer(ldsp lds, const Params& p, int L) {
    unsigned char* wl = p.ws + WS_WL;
    conv_job(lds, p.in[3] + (size_t)L * 1024 * 5632, (bf16_t*)(wl + WL_F1IN), 1024, 5632, 5632, 1, nullptr);
    conv_job(lds, p.in[4] + (size_t)L * 2816 * 1024, (bf16_t*)(wl + WL_F1OUT), 2816, 1024, 1024, 0, nullptr);
    conv_job(lds, p.in[5] + (size_t)L * 1024 * 5632, (bf16_t*)(wl + WL_F2IN), 1024, 5632, 5632, 1, nullptr);
    conv_job(lds, p.in[6] + (size_t)L * 2816 * 1024, (bf16_t*)(wl + WL_F2OUT), 2816, 1024, 1024, 0, nullptr);
    const int j = L >> 1;
    if ((L & 1) == 0) {
        conv_job(lds, p.in[7] + (size_t)j * 1024 * 1864, (bf16_t*)(wl + WL_MIX + WM_AIN), 1024, 1864, 2048, 2, nullptr);
        conv_job(lds, p.in[9] + (size_t)j * 16 * 64 * 256, (bf16_t*)(wl + WL_MIX + WM_UK), 64, 256, 256, 0, nullptr, 16);
        conv_job(lds, p.in[10] + (size_t)j * 16 * 256 * 64, (bf16_t*)(wl + WL_MIX + WM_UV), 256, 64, 64, 0, nullptr, 16);
        conv_job(lds, p.in[11] + (size_t)j * 1024 * 1024, (bf16_t*)(wl + WL_MIX + WM_AOUT), 1024, 1024, 1024, 0, nullptr);
    } else {
        conv_job(lds, p.in[12] + (size_t)j * 1024 * 5152, (bf16_t*)(wl + WL_MIX + WM_SIN), 1024, 5152, 5376, 0, nullptr);
        conv_job(lds, p.in[19] + (size_t)j * 2048 * 1024, (bf16_t*)(wl + WL_MIX + WM_SOUT), 2048, 1024, 1024, 0, p.in[18] + (size_t)j * 2048);
    }
}

template <bool DRY>
__device__ __forceinline__ void ln_phase(float* x, bf16_t* xb, const float* g, const float* b, unsigned char* dummy, bool write_f32) {
    const int tid_ = otid(); const int lane = tid_ & 63, gw = obx() * 8 + (tid_ >> 6), nw = ogd() * 8;
    for (int row0 = gw; row0 < MT; row0 += 4 * nw) {
        f32x4 v[4][4]; float s[4];
#pragma unroll
        for (int r = 0; r < 4; ++r) { const int row = row0 + r * nw; const bf16_t* xr = xb + (size_t)(row < MT ? row : row0) * DM; s[r] = 0.f;
#pragma unroll
            for (int i = 0; i < 4; ++i) { const u32x2 w = *(const u32x2*)(xr + i * 256 + lane * 4); v[r][i][0] = bflo(w.x); v[r][i][1] = bfhi(w.x); v[r][i][2] = bflo(w.y); v[r][i][3] = bfhi(w.y); } }
#pragma unroll
        for (int r = 0; r < 4; ++r) {
#pragma unroll
            for (int i = 0; i < 4; ++i) s[r] += v[r][i][0] + v[r][i][1] + v[r][i][2] + v[r][i][3];
            s[r] = wave_sum(s[r]) * (1.0f / DM); }
        float q[4];
#pragma unroll
        for (int r = 0; r < 4; ++r) { q[r] = 0.f;
#pragma unroll
            for (int i = 0; i < 4; ++i) { v[r][i] = v[r][i] - s[r]; q[r] += v[r][i][0] * v[r][i][0] + v[r][i][1] * v[r][i][1] + v[r][i][2] * v[r][i][2] + v[r][i][3] * v[r][i][3]; }
            q[r] = rsqrtf(wave_sum(q[r]) * (1.0f / DM) + LN_EPS); }
#pragma unroll
        for (int i = 0; i < 4; ++i) { const int c = i * 256 + lane * 4; const f32x4 gg = *(const f32x4*)(g + c), bb = *(const f32x4*)(b + c);
#pragma unroll
            for (int r = 0; r < 4; ++r) { const int row = row0 + r * nw;
                if (row < MT) { const f32x4 o = v[r][i] * q[r] * gg + bb; u32x2 w; w.x = pk2(o[0], o[1]); w.y = pk2(o[2], o[3]);
                    if (write_f32) *(f32x4*)(x + (size_t)row * DM + c) = o;
                    if (!write_f32) *(u32x2*)(xb + (size_t)row * DM + c) = w; } } }
    }
}
__device__ __forceinline__ void cvt_x_phase(const float* x, bf16_t* xb) {
    const size_t n8 = (size_t)MT * DM / 8, stride = (size_t)ogd() * NTHR;
    for (size_t i0 = (size_t)obx() * NTHR + otid(); i0 < n8; i0 += 4 * stride) {
        f32x4 a[4], b[4];
#pragma unroll
        for (int s = 0; s < 4; ++s) { const size_t i = i0 + s * stride; const size_t ii = i < n8 ? i : i0; a[s] = *(const f32x4*)(x + ii * 8); b[s] = *(const f32x4*)(x + ii * 8 + 4); }
#pragma unroll
        for (int s = 0; s < 4; ++s) { const size_t i = i0 + s * stride;
            if (i < n8) { u32x4 w; w.x = pk2(a[s][0], a[s][1]); w.y = pk2(a[s][2], a[s][3]); w.z = pk2(b[s][0], b[s][1]); w.w = pk2(b[s][2], b[s][3]); *(u32x4*)(xb + i * 8) = w; } }
    }
}

__device__ __forceinline__ void ckv_norm_phase(const float* ckv, bf16_t* ckvn, const float* g) {
    const int tid_ = otid(); const int lane = tid_ & 63, gw = obx() * 8 + (tid_ >> 6), nw = ogd() * 8;
    const f32x4 gg = *(const f32x4*)(g + lane * 4);
    for (int row0 = gw; row0 < MT; row0 += 4 * nw) {
        f32x4 v[4];
#pragma unroll
        for (int r = 0; r < 4; ++r) { const int row = row0 + r * nw; v[r] = *(const f32x4*)(ckv + (size_t)(row < MT ? row : row0) * 256 + lane * 4); }
#pragma unroll
        for (int r = 0; r < 4; ++r) { const int row = row0 + r * nw;
            const float ms = wave_sum(v[r][0] * v[r][0] + v[r][1] * v[r][1] + v[r][2] * v[r][2] + v[r][3] * v[r][3]) * (1.0f / 256.0f);
            const float rs = rsqrtf(ms + RMS_EPS); const f32x4 o = v[r] * rs * gg; u32x2 w; w.x = pk2(o[0], o[1]); w.y = pk2(o[2], o[3]);
            if (row < MT) *(u32x2*)(ckvn + (size_t)row * 256 + lane * 4) = w; }
    }
}

__device__ __forceinline__ unsigned f2key(float s) { const unsigned u = __float_as_uint(s); return (u & 0x80000000u) ? ~u : (u | 0x80000000u); }
__device__ __forceinline__ void find_bin(ldsp hq, unsigned need, unsigned& bin, unsigned& newneed) {
    const int lane = otid() & 63;
    u32x4 w[4];
#pragma unroll
    for (int i = 0; i < 4; ++i) w[i] = *(LAS const u32x4*)(hq + lane * 64 + i * 16);
    unsigned sum = 0;
#pragma unroll
    for (int i = 0; i < 4; ++i)
#pragma unroll
        for (int k = 0; k < 4; ++k) sum += (w[i][k] & 0xFFFFu) + (w[i][k] >> 16);
    unsigned suf = sum;
#pragma unroll
    for (int d = 1; d < 64; d <<= 1) { const unsigned t = __shfl_down(suf, d); if (lane + d < 64) suf += t; }
    const unsigned above = suf - sum;
    const bool mine = (above < need) && (need <= suf);
    unsigned cum = above, fb = 0, fn = 0; bool found = false;
#pragma unroll
    for (int i = 3; i >= 0; --i)
#pragma unroll
        for (int k = 3; k >= 0; --k) {
            const unsigned hi16 = w[i][k] >> 16, lo16 = w[i][k] & 0xFFFFu; const int wi = i * 4 + k;
            if (!found && cum + hi16 >= need) { fb = lane * 32 + wi * 2 + 1; fn = need - cum; found = true; } cum += hi16;
            if (!found && cum + lo16 >= need) { fb = lane * 32 + wi * 2; fn = need - cum; found = true; } cum += lo16; }
    const unsigned long long bal = __ballot(mine);
    const int src = bal ? (int)__builtin_ctzll(bal) : 0;
    bin = __shfl(fb, src); newneed = __shfl(fn, src);
}

__device__ __forceinline__ void indexer_item(ldsp lds, const bf16_t* QB, unsigned short* IDX, int b, int qt) {
    const int tid = otid(), lane = tid & 63, wid = tid >> 6, c = lane & 31, hi = lane >> 5;
    const int q0 = qt * 32; const size_t tb = (size_t)b * SEQ;
    const int posb = q0 + 4 * wid + 2 * hi;
#ifdef IDX_SIMPLE
    if (true) {
#else
    if (q0 < 256) {
#endif
        for (int tq = 0; tq < 4; ++tq) { const int pos = q0 + 4 * wid + tq; unsigned short* o = IDX + (tb + pos) * 256;
#pragma unroll
            for (int k = 0; k < 4; ++k) { const int j = lane * 4 + k; o[j] = (unsigned short)(j <= pos ? j : 0xFFFF); } }
        return;
    }
    ldsp hist = lds + wid * 16384;
    ldsp kbuf = lds + 131072;
    bf16x8 af[4];
    { const int r = c, tk = ((r >> 2) & 1) * 2 + (r & 1), hd = (r >> 3) * 2 + ((r >> 1) & 1);
      const bf16_t* qp = QB + (tb + q0 + 4 * wid + tk) * QBLD + 1024 + hd * 64 + hi * 8;
#pragma unroll
      for (int ks = 0; ks < 4; ++ks) af[ks] = *(const bf16x8*)(qp + ks * 16); }
    float wq[2][8];
#pragma unroll
    for (int e = 0; e < 2; ++e) { const u32x4 wv = *(const u32x4*)(QB + T_KW / 2 + (tb + posb + e) * 128 + 64);
#pragma unroll
        for (int k = 0; k < 4; ++k) { wq[e][2 * k] = bflo(wv[k]) * 0.04419417382415922f; wq[e][2 * k + 1] = bfhi(wv[k]) * 0.04419417382415922f; } }
    const int nch = (q0 + 32 + 63) >> 6;
    const bf16_t* KW = QB + T_KW / 2;
    const bf16_t* kg = KW + (tb + (tid >> 3)) * 128 + (tid & 7) * 8;
    const int kst = (tid >> 3) * 144 + (tid & 7) * 16;
    unsigned pre[2] = {0u, 0u}, need[2] = {256u, 256u};
    unsigned cnt[2] = {0u, 0u}, tie[2] = {0u, 0u};
    for (int pass = 0; pass < 4; ++pass) {
        if (pass < 3) {
#pragma unroll
            for (int i = 0; i < 16; ++i) *(LAS u32x4*)(hist + i * 1024 + lane * 16) = (u32x4){0u, 0u, 0u, 0u};
        }
        __syncthreads();
        u32x4 kr = *(const u32x4*)kg;
        *(LAS u32x4*)(kbuf + kst) = kr;
        __syncthreads();
        for (int ch = 0; ch < nch; ++ch) {
            if (ch + 1 < nch) kr = *(const u32x4*)(kg + (size_t)(ch + 1) * 64 * 128);
            ldsp kb = kbuf + (ch & 1) * 9216;
#pragma unroll
            for (int ts = 0; ts < 2; ++ts) {
                f32x16 acc;
#pragma unroll
                for (int i = 0; i < 16; ++i) acc[i] = 0.f;
#pragma unroll
                for (int ks = 0; ks < 4; ++ks) { const bf16x8 bf = ld_lds128(kb + (ts * 32 + c) * 144 + ks * 32 + hi * 16); acc = __builtin_amdgcn_mfma_f32_32x32x16_bf16(af[ks], bf, acc, 0, 0, 0); }
                const int key = ch * 64 + ts * 32 + c;
#pragma unroll
                for (int e = 0; e < 2; ++e) {
                    float s = 0.f;
#pragma unroll
                    for (int h = 0; h < 8; ++h) s = fmaf(wq[e][h], fmaxf(acc[2 * h + e], 0.f), s);
                    s += 0.0f;
                    const unsigned u = f2key(s); const bool valid = key <= posb + e;
                    if (pass == 0) { if (valid) { const unsigned bin = u >> 21; __hip_atomic_fetch_add((LAS unsigned*)(hist + (2 * hi + e) * 4096 + (bin >> 1) * 4), 1u << ((bin & 1) * 16), __ATOMIC_RELAXED, __HIP_MEMORY_SCOPE_WORKGROUP); } }
                    else if (pass == 1) { if (valid && (u >> 21) == pre[e]) { const unsigned bin = (u >> 10) & 0x7FFu; __hip_atomic_fetch_add((LAS unsigned*)(hist + (2 * hi + e) * 4096 + (bin >> 1) * 4), 1u << ((bin & 1) * 16), __ATOMIC_RELAXED, __HIP_MEMORY_SCOPE_WORKGROUP); } }
                    else if (pass == 2) { if (valid && (u >> 10) == pre[e]) { const unsigned bin = u & 0x3FFu; __hip_atomic_fetch_add((LAS unsigned*)(hist + (2 * hi + e) * 4096 + (bin >> 1) * 4), 1u << ((bin & 1) * 16), __ATOMIC_RELAXED, __HIP_MEMORY_SCOPE_WORKGROUP); } }
                    else {
                        const bool gt = valid && (u > pre[e]), eq = valid && (u == pre[e]);
                        const unsigned long long beq = __ballot(eq); const unsigned meq = hi ? (unsigned)(beq >> 32) : (unsigned)beq;
                        const unsigned below = (1u << c) - 1u;
                        const bool emit = gt || (eq && (tie[e] + __popc(meq & below) < need[e]));
                        tie[e] += __popc(meq);
                        const unsigned long long bem = __ballot(emit); const unsigned mem = hi ? (unsigned)(bem >> 32) : (unsigned)bem;
                        const unsigned slot = cnt[e] + __popc(mem & below);
                        if (emit && slot < 256u) IDX[(tb + posb + e) * 256 + slot] = (unsigned short)key;
                        cnt[e] += __popc(mem);
                    }
                }
            }
            if (ch + 1 < nch) *(LAS u32x4*)(kbuf + ((ch + 1) & 1) * 9216 + kst) = kr;
            __syncthreads();
        }
        if (pass < 3) {
            unsigned nb[4], nn[4];
#pragma unroll
            for (int tq = 0; tq < 4; ++tq) {
                const unsigned nd = __shfl(need[tq & 1], (tq >> 1) * 32);
                find_bin(hist + tq * 4096, nd, nb[tq], nn[tq]); }
#pragma unroll
            for (int e = 0; e < 2; ++e) { const unsigned bsel = hi ? nb[2 + e] : nb[e], nsel = hi ? nn[2 + e] : nn[e];
                pre[e] = (pass == 0) ? bsel : (pass == 1 ? ((pre[e] << 11) | bsel) : ((pre[e] << 10) | bsel)); need[e] = nsel; }
        }
    }
}
__device__ __forceinline__ void find_bin1k(ldsp hq, unsigned need, unsigned& bin, unsigned& newneed) {
    const int lane = otid() & 63;
    u32x4 w[2];
#pragma unroll
    for (int i = 0; i < 2; ++i) w[i] = *(LAS const u32x4*)(hq + lane * 32 + i * 16);
    unsigned sum = 0;
#pragma unroll
    for (int i = 0; i < 2; ++i)
#pragma unroll
        for (int k = 0; k < 4; ++k) sum += (w[i][k] & 0xFFFFu) + (w[i][k] >> 16);
    unsigned suf = sum;
#pragma unroll
    for (int d = 1; d < 64; d <<= 1) { const unsigned t = __shfl_down(suf, d); if (lane + d < 64) suf += t; }
    const unsigned above = suf - sum;
    const bool mine = (above < need) && (need <= suf);
    unsigned cum = above, fb = 0, fn = 0; bool found = false;
#pragma unroll
    for (int i = 1; i >= 0; --i)
#pragma unroll
        for (int k = 3; k >= 0; --k) {
            const unsigned hi16 = w[i][k] >> 16, lo16 = w[i][k] & 0xFFFFu; const int wi = i * 4 + k;
            if (!found && cum + hi16 >= need) { fb = lane * 16 + wi * 2 + 1; fn = need - cum; found = true; } cum += hi16;
            if (!found && cum + lo16 >= need) { fb = lane * 16 + wi * 2; fn = need - cum; found = true; } cum += lo16; }
    const unsigned long long bal = __ballot(mine);
    const int src = bal ? (int)__builtin_ctzll(bal) : 0;
    bin = __shfl(fb, src); newneed = __shfl(fn, src);
}
struct IdxState { bf16x8 af[4]; float wq[2][8], bsc[2], bof[2]; unsigned tbin[2], cnt[2], ccnt[2]; };
template <int PASS>
__device__ __forceinline__ void idx_update(float sv, unsigned bin, int e, int key, IdxState& st, ldsp hist, ldsp cand, ldsp ctrs, unsigned short* IDX, size_t tb, int posb, int hi) {
    const bool valid = key <= posb + e;
    if (PASS == 2) { if (valid && sv == 123456.789f) IDX[(tb + posb + e) * 256] = (unsigned short)bin; }
    else if (PASS == 0) { __hip_atomic_fetch_add((LAS unsigned*)(hist + (2 * hi + e) * 2048 + (bin >> 1) * 4), valid ? (1u << ((bin & 1) * 16)) : 0u, __ATOMIC_RELAXED, __HIP_MEMORY_SCOPE_WORKGROUP); }
    else if (valid && bin >= st.tbin[e]) {
        LAS unsigned* ctr = (LAS unsigned*)(ctrs + (2 * hi + e) * 8);
        if (bin > st.tbin[e]) { const unsigned slot = __hip_atomic_fetch_add(ctr, 1u, __ATOMIC_RELAXED, __HIP_MEMORY_SCOPE_WORKGROUP);
            if (slot < 256u) IDX[(tb + posb + e) * 256 + slot] = (unsigned short)key; }
        else { const unsigned cp = __hip_atomic_fetch_add(ctr + 1, 1u, __ATOMIC_RELAXED, __HIP_MEMORY_SCOPE_WORKGROUP);
            if (cp < 256u) { u32x2 cv; cv.x = f2key(sv); cv.y = (unsigned)key; *(LAS u32x2*)(cand + ((2 * hi + e) * 256 + cp) * 8) = cv; } }
    }
}
__device__ __forceinline__ void idx_mfma(ldsp kb, const IdxState& st, f32x16 (&acc)[4]) {
#pragma unroll
    for (int tl = 0; tl < 4; ++tl)
#pragma unroll
        for (int i = 0; i < 16; ++i) acc[tl][i] = 0.f;
#pragma unroll
    for (int tp = 0; tp < 2; ++tp) { bf16x8 b0[4], b1[4];
#pragma unroll
        for (int ks = 0; ks < 4; ++ks) { b0[ks] = ld_lds128(kb + (2 * tp) * 32 * 144 + ks * 32); b1[ks] = ld_lds128(kb + (2 * tp + 1) * 32 * 144 + ks * 32); }
#pragma unroll
        for (int ks = 0; ks < 4; ++ks) { acc[2 * tp] = __builtin_amdgcn_mfma_f32_32x32x16_bf16(st.af[ks], b0[ks], acc[2 * tp], 0, 0, 0); acc[2 * tp + 1] = __builtin_amdgcn_mfma_f32_32x32x16_bf16(st.af[ks], b1[ks], acc[2 * tp + 1], 0, 0, 0); } }
}
template <int PASS>
__device__ __forceinline__ void idx_pass(ldsp lds, IdxState& st, const bf16_t* kg, unsigned short* IDX, size_t tb, int q0, int posb, int wid, int c, int hi, int kst, int nch) {
    ldsp hist = lds + wid * 8192; ldsp cand = hist; ldsp ctrs = lds + 65536 + wid * 32; ldsp kbuf = lds + 81920; const int lo = c * 144 + hi * 16;
    __syncthreads();
    u32x4 kr0 = *(const u32x4*)kg, kr1 = *(const u32x4*)(kg + (size_t)64 * 128);
    *(LAS u32x4*)(kbuf + kst) = kr0; *(LAS u32x4*)(kbuf + 9216 + kst) = kr1;
    if (1 < nch) { kr0 = *(const u32x4*)(kg + (size_t)128 * 128); kr1 = *(const u32x4*)(kg + (size_t)(128 + 64) * 128); *(LAS u32x4*)(kbuf + 18432 + kst) = kr0; *(LAS u32x4*)(kbuf + 18432 + 9216 + kst) = kr1; }
    u32x4 kn0 = kr0, kn1 = kr1;
    if (2 < nch) { kr0 = *(const u32x4*)(kg + (size_t)256 * 128); kr1 = *(const u32x4*)(kg + (size_t)(256 + 64) * 128); }
    if (3 < nch) { kn0 = *(const u32x4*)(kg + (size_t)384 * 128); kn1 = *(const u32x4*)(kg + (size_t)(384 + 64) * 128); }
    __syncthreads();
    f32x16 accA[4], accB[4];
    idx_mfma(kbuf + lo, st, accA);
    int bcur = 0;
#define IDX_STEP(CH, CUR, NXT) do { const int ch_ = (CH); const int bn = bcur == 2 ? 0 : bcur + 1, bw = bn == 2 ? 0 : bn + 1; \
        ldsp kb_ = kbuf + bn * 18432 + lo; float sv_[4][2]; unsigned bin_[4][2]; \
          \
        _Pragma("unroll") for (int tl = 0; tl < 4; ++tl) _Pragma("unroll") for (int i = 0; i < 16; ++i) NXT[tl][i] = 0.f; \
        _Pragma("unroll") for (int ks = 0; ks < 4; ++ks) { \
            bf16x8 f0 = ld_lds128(kb_ + ks * 32), f1 = ld_lds128(kb_ + 4608 + ks * 32), f2 = ld_lds128(kb_ + 9216 + ks * 32), f3 = ld_lds128(kb_ + 13824 + ks * 32); \
            NXT[0] = __builtin_amdgcn_mfma_f32_32x32x16_bf16(st.af[ks], f0, NXT[0], 0, 0, 0); NXT[1] = __builtin_amdgcn_mfma_f32_32x32x16_bf16(st.af[ks], f1, NXT[1], 0, 0, 0); \
            NXT[2] = __builtin_amdgcn_mfma_f32_32x32x16_bf16(st.af[ks], f2, NXT[2], 0, 0, 0); NXT[3] = __builtin_amdgcn_mfma_f32_32x32x16_bf16(st.af[ks], f3, NXT[3], 0, 0, 0); \
            { const int tl = ks;                                     \
              _Pragma("unroll") for (int e = 0; e < 2; ++e) { float s = 0.f; \
                  _Pragma("unroll") for (int h = 0; h < 8; ++h) s = fmaf(st.wq[e][h], __builtin_amdgcn_fmed3f(CUR[tl][2 * h + e], 0.f, 3.0e38f), s); \
                  sv_[tl][e] = s + 0.0f; bin_[tl][e] = (unsigned)__builtin_amdgcn_fmed3f(fmaf(sv_[tl][e], st.bsc[e], st.bof[e]), 0.f, 1023.f); } } } \
        _Pragma("unroll") for (int i = 0; i < 16; ++i) { __builtin_amdgcn_sched_group_barrier(0x008, 1, 0); __builtin_amdgcn_sched_group_barrier(0x002, 9, 0); } \
          \
        _Pragma("unroll") for (int tl = 0; tl < 4; ++tl) { \
            _Pragma("unroll") for (int e = 0; e < 2; ++e) idx_update<PASS>(sv_[tl][e], bin_[tl][e], e, ch_ * 128 + tl * 32 + c, st, hist, cand, ctrs, IDX, tb, posb, hi); } \
        if (ch_ + 2 < nch) { *(LAS u32x4*)(kbuf + bw * 18432 + kst) = kr0; *(LAS u32x4*)(kbuf + bw * 18432 + 9216 + kst) = kr1; } \
        kr0 = kn0; kr1 = kn1; \
        if (ch_ + 4 < nch) { kn0 = *(const u32x4*)(kg + (size_t)(ch_ + 4) * 128 * 128); kn1 = *(const u32x4*)(kg + (size_t)((ch_ + 4) * 128 + 64) * 128); } \
        bcur = bn; __syncthreads(); } while (0)
#pragma unroll 1
    for (int ch = 0; ch < nch; ch += 2) {
        IDX_STEP(ch, accA, accB);
        if (ch + 1 < nch) IDX_STEP(ch + 1, accB, accA);
    }
#undef IDX_STEP
}
__device__ __forceinline__ int indexer_item_fast(ldsp lds, const bf16_t* QB, unsigned short* IDX, int b, int qt) {
    const int tid = otid(), lane = tid & 63, wid = tid >> 6, c = lane & 31, hi = lane >> 5;
    const int q0 = qt * 32; const size_t tb = (size_t)b * SEQ;
    const int posb = q0 + 4 * wid + 2 * hi;
    ldsp hist = lds + wid * 8192;
    ldsp cand = hist;
    ldsp ctrs = lds + 65536 + wid * 32;
    IdxState st;
    { const int r = c, tk = ((r >> 2) & 1) * 2 + (r & 1), hd = (r >> 3) * 2 + ((r >> 1) & 1);
      const bf16_t* qp = QB + (tb + q0 + 4 * wid + tk) * QBLD + 1024 + hd * 64 + hi * 8;
#pragma unroll
      for (int ks = 0; ks < 4; ++ks) st.af[ks] = *(const bf16x8*)(qp + ks * 16); }
#pragma unroll
    for (int e = 0; e < 2; ++e) { const u32x4 wv = *(const u32x4*)(QB + T_KW / 2 + (tb + posb + e) * 128 + 64); float sw = 0.f, sw2 = 0.f;
#pragma unroll
        for (int k = 0; k < 4; ++k) { st.wq[e][2 * k] = bflo(wv[k]) * 0.04419417382415922f; st.wq[e][2 * k + 1] = bfhi(wv[k]) * 0.04419417382415922f; }
#pragma unroll
        for (int h = 0; h < 8; ++h) { sw += st.wq[e][h]; sw2 += st.wq[e][h] * st.wq[e][h]; }
        const float mu = sw * 3.1915382f, sg = sqrtf(sw2 * 21.81f) + 1e-20f;
        st.bsc[e] = 128.0f / sg; st.bof[e] = 256.0f - mu * st.bsc[e];
        st.tbin[e] = 0u; st.cnt[e] = 0u; st.ccnt[e] = 0u; }
    const int nch = (q0 + 32 + 127) >> 7;
    const bf16_t* kg = QB + T_KW / 2 + (tb + (tid >> 3)) * 128 + (tid & 7) * 8;
    const int kst = (tid >> 3) * 144 + (tid & 7) * 16;
#pragma unroll
    for (int i = 0; i < 8; ++i) *(LAS u32x4*)(hist + i * 1024 + lane * 16) = (u32x4){0u, 0u, 0u, 0u};
#ifdef DUMMY_PASS
    idx_pass<2>(lds, st, kg, IDX, tb, q0, posb, wid, c, hi, kst, nch);
#endif
    idx_pass<0>(lds, st, kg, IDX, tb, q0, posb, wid, c, hi, kst, nch);
    unsigned need[2];
    { unsigned nb[4], nn[4];
#pragma unroll
      for (int tq = 0; tq < 4; ++tq) find_bin1k(hist + tq * 2048, 256u, nb[tq], nn[tq]);
#pragma unroll
      for (int e = 0; e < 2; ++e) { st.tbin[e] = hi ? nb[2 + e] : nb[e]; need[e] = hi ? nn[2 + e] : nn[e]; } }
    if (lane < 8) *(LAS unsigned*)(ctrs + lane * 4) = 0u;
    idx_pass<1>(lds, st, kg, IDX, tb, q0, posb, wid, c, hi, kst, nch);
    int ovf = 0;
#pragma unroll 1
    for (int tq = 0; tq < 4; ++tq) {
        const unsigned base = *(LAS const unsigned*)(ctrs + tq * 8), n = *(LAS const unsigned*)(ctrs + tq * 8 + 4);
        const unsigned nd = __shfl(need[tq & 1], (tq >> 1) * 32);
        if (n > 256u) { ovf = 1; }
        else {
#pragma unroll 1
            for (unsigned g0 = 0; g0 < n; g0 += 64) {
                const unsigned ci = g0 + lane;
                const u32x2 mine = ci < n ? *(LAS const u32x2*)(cand + (tq * 256 + ci) * 8) : (u32x2){0u, 0u};
                unsigned rank = 0;
                for (unsigned j = 0; j < n; ++j) { const u32x2 o = *(LAS const u32x2*)(cand + (tq * 256 + j) * 8); rank += (o.x > mine.x || (o.x == mine.x && o.y < mine.y)) ? 1u : 0u; }
                if (ci < n && rank < nd && base + rank < 256u) IDX[(tb + q0 + 4 * wid + tq) * 256 + base + rank] = (unsigned short)mine.y;
            }
        }
    }
    return __syncthreads_or(ovf);
}
__device__ __forceinline__ void indexer_phase(ldsp lds, const Params& p) {
    const bf16_t* QB = (const bf16_t*)(p.ws + WS_TMP + T_QB); unsigned short* IDX = (unsigned short*)(p.ws + WS_TMP + T_IDX);
    for (int s = obx(); s < 256; s += ogd()) {
        int b = s >> 6, j = s & 63;
        if (ogd() == 256) { b = (s & 7) >> 1; j = (s >> 3) * 2 + (s & 1); }
#pragma unroll 1
        for (int k = 0; k < 4; ++k) {
            const int qt = k == 0 ? 255 - j : (k == 1 ? 128 + j : (k == 2 ? 127 - j : j));
#ifndef IDX_SLOW
            if (qt * 32 >= 256) { if (indexer_item_fast(lds, QB, IDX, b, qt)) { indexer_item(lds, QB, IDX, b, qt); __syncthreads(); } }
            else
#endif
            { indexer_item(lds, QB, IDX, b, qt); __syncthreads(); }
        }
    }
}

__device__ __forceinline__ s16x4 tr_read(ldsp p) { typedef short v4i16_t __attribute__((ext_vector_type(4))); return __builtin_bit_cast(s16x4, __builtin_amdgcn_ds_read_tr16_b64_v4i16((LAS v4i16_t*)p)); }
constexpr int XS = 528, CS = 544;
__device__ __forceinline__ void sattn_step(ldsp lds, const Params& p, int b, int si) {
    const int tid = otid(), lane = tid & 63, wid = tid >> 6, fr = lane & 15, g = lane >> 4;
    const bf16_t* QB = (const bf16_t*)(p.ws + WS_TMP + T_QB); const bf16_t* CKVN = (const bf16_t*)(p.ws + WS_TMP + T_CKVN);
    const unsigned short* IDX = (const unsigned short*)(p.ws + WS_TMP + T_IDX); bf16_t* O = (bf16_t*)(p.ws + WS_TMP + T_O);
    const bf16_t* WUK = (const bf16_t*)(p.ws + WS_WL + WL_MIX + WM_UK); const bf16_t* WUV = (const bf16_t*)(p.ws + WS_WL + WL_MIX + WM_UV);
    const size_t tb = (size_t)b * SEQ; const int p0 = si * 16; const size_t t0 = tb + p0;
    ldsp X = lds; ldsp Cw = lds + wid * (32 * CS); ldsp IL = lds + 8 * 32 * CS + wid * 1024;
#pragma unroll 1
    for (int hh = 0; hh < 2; ++hh) { const int h = wid * 2 + hh;
        bf16x8 bq[2]; { const bf16_t* qp = QB + (t0 + fr) * QBLD + h * 64 + g * 8; bq[0] = *(const bf16x8*)qp; bq[1] = *(const bf16x8*)(qp + 32); }
#pragma unroll 16
        for (int rt = 0; rt < 16; ++rt) {
            const bf16_t* wp = WUK + ((size_t)(h * 256 + rt * 16 + fr)) * 64 + g * 8;
            f32x4 acc = {0.f, 0.f, 0.f, 0.f};
            acc = mfma16(*(const bf16x8*)wp, bq[0], acc); acc = mfma16(*(const bf16x8*)(wp + 32), bq[1], acc);
            u32x2 w; w.x = pk2(acc[0], acc[1]); w.y = pk2(acc[2], acc[3]); *(LAS u32x2*)(X + (fr * 16 + h) * XS + (rt * 16 + 4 * g) * 2) = w; } }
    { const u32x2 iv0 = *(const u32x2*)(IDX + (t0 + wid) * 256 + lane * 4), iv1 = *(const u32x2*)(IDX + (t0 + wid + 8) * 256 + lane * 4);
      *(LAS u32x2*)(IL + lane * 8) = iv0; *(LAS u32x2*)(IL + 512 + lane * 8) = iv1; }
    __syncthreads();
    bf16x8 qa[8], qb[8];
#pragma unroll
    for (int ks = 0; ks < 8; ++ks) { qa[ks] = ld_lds128(X + (wid * 16 + fr) * XS + ks * 64 + g * 16); qb[ks] = ld_lds128(X + ((wid + 8) * 16 + fr) * XS + ks * 64 + g * 16); }
    __syncthreads();
    u32x2 olat[2][16];
#pragma unroll 1
    for (int tk = 0; tk < 2; ++tk) {
        const int pos = p0 + wid + 8 * tk; ldsp ILt = IL + tk * 512;
        f32x4 o[16];
#pragma unroll
        for (int i = 0; i < 16; ++i) o[i] = (f32x4){0.f, 0.f, 0.f, 0.f};
        float mrun = -INFINITY, lsum = 0.f;
#pragma unroll 2
        for (int kt = 0; kt < 8; ++kt) {
#pragma unroll
            for (int hf = 0; hf < 2; ++hf) { u32x4 gv[8];
#pragma unroll
              for (int i = 0; i < 8; ++i) { const int row = (hf * 8 + i) * 2 + (lane >> 5); const int key = *(LAS const unsigned short*)(ILt + (kt * 32 + row) * 2);
                  const int kc = key <= pos ? key : 0; gv[i] = *(const u32x4*)(CKVN + (tb + kc) * 256 + (lane & 31) * 8); }
#pragma unroll
              for (int i = 0; i < 8; ++i) { const int row = (hf * 8 + i) * 2 + (lane >> 5); *(LAS u32x4*)(Cw + row * CS + (lane & 31) * 16) = gv[i]; }
              __builtin_amdgcn_sched_barrier(0); }
            f32x4 s0 = {0.f, 0.f, 0.f, 0.f}, s1 = {0.f, 0.f, 0.f, 0.f};
#pragma unroll
            for (int ks = 0; ks < 8; ++ks) { s0 = mfma16(ld_lds128(Cw + fr * CS + ks * 64 + g * 16), qa[ks], s0); s1 = mfma16(ld_lds128(Cw + (16 + fr) * CS + ks * 64 + g * 16), qa[ks], s1); }
            const u32x2 k0 = *(LAS const u32x2*)(ILt + (kt * 32 + 4 * g) * 2), k1 = *(LAS const u32x2*)(ILt + (kt * 32 + 16 + 4 * g) * 2);
            float sv[8];
            sv[0] = (int)(k0.x & 0xFFFFu) <= pos ? s0[0] * 0.125f : -INFINITY; sv[1] = (int)(k0.x >> 16) <= pos ? s0[1] * 0.125f : -INFINITY;
            sv[2] = (int)(k0.y & 0xFFFFu) <= pos ? s0[2] * 0.125f : -INFINITY; sv[3] = (int)(k0.y >> 16) <= pos ? s0[3] * 0.125f : -INFINITY;
            sv[4] = (int)(k1.x & 0xFFFFu) <= pos ? s1[0] * 0.125f : -INFINITY; sv[5] = (int)(k1.x >> 16) <= pos ? s1[1] * 0.125f : -INFINITY;
            sv[6] = (int)(k1.y & 0xFFFFu) <= pos ? s1[2] * 0.125f : -INFINITY; sv[7] = (int)(k1.y >> 16) <= pos ? s1[3] * 0.125f : -INFINITY;
            float tm = fmaxf(fmaxf(fmaxf(sv[0], sv[1]), fmaxf(sv[2], sv[3])), fmaxf(fmaxf(sv[4], sv[5]), fmaxf(sv[6], sv[7])));
            tm = fmaxf(tm, __shfl_xor(tm, 16)); tm = fmaxf(tm, __shfl_xor(tm, 32));
            const float mnew = fmaxf(mrun, tm); const float sc = __expf(mrun - mnew); mrun = mnew;
            float ps = 0.f;
#pragma unroll
            for (int i = 0; i < 8; ++i) { sv[i] = __expf(sv[i] - mnew); ps += sv[i]; }
            lsum = lsum * sc + ps;
#pragma unroll
            for (int i = 0; i < 16; ++i) o[i] = o[i] * sc;
            union { bf16x8 v; unsigned u[4]; } pb; pb.u[0] = pk2(sv[0], sv[1]); pb.u[1] = pk2(sv[2], sv[3]); pb.u[2] = pk2(sv[4], sv[5]); pb.u[3] = pk2(sv[6], sv[7]);
            ldsp tra = Cw + (4 * g + (fr >> 2)) * CS + (fr & 3) * 8;
#pragma unroll
            for (int rt = 0; rt < 16; ++rt) {
                const s16x4 lo = tr_read(tra + rt * 32), hi4 = tr_read(tra + 16 * CS + rt * 32);
                bf16x8 a; a[0] = lo[0]; a[1] = lo[1]; a[2] = lo[2]; a[3] = lo[3]; a[4] = hi4[0]; a[5] = hi4[1]; a[6] = hi4[2]; a[7] = hi4[3];
                o[rt] = mfma16(a, pb.v, o[rt]); if ((rt & 3) == 3) __builtin_amdgcn_sched_barrier(0); }
        }
        lsum += __shfl_xor(lsum, 16); lsum += __shfl_xor(lsum, 32);
        const float inv = 1.0f / lsum;
        if (tk == 0) {
#pragma unroll
            for (int rt = 0; rt < 16; ++rt) { olat[0][rt].x = pk2(o[rt][0] * inv, o[rt][1] * inv); olat[0][rt].y = pk2(o[rt][2] * inv, o[rt][3] * inv); }
#pragma unroll
            for (int ks = 0; ks < 8; ++ks) qa[ks] = qb[ks];
        } else {
#pragma unroll
            for (int rt = 0; rt < 16; ++rt) { olat[1][rt].x = pk2(o[rt][0] * inv, o[rt][1] * inv); olat[1][rt].y = pk2(o[rt][2] * inv, o[rt][3] * inv); }
        }
    }
    __syncthreads();
#pragma unroll
    for (int rt = 0; rt < 16; ++rt) { *(LAS u32x2*)(X + (wid * 16 + fr) * XS + (rt * 16 + 4 * g) * 2) = olat[0][rt]; *(LAS u32x2*)(X + ((wid + 8) * 16 + fr) * XS + (rt * 16 + 4 * g) * 2) = olat[1][rt]; }
    __syncthreads();
#pragma unroll 1
    for (int hh = 0; hh < 2; ++hh) { const int h = wid * 2 + hh;
        bf16x8 ao[8];
#pragma unroll
        for (int ks = 0; ks < 8; ++ks) ao[ks] = ld_lds128(X + (fr * 16 + h) * XS + ks * 64 + g * 16);
#pragma unroll 4
        for (int dt = 0; dt < 4; ++dt) {
            const bf16_t* wp = WUV + ((size_t)(h * 64 + dt * 16 + fr)) * 256 + g * 8;
            f32x4 acc = {0.f, 0.f, 0.f, 0.f};
#pragma unroll
            for (int ks = 0; ks < 8; ++ks) acc = mfma16(ao[ks], *(const bf16x8*)(wp + ks * 32), acc);
#pragma unroll
            for (int j = 0; j < 4; ++j) O[(t0 + 4 * g + j) * 1024 + h * 64 + dt * 16 + fr] = (bf16_t)(pk2(acc[j], 0.f) & 0xFFFFu); } }
    __syncthreads();
}
__device__ __forceinline__ void sattn_phase(ldsp lds, const Params& p) {
    const int G = ogd(), bx = obx();
    if ((G & 7) == 0) {
        const int b = (bx & 7) >> 1, wb = (bx >> 3) * 2 + (bx & 1), nwb = G >> 2;
        for (int si = wb; si < 512; si += nwb) sattn_step(lds, p, b, si);
    } else {
        for (int s = bx; s < 2048; s += G) sattn_step(lds, p, s >> 9, s & 511);
    }
}

constexpr int RS = 272;
__device__ __forceinline__ void conv8(const u32x4 (&raw)[7], const float* cw, const float* cb, int c0, float (&out)[4][8]) {
    float w[4][8], bias[8];
#pragma unroll
    for (int k = 0; k < 4; ++k) { const f32x4 a = *(const f32x4*)(cw + k * 3072 + c0), b = *(const f32x4*)(cw + k * 3072 + c0 + 4);
        w[k][0] = a[0]; w[k][1] = a[1]; w[k][2] = a[2]; w[k][3] = a[3]; w[k][4] = b[0]; w[k][5] = b[1]; w[k][6] = b[2]; w[k][7] = b[3]; }
    { const f32x4 a = *(const f32x4*)(cb + c0), b = *(const f32x4*)(cb + c0 + 4); bias[0] = a[0]; bias[1] = a[1]; bias[2] = a[2]; bias[3] = a[3]; bias[4] = b[0]; bias[5] = b[1]; bias[6] = b[2]; bias[7] = b[3]; }
#pragma unroll
    for (int li = 0; li < 4; ++li)
#pragma unroll
        for (int i = 0; i < 8; ++i) { float v = bias[i];
#pragma unroll
            for (int k = 0; k < 4; ++k) { const unsigned wv = raw[li + k][i >> 1]; v = fmaf(w[k][i], (i & 1) ? bfhi(wv) : bflo(wv), v); }
            out[li][i] = pg8::silu_f(v); }
}
__device__ __forceinline__ float softplus_f(float x) {
    const float u = __expf(-fabsf(x));
    const float l = u < 0.03f ? u * (1.0f - u * (0.5f - u * (0.33333334f - 0.25f * u))) : __logf(1.0f + u);
    return fmaxf(x, 0.f) + l;
}
__device__ __forceinline__ void conv8l(const u32x4 (&raw)[7], LAS const float* wl, int stride, float (&out)[4][8]) {
    { const f32x4 a = *(LAS const f32x4*)(wl + 4 * stride), b = *(LAS const f32x4*)(wl + 4 * stride + 4);
#pragma unroll
      for (int li = 0; li < 4; ++li) { out[li][0] = a[0]; out[li][1] = a[1]; out[li][2] = a[2]; out[li][3] = a[3]; out[li][4] = b[0]; out[li][5] = b[1]; out[li][6] = b[2]; out[li][7] = b[3]; } }
#pragma unroll
    for (int k = 0; k < 4; ++k) { const f32x4 a = *(LAS const f32x4*)(wl + k * stride), b = *(LAS const f32x4*)(wl + k * stride + 4); const float w8[8] = {a[0], a[1], a[2], a[3], b[0], b[1], b[2], b[3]};
#pragma unroll
        for (int li = 0; li < 4; ++li)
#pragma unroll
            for (int i = 0; i < 8; ++i) { const unsigned wv = raw[li + k][i >> 1]; out[li][i] = fmaf(w8[i], (i & 1) ? bfhi(wv) : bflo(wv), out[li][i]); } }
#pragma unroll
    for (int li = 0; li < 4; ++li)
#pragma unroll
        for (int i = 0; i < 8; ++i) out[li][i] = pg8::silu_f(out[li][i]);
}
__device__ __forceinline__ void conv1l(const u32x4 (&raw)[4], LAS const float* wl, int stride, float (&out)[8]) {
#pragma unroll
    for (int i = 0; i < 8; ++i) out[i] = wl[4 * stride + i];
#pragma unroll
    for (int k = 0; k < 4; ++k) { const f32x4 a = *(LAS const f32x4*)(wl + k * stride), b = *(LAS const f32x4*)(wl + k * stride + 4); const float w8[8] = {a[0], a[1], a[2], a[3], b[0], b[1], b[2], b[3]};
#pragma unroll
        for (int i = 0; i < 8; ++i) { const unsigned wv = raw[k][i >> 1]; out[i] = fmaf(w8[i], (i & 1) ? bfhi(wv) : bflo(wv), out[i]); } }
#pragma unroll
    for (int i = 0; i < 8; ++i) out[i] = pg8::silu_f(out[i]);
}
__device__ __forceinline__ void load4(const bf16_t* ZX, size_t tb, int posl, int col, u32x4 (&raw)[4]) {
#pragma unroll
    for (int r = 0; r < 4; ++r) { const int pos = posl - 3 + r; raw[r] = pos >= 0 ? *(const u32x4*)(ZX + (tb + pos) * ZXLD + col) : (u32x4){0u, 0u, 0u, 0u}; }
}
__device__ __forceinline__ void load7(const bf16_t* ZX, size_t tb, int posl0, int col, u32x4 (&raw)[7]) {
#pragma unroll
    for (int r = 0; r < 7; ++r) { const int pos = posl0 - 3 + r; raw[r] = pos >= 0 ? *(const u32x4*)(ZX + (tb + pos) * ZXLD + col) : (u32x4){0u, 0u, 0u, 0u}; }
}
__device__ __forceinline__ void bc_conv_phase(const Params& p, int sl) {
    const bf16_t* ZX = (const bf16_t*)(p.ws + WS_TMP + T_ZX); bf16_t* BCC = (bf16_t*)(p.ws + WS_BCC);
    const float* cw = p.in[13] + (size_t)sl * 4 * 3072 + 2048; const float* cb = p.in[14] + (size_t)sl * 3072 + 2048;
    const int gt = obx() * NTHR + otid(), nthr = ogd() * NTHR;
    const int cg = gt & 127;
    float w[4][8], bias[8];
#pragma unroll
    for (int k = 0; k < 4; ++k) { const f32x4 a = *(const f32x4*)(cw + k * 3072 + cg * 8), b = *(const f32x4*)(cw + k * 3072 + cg * 8 + 4);
        w[k][0] = a[0]; w[k][1] = a[1]; w[k][2] = a[2]; w[k][3] = a[3]; w[k][4] = b[0]; w[k][5] = b[1]; w[k][6] = b[2]; w[k][7] = b[3]; }
    { const f32x4 a = *(const f32x4*)(cb + cg * 8), b = *(const f32x4*)(cb + cg * 8 + 4); bias[0] = a[0]; bias[1] = a[1]; bias[2] = a[2]; bias[3] = a[3]; bias[4] = b[0]; bias[5] = b[1]; bias[6] = b[2]; bias[7] = b[3]; }
    for (int item = gt; item < (MT / 8) * 128; item += nthr) {
        const int t0 = (item >> 7) * 8, pos0 = t0 & (SEQ - 1);
        u32x4 raw[11];
#pragma unroll
        for (int r = 0; r < 11; ++r) raw[r] = (pos0 - 3 + r) >= 0 ? *(const u32x4*)(ZX + (size_t)(t0 - 3 + r) * ZXLD + 4096 + cg * 8) : (u32x4){0u, 0u, 0u, 0u};
#pragma unroll
        for (int li = 0; li < 8; ++li) { float o[8];
#pragma unroll
            for (int i = 0; i < 8; ++i) { float v = bias[i];
#pragma unroll
                for (int k = 0; k < 4; ++k) { const unsigned wv = raw[li + k][i >> 1]; v = fmaf(w[k][i], (i & 1) ? bfhi(wv) : bflo(wv), v); }
                o[i] = pg8::silu_f(v); }
            u32x4 q; q.x = pk2(o[0], o[1]); q.y = pk2(o[2], o[3]); q.z = pk2(o[4], o[5]); q.w = pk2(o[6], o[7]);
            *(u32x4*)(BCC + (size_t)(t0 + li) * 1024 + cg * 8) = q; }
    }
}
template <bool DRY>
__device__ __forceinline__ void ssd_item(ldsp lds, const Params& p, int sl, int item) {
    const int tid = otid(), lane = tid & 63, wid = tid >> 6, fr = lane & 15, g = lane >> 4;
    const int b = item >> 6, h = (item >> 1) & 31, ph = item & 1, grp = h >> 3;
    bf16_t* ZX = (bf16_t*)(p.ws + WS_TMP + T_ZX); const float* DT = (const float*)(p.ws + WS_TMP + T_DT); float* SSQ = (float*)(p.ws + WS_TMP + T_SSQ);
    const float* cw_ = p.in[13] + (size_t)sl * 4 * 3072; const float* cb_ = p.in[14] + (size_t)sl * 3072;
    const float dtb = p.in[15][sl * 32 + h], av = -__expf(p.in[16][sl * 32 + h]), dsk = p.in[17][sl * 32 + h];
    const size_t tb = (size_t)b * SEQ;
    ldsp Cc = lds, Bc = lds + 34816, BcT = lds + 69632, XdT = lds + 104448, XwT = lds + 113152, Hb = lds + 121856, Xs = lds + 130560;
    LAS float* dtv = (LAS float*)(lds + 140800); LAS float* acs = (LAS float*)(lds + 141312);
    f32x4 hst[2] = {{0.f, 0.f, 0.f, 0.f}, {0.f, 0.f, 0.f, 0.f}};
    for (int i = tid; i < 32 * RS / 4; i += NTHR) ((LAS unsigned*)Hb)[i] = 0u;
    LAS float* cwl = (LAS float*)(lds + 141824);
    for (int i = tid; i < 1440; i += NTHR) { int which, k, ch, chan;
        if (i < 640) { which = 0; k = i >> 7; ch = i & 127; chan = 2048 + grp * 128 + ch; } else if (i < 1280) { which = 1; k = (i - 640) >> 7; ch = (i - 640) & 127; chan = 2560 + grp * 128 + ch; }
        else { which = 2; k = (i - 1280) >> 5; ch = (i - 1280) & 31; chan = h * 64 + ph * 32 + ch; }
        (void)which; cwl[i] = k < 4 ? cw_[k * 3072 + chan] : cb_[chan]; }
    __syncthreads();
    const int cgi = tid & 15, l0s = (tid >> 4) * 4, c0B = 2048 + grp * 128 + cgi * 8, c0C = c0B + 512;
    const int cgx = tid & 3, lx = tid >> 2, c0X = h * 64 + ph * 32 + cgx * 8;
    const bf16_t* BCC = (const bf16_t*)(p.ws + WS_BCC) + grp * 128;
    u32x4 rawB[4], rawC[4], rawX[4]; float dtr0 = 0.f, dtr1 = 0.f;
#define LOAD_BC(dst, tok0, off) do { _Pragma("unroll") for (int r_ = 0; r_ < 4; ++r_) dst[r_] = *(const u32x4*)(BCC + (size_t)((tok0) + r_) * 1024 + (off) + cgi * 8); } while (0)
    LOAD_BC(rawC, tb + l0s, 512); load4(ZX, tb, lx, 2048 + c0X, rawX);
    LOAD_BC(rawB, tb + l0s, 0);
    if (wid == 7) { dtr0 = DT[(tb + 2 * lane) * 32 + h]; dtr1 = DT[(tb + 2 * lane + 1) * 32 + h]; }
#pragma unroll 1
    for (int c = 0; c < 64; ++c) {
        const int cp = c * 128;
        int tidc = tid; asm volatile("" : "+v"(tidc));
        const int lane = tidc & 63, wid = tidc >> 6, fr = lane & 15, g = lane >> 4;
        const int cgi = tidc & 15, l0s = (tidc >> 4) * 4, c0B = 2048 + grp * 128 + cgi * 8, c0C = c0B + 512;
        const int cgx = tidc & 3, lx = tidc >> 2, c0X = h * 64 + ph * 32 + cgx * 8;
        u32x2 zpre[2];
        { bf16_t* zp = ZX + (tb + cp + 16 * wid + fr) * ZXLD + h * 64 + ph * 32 + 4 * g; zpre[0] = *(const u32x2*)zp; zpre[1] = *(const u32x2*)(zp + 16); }
        if (wid == 7) {
            const float r0 = dtr0 + dtb, r1 = dtr1 + dtb;
            if (c + 1 < 64) { dtr0 = DT[(tb + cp + 128 + 2 * lane) * 32 + h]; dtr1 = DT[(tb + cp + 128 + 2 * lane + 1) * 32 + h]; }
            const float d0 = softplus_f(r0), d1 = softplus_f(r1);
            const float a0 = d0 * av, a1 = d1 * av; float sc = a0 + a1;
#pragma unroll
            for (int d = 1; d < 64; d <<= 1) { const float t = __shfl_up(sc, d); if (lane >= d) sc += t; }
            dtv[2 * lane] = d0; dtv[2 * lane + 1] = d1; acs[2 * lane] = sc - a1; acs[2 * lane + 1] = sc;
        }
        { const int l0 = l0s;
#pragma unroll
          for (int li = 0; li < 4; ++li) { *(LAS u32x4*)(Bc + (l0 + li) * RS + cgi * 16) = rawB[li]; *(LAS u32x4*)(Cc + (l0 + li) * RS + cgi * 16) = rawC[li]; }
#pragma unroll
          for (int i = 0; i < 8; ++i) { u32x2 w;
              if (i & 1) { w.x = (rawB[0][i >> 1] >> 16) | (rawB[1][i >> 1] & 0xFFFF0000u); w.y = (rawB[2][i >> 1] >> 16) | (rawB[3][i >> 1] & 0xFFFF0000u); }
              else { w.x = (rawB[0][i >> 1] & 0xFFFFu) | (rawB[1][i >> 1] << 16); w.y = (rawB[2][i >> 1] & 0xFFFFu) | (rawB[3][i >> 1] << 16); }
              *(LAS u32x2*)(BcT + (cgi * 8 + i) * RS + l0 * 2) = w; }
          if (c + 1 < 64) LOAD_BC(rawB, tb + cp + 128 + l0, 0); }
        __syncthreads();
        const float aend = acs[127];
        { float o8[8]; conv1l(rawX, cwl + 1280 + cgx * 8, 32, o8);
          const float dl = dtv[lx], wl = dl * __expf(aend - acs[lx]);
          u32x4 w; w.x = pk2(o8[0], o8[1]); w.y = pk2(o8[2], o8[3]); w.z = pk2(o8[4], o8[5]); w.w = pk2(o8[6], o8[7]);
          *(LAS u32x4*)(Xs + lx * 80 + cgx * 16) = w;
#pragma unroll
          for (int i = 0; i < 8; i += 2) { const int pp = cgx * 8 + i; const unsigned a2 = pk2(o8[i] * dl, o8[i + 1] * dl), b2 = pk2(o8[i] * wl, o8[i + 1] * wl);
              *(LAS unsigned short*)(XdT + pp * RS + lx * 2) = (unsigned short)(a2 & 0xFFFFu); *(LAS unsigned short*)(XdT + (pp + 1) * RS + lx * 2) = (unsigned short)(a2 >> 16);
              *(LAS unsigned short*)(XwT + pp * RS + lx * 2) = (unsigned short)(b2 & 0xFFFFu); *(LAS unsigned short*)(XwT + (pp + 1) * RS + lx * 2) = (unsigned short)(b2 >> 16); } }
        u32x2 mm[8];
        { bf16x8 a[4];
#pragma unroll
          for (int ks = 0; ks < 4; ++ks) a[ks] = ld_lds128(Bc + (16 * wid + fr) * RS + ks * 64 + g * 16);
          float as4[4];
#pragma unroll
          for (int j = 0; j < 4; ++j) as4[j] = acs[16 * wid + 4 * g + j];
#pragma unroll
          for (int lt = 0; lt < 8; ++lt) {
              mm[lt] = (u32x2){0u, 0u};
              if (lt >= wid) {
                  f32x4 acc = {0.f, 0.f, 0.f, 0.f};
#pragma unroll
                  for (int ks = 0; ks < 4; ++ks) acc = mfma16(a[ks], ld_lds128(Cc + (lt * 16 + fr) * RS + ks * 64 + g * 16), acc);
                  const int l = lt * 16 + fr; const float al = acs[l]; float v[4];
#pragma unroll
                  for (int j = 0; j < 4; ++j) { const int s = 16 * wid + 4 * g + j; v[j] = (s <= l) ? acc[j] * __expf(al - as4[j]) : 0.f; }
                  mm[lt].x = pk2(v[0], v[1]); mm[lt].y = pk2(v[2], v[3]); } } }
        __syncthreads();
#pragma unroll
        for (int lt = 0; lt < 8; ++lt) *(LAS u32x2*)(Bc + (lt * 16 + fr) * RS + (16 * wid + 4 * g) * 2) = mm[lt];
        __syncthreads();
        if (c + 1 < 64) { LOAD_BC(rawC, tb + cp + 128 + l0s, 512); load4(ZX, tb, cp + 128 + lx, 2048 + c0X, rawX); }
        { f32x4 y1[2] = {{0.f, 0.f, 0.f, 0.f}, {0.f, 0.f, 0.f, 0.f}}, y2[2] = {{0.f, 0.f, 0.f, 0.f}, {0.f, 0.f, 0.f, 0.f}};
          const int l = 16 * wid + fr;
#pragma unroll
          for (int ks = 0; ks < 4; ++ks) {
              const bf16x8 bm = ld_lds128(Bc + l * RS + ks * 64 + g * 16), bc = ld_lds128(Cc + l * RS + ks * 64 + g * 16);
#pragma unroll
              for (int pt = 0; pt < 2; ++pt) { y1[pt] = mfma16(ld_lds128(XdT + (pt * 16 + fr) * RS + ks * 64 + g * 16), bm, y1[pt]); y2[pt] = mfma16(ld_lds128(Hb + (pt * 16 + fr) * RS + ks * 64 + g * 16), bc, y2[pt]); } }
          const float el = __expf(acs[l]); const size_t tg = tb + cp + l; float sq = 0.f;
#pragma unroll
          for (int pt = 0; pt < 2; ++pt) { const int pp = pt * 16 + 4 * g;
              const u32x2 xs2 = *(LAS const u32x2*)(Xs + l * 80 + pp * 2); bf16_t* zp = ZX + tg * ZXLD + h * 64 + ph * 32 + pp; const u32x2 z2 = zpre[pt];
              float yv[4], xv[4] = {bflo(xs2.x), bfhi(xs2.x), bflo(xs2.y), bfhi(xs2.y)}, zv[4] = {bflo(z2.x), bfhi(z2.x), bflo(z2.y), bfhi(z2.y)};
#pragma unroll
              for (int j = 0; j < 4; ++j) { yv[j] = (y1[pt][j] + el * y2[pt][j] + xv[j] * dsk) * pg8::silu_f(zv[j]); sq += yv[j] * yv[j]; }
              u32x2 w; w.x = pk2(yv[0], yv[1]); w.y = pk2(yv[2], yv[3]);
              if (DRY) *(u32x2*)((bf16_t*)(p.ws + WS_END + 65536) + (((size_t)(zp - ZX)) & 0xFFFFFCull)) = w; else *(u32x2*)zp = w; }
          sq += __shfl_xor(sq, 16); sq += __shfl_xor(sq, 32);
          if (g == 0) { if (DRY) ((float*)(p.ws + WS_END + 65536 + 40000000))[(tg * 64 + h * 2 + ph) & 0xFFFFF] = sq; else SSQ[tg * 64 + h * 2 + ph] = sq; } }
        { const float dec = __expf(aend);
          hst[0] = hst[0] * dec; hst[1] = hst[1] * dec;
#pragma unroll
          for (int ks = 0; ks < 4; ++ks) { const bf16x8 ab = ld_lds128(BcT + (16 * wid + fr) * RS + ks * 64 + g * 16);
#pragma unroll
              for (int pt = 0; pt < 2; ++pt) hst[pt] = mfma16(ab, ld_lds128(XwT + (pt * 16 + fr) * RS + ks * 64 + g * 16), hst[pt]); } }
        __syncthreads();
#pragma unroll
        for (int pt = 0; pt < 2; ++pt) { u32x2 w; w.x = pk2(hst[pt][0], hst[pt][1]); w.y = pk2(hst[pt][2], hst[pt][3]); *(LAS u32x2*)(Hb + (pt * 16 + fr) * RS + (16 * wid + 4 * g) * 2) = w; }
    }
    __syncthreads();
#undef LOAD_BC
}
__device__ __forceinline__ void ssd_norm_phase(const Params& p) {
    bf16_t* ZX = (bf16_t*)(p.ws + WS_TMP + T_ZX); const float* SSQ = (const float*)(p.ws + WS_TMP + T_SSQ);
    const int tid_ = otid(); const int lane = tid_ & 63, gw = obx() * 8 + (tid_ >> 6), nw = ogd() * 8;
    for (int row0 = gw; row0 < MT; row0 += 2 * nw) {
        float part[2]; u32x4 v[2][4];
#pragma unroll
        for (int r = 0; r < 2; ++r) { const int row = row0 + r * nw; const size_t rr = (size_t)(row < MT ? row : row0);
            part[r] = SSQ[rr * 64 + lane];
#pragma unroll
            for (int i = 0; i < 4; ++i) v[r][i] = *(const u32x4*)(ZX + rr * ZXLD + i * 512 + lane * 8); }
#pragma unroll
        for (int r = 0; r < 2; ++r) { const int row = row0 + r * nw;
            float pt = part[r]; pt += __shfl_xor(pt, 1); pt += __shfl_xor(pt, 2); pt += __shfl_xor(pt, 4); pt += __shfl_xor(pt, 8);
#pragma unroll
            for (int i = 0; i < 4; ++i) { const float rs = rsqrtf(__shfl(pt, i * 16) * (1.0f / 512.0f) + RMS_EPS); u32x4 w;
#pragma unroll
                for (int k = 0; k < 4; ++k) w[k] = pk2(bflo(v[r][i][k]) * rs, bfhi(v[r][i][k]) * rs);
                if (row < MT) *(u32x4*)(ZX + (size_t)row * ZXLD + i * 512 + lane * 8) = w; } }
    }
}

#define XB_TMO      128
#define XB_XCNT(j)  (256  + 64 * (j))
#define XB_XSUB(j)  (1280 + 64 * (j))
#define XB_XGEN(j)  (2304 + 64 * (j))
#define XB_TOP      3328
#define XB_TOPGEN   3392
#define XCD_BAR_WORDS 3456
#define XB_SPIN_CAP (1u << 20)
__device__ __forceinline__ unsigned xb_ld(unsigned* p)              { return __hip_atomic_load(p, __ATOMIC_RELAXED, __HIP_MEMORY_SCOPE_AGENT); }
__device__ __forceinline__ unsigned xb_add(unsigned* p, unsigned v) { return __hip_atomic_fetch_add(p, v, __ATOMIC_RELAXED, __HIP_MEMORY_SCOPE_AGENT); }
__device__ __forceinline__ unsigned xb_xcc_id() { return (unsigned)__builtin_amdgcn_s_getreg((3 << 11) | 20) & 0xFu; }
#define XB_SPIN(cond, bar) do { unsigned _sp = 0; while (cond) { __builtin_amdgcn_s_sleep(1); \
    if ((++_sp & 255u) == 0u) { if (xb_ld(&(bar)[XB_TMO])) break; if (_sp > XB_SPIN_CAP) { atomicAdd(&(bar)[XB_TMO], 1u); break; } } } } while (0)
struct XcdBarrier { unsigned* bar; unsigned x; volatile LAS unsigned* st; };
__device__ __forceinline__ void xcd_barrier_complete(unsigned* bar, unsigned x, unsigned& nloc, unsigned& nx) {
    const unsigned G = gridDim.x * gridDim.y * gridDim.z;
    unsigned sum, cnt, mine, sp = 0u;
    for (;;) {
        sum = 0u; cnt = 0u; mine = 0u;
#pragma unroll
        for (unsigned j = 0; j < 16; ++j) { const unsigned c = xb_ld(&bar[XB_XCNT(j)]); sum += c; cnt += (c > 0u) ? 1u : 0u; mine = (j == x) ? c : mine; }
        if (sum == G) break;
        __builtin_amdgcn_s_sleep(1);
        if ((++sp & 255u) == 0u) { if (xb_ld(&bar[XB_TMO])) break; if (sp > XB_SPIN_CAP) { atomicAdd(&bar[XB_TMO], 1u); break; } }
    }
    nloc = mine > 0u ? mine : 1u; nx = cnt > 0u ? cnt : 1u;
}
__device__ __forceinline__ void xcd_barrier(const XcdBarrier& b) {
    asm volatile("s_waitcnt vmcnt(0)" ::: "memory");
    __syncthreads();
    if (otid() == 0) {
        unsigned* bar = b.bar;
        __builtin_amdgcn_s_waitcnt(0);
        unsigned nloc = b.st[0], nx = b.st[1];
        if (nloc == 0u) { xcd_barrier_complete(bar, b.x, nloc, nx); b.st[0] = nloc; b.st[1] = nx; }
        const unsigned old = xb_add(&bar[XB_XSUB(b.x)], 1u);
        const unsigned gen = old / nloc;
        if (old + 1u == (gen + 1u) * nloc) {
            __builtin_amdgcn_fence(__ATOMIC_RELEASE, "agent");
            asm volatile("s_waitcnt vmcnt(0)" ::: "memory");
            const unsigned og = xb_add(&bar[XB_TOP], 1u);
            const unsigned tg = og / nx;
            if (og + 1u == (tg + 1u) * nx) xb_add(&bar[XB_TOPGEN], 1u);
            else XB_SPIN(xb_ld(&bar[XB_TOPGEN]) == tg, bar);
            __builtin_amdgcn_fence(__ATOMIC_ACQUIRE, "agent");
            xb_add(&bar[XB_XGEN(b.x)], 1u);
            asm volatile("s_waitcnt vmcnt(0)" ::: "memory");
        } else {
            XB_SPIN(xb_ld(&bar[XB_XGEN(b.x)]) == gen, bar);
            __builtin_amdgcn_fence(__ATOMIC_ACQUIRE, "agent");
            asm volatile("s_waitcnt vmcnt(0)" ::: "memory");
        }
    }
    __syncthreads();
}
constexpr size_t WS_BAR = WS_END;
constexpr int LDS_BARST = LDS_BYTES - 16;
#define GRID_BAR() do { XcdBarrier _b; { const Params _q = load_params(); _b.bar = (unsigned*)(_q.ws + WS_BAR); } _b.x = xb_xcc_id(); _b.st = (volatile LAS unsigned*)(lds + LDS_BARST); xcd_barrier(_b); } while (0)

__global__ void __launch_bounds__(NTHR, 2) fwd_megakernel(Params p) {
    extern __shared__ __attribute__((aligned(16))) unsigned char smem[];
    ldsp lds = (ldsp)smem;
    cg::grid_group grid = cg::this_grid();
    if (otid() == 0) { ((volatile LAS unsigned*)(lds + LDS_BARST))[0] = 0u; ((volatile LAS unsigned*)(lds + LDS_BARST))[1] = 0u; }
    __syncthreads();
    { const Params q = load_params(); if (otid() == 0) (void)xb_add(&((unsigned*)(q.ws + WS_BAR))[XB_XCNT(xb_xcc_id())], 1u); }
    { const Params q = load_params(); cvt_x_phase(q.in[0], (bf16_t*)(q.ws + WS_XB)); }
#ifndef NO_CONV
    { const Params q = load_params(); convert_layer(lds, q, 0); }
#endif
    if (ogd() == 0x7FFFFFF) grid.sync();
    GRID_BAR();
#pragma unroll 1
    for (int sub = 0; sub < 12; ++sub) {
        const int L = sub / 3, kind = sub % 3, sl = L >> 1; const bool attn = (L & 1) == 0;
#if defined(SKIP_ATTN) || defined(SKIP_SSM)
        {
#if defined(SKIP_ATTN) && defined(SKIP_SSM)
            const bool skip = kind == 1;
#elif defined(SKIP_ATTN)
            const bool skip = kind == 1 && attn;
#else
            const bool skip = kind == 1 && !attn;
#endif
            if (skip) { const Params q = load_params(); ln_phase<false>(q.out, (bf16_t*)(q.ws + WS_XB), q.in[1] + (size_t)(L * 3 + kind) * DM, q.in[2] + (size_t)(L * 3 + kind) * DM, nullptr, sub == 11); GRID_BAR(); continue; }
        }
#endif
        if (kind != 1) {
            const Params q = load_params(); const int G = ogd(), bx = obx();
            pg8::Gemm gm{(const bf16_t*)(q.ws + WS_XB), (const bf16_t*)(q.ws + WS_WL + (kind == 0 ? WL_F1IN : WL_F2IN)), MT, 5632, 1024, 1024}; pg8::StaticOrder S; S.init(MT, 5632, G, bx);
            pg8::EpiSwiglu E{(bf16_t*)(q.ws + WS_TMP + T_H)};
            pg8::gemm_phase<pg8::EpiSwiglu, pg8::StaticOrder>((PG8_LAS unsigned char*)lds, gm, S, E, nullptr);
        } else {
            const Params q = load_params(); const int G = ogd(), bx = obx(); unsigned char* tmp = q.ws + WS_TMP;
            const int N = attn ? 2048 : 5376;
            pg8::Gemm gm{(const bf16_t*)(q.ws + WS_XB), (const bf16_t*)(q.ws + WS_WL + WL_MIX), MT, N, 1024, 1024}; pg8::StaticOrder S; S.init(MT, N, G, bx);
            pg8::EpiSplit E{(bf16_t*)tmp, attn ? QBLD : ZXLD, attn ? 7 : 20, (float*)(tmp + (attn ? T_CKV : T_DT)), attn ? 256 : 32, attn ? 256 : 32, (bf16_t*)(tmp + T_KW), attn ? 6 : -1};
            pg8::gemm_phase<pg8::EpiSplit, pg8::StaticOrder>((PG8_LAS unsigned char*)lds, gm, S, E, nullptr);
        }
        GRID_BAR();
        if (kind == 1) {
            if (attn) {
                { const Params q = load_params(); ckv_norm_phase((const float*)(q.ws + WS_TMP + T_CKV), (bf16_t*)(q.ws + WS_TMP + T_CKVN), q.in[8] + (size_t)sl * 256); }
#ifndef NO_IDX
                { const Params q = load_params(); indexer_phase(lds, q); }
#ifdef DBL_IDX
                { const Params q = load_params(); indexer_phase(lds, q); }
#endif
#endif
                GRID_BAR();
#ifndef NO_SATTN
                { const Params q = load_params(); sattn_phase(lds, q); }
#ifdef DBL_SATTN
                { const Params q = load_params(); sattn_phase(lds, q); }
#endif
#else
                { const Params q = load_params(); u32x4* Oz = (u32x4*)(q.ws + WS_TMP + T_O); for (size_t i = (size_t)obx() * NTHR + otid(); i < (size_t)MT * 1024 / 8; i += (size_t)ogd() * NTHR) Oz[i] = (u32x4){0u, 0u, 0u, 0u}; }
#endif
                GRID_BAR();
            } else {
                { const Params q = load_params(); bc_conv_phase(q, sl); }
                GRID_BAR();
#ifndef NO_SSD
#ifdef DBL_SSD
                { const Params q = load_params(); const int G = ogd(); for (int it = obx(); it < 256; it += G) ssd_item<true>(lds, q, sl, it); }
#endif
                { const Params q = load_params(); const int G = ogd();
                  for (int it = obx(); it < 256; it += G) { int item = it;
                      if (G == 256) { const int xcd = it & 7, slot = it >> 3, bg = xcd * 2 + (slot >> 4), wi = slot & 15; item = ((bg >> 2) << 6) | ((((bg & 3) * 8) + (wi >> 1)) << 1) | (wi & 1); }
                      ssd_item<false>(lds, q, sl, item); } }
#endif
                GRID_BAR();
                { const Params q = load_params(); ssd_norm_phase(q); }
                GRID_BAR();
            }
        }
        {
            const Params q = load_params(); const int G = ogd(), bx = obx(); unsigned char* tmp = q.ws + WS_TMP; unsigned char* wl = q.ws + WS_WL;
            const bf16_t* A2 = (const bf16_t*)(tmp + T_H); int K2 = DFF, lda2 = DFF; const bf16_t* B2 = (const bf16_t*)(wl + (kind == 0 ? WL_F1OUT : WL_F2OUT)); float sc2 = 0.5f;
            if (kind == 1) { sc2 = 1.0f;
                if (attn) { A2 = (const bf16_t*)(tmp + T_O); K2 = 1024; lda2 = 1024; B2 = (const bf16_t*)(wl + WL_MIX + WM_AOUT); }
                else { A2 = (const bf16_t*)(tmp + T_ZX); K2 = 2048; lda2 = ZXLD; B2 = (const bf16_t*)(wl + WL_MIX + WM_SOUT); } }
            pg8::Gemm gm{A2, B2, MT, 1024, K2, lda2}; pg8::StaticOrder S; S.init(MT, 1024, G, bx);
            pg8::EpiResid E{(bf16_t*)(q.ws + WS_XB), ALPHA, sc2};
            pg8::gemm_phase<pg8::EpiResid, pg8::StaticOrder>((PG8_LAS unsigned char*)lds, gm, S, E, nullptr);
        }
        GRID_BAR();
#ifdef DBL_LN
        { const Params q = load_params(); ln_phase<true>(q.out, (bf16_t*)(q.ws + WS_XB), q.in[1] + (size_t)(L * 3 + kind) * DM, q.in[2] + (size_t)(L * 3 + kind) * DM, q.ws + WS_END + 65536, sub == 11); }
#endif
        { const Params q = load_params(); ln_phase<false>(q.out, (bf16_t*)(q.ws + WS_XB), q.in[1] + (size_t)(L * 3 + kind) * DM, q.in[2] + (size_t)(L * 3 + kind) * DM, nullptr, sub == 11); }
#ifndef NO_CONV
        if (kind == 2 && L < 3) { const Params q = load_params(); convert_layer(lds, q, L + 1); }
#endif
        GRID_BAR();
    }
}

extern "C" void kernel_launch(void* const* d_in, const int* in_sizes, int n_in, void* d_out, int out_size, void* d_ws, size_t ws_size, hipStream_t stream) {
    static int grid_blocks = 0;
    if (grid_blocks == 0) {
        if (n_in != 20 || ws_size < WS_BCC + (size_t)MT * 1024 * 2) { fprintf(stderr, "kernel_launch: unexpected inputs (n_in %d, ws %zu < %zu)\n", n_in, ws_size, (size_t)WS_END); grid_blocks = -1; return; }
        int dev = 0, cus = 0, per_cu = 0;
        hipGetDevice(&dev); hipDeviceGetAttribute(&cus, hipDeviceAttributeMultiprocessorCount, dev);
        if (hipFuncSetAttribute((const void*)fwd_megakernel, hipFuncAttributeMaxDynamicSharedMemorySize, LDS_BYTES) != hipSuccess) { fprintf(stderr, "kernel_launch: hipFuncSetAttribute failed\n"); grid_blocks = -1; return; }
        hipOccupancyMaxActiveBlocksPerMultiprocessor(&per_cu, (const void*)fwd_megakernel, NTHR, LDS_BYTES);
        if (per_cu < 1) { fprintf(stderr, "kernel_launch: occupancy query says %d blocks per CU\n", per_cu); per_cu = 1; }
        (void)hipGetLastError();
        grid_blocks = cus * per_cu;
    }
    if (grid_blocks < 0) return;
    if (hipMemsetAsync((char*)d_ws + WS_BAR, 0, XCD_BAR_WORDS * 4, stream) != hipSuccess) { fprintf(stderr, "kernel_launch: memset of the barrier words failed\n"); return; }
    Params p{};
    for (int i = 0; i < 20; ++i) p.in[i] = (const float*)d_in[i];
    p.out = (float*)d_out; p.ws = (unsigned char*)d_ws;
    void* args[] = {&p};
    hipError_t e = hipLaunchCooperativeKernel((const void*)fwd_megakernel, dim3(grid_blocks), dim3(NTHR), args, LDS_BYTES, stream);
    if (e != hipSuccess) fprintf(stderr, "cooperative launch failed: %s (grid %d)\n", hipGetErrorString(e), grid_blocks);
}
```
